# Optimizing an MI355X kernel written in HIP

```python
import jax, jax.numpy as jnp
from jax import lax
import numpy as np

D_MODEL = 2048
BATCH = 4
SEQ = 4096
DEPTH = 1

HEAD_DIM = 128
ROPE_DIM = HEAD_DIM // 4
ROPE_THETA = 500000.0
NORM_EPS = 1e-5
NEG_INF = -1e30
SEL_FORCED = 1e9

NSA_HEADS = 8
NSA_GROUPS = 2
NSA_REP = NSA_HEADS // NSA_GROUPS
CMP_BLOCK = 32
CMP_STRIDE = 16
CMP_HIDDEN = 256
SEL_BLOCK = 64
SEL_TOPN = 16
WINDOW = 512
WIN_QBLOCK = 128
NSA_QCHUNK = 64

MOBA_HEADS = 8
MOBA_BLOCK = 256
MOBA_TOPK = 3
MOBA_QCHUNK = 16

N_EXPERTS = 32
TOP_K = 4
D_FF = 2048
SWIGLU_LIMIT = 7.0
SWIGLU_ALPHA = 1.702
EXPERT_ROW_BLOCK = 256

NSA_WIDTH = NSA_HEADS * HEAD_DIM
MOBA_WIDTH = MOBA_HEADS * HEAD_DIM
NSA_KV_WIDTH = NSA_GROUPS * HEAD_DIM
IN_SPLITS = (NSA_WIDTH, 6 * NSA_KV_WIDTH, 3 * NSA_HEADS, 3 * MOBA_WIDTH, 2 * D_MODEL)
IN_WIDTH = sum(IN_SPLITS)

kernel_name = "hybrid_nsa_moba_gptoss_moe"


def rms_norm(x, g):
    xf = x.astype(jnp.float32)
    y = xf * lax.rsqrt(jnp.mean(xf * xf, axis=-1, keepdims=True) + NORM_EPS)
    return (y * g.astype(jnp.float32)).astype(x.dtype)


def rope_partial(x, pos):
    half = ROPE_DIM // 2
    inv_freq = ROPE_THETA ** (-jnp.arange(0, ROPE_DIM, 2, dtype=jnp.float32) / ROPE_DIM)
    ang = pos.astype(jnp.float32)[..., None] * inv_freq
    cos = jnp.cos(ang)[:, :, None, :]
    sin = jnp.sin(ang)[:, :, None, :]
    x1 = x[..., :half].astype(jnp.float32)
    x2 = x[..., half:ROPE_DIM].astype(jnp.float32)
    rot = jnp.concatenate([x1 * cos - x2 * sin, x2 * cos + x1 * sin], axis=-1).astype(x.dtype)
    return jnp.concatenate([rot, x[..., ROPE_DIM:]], axis=-1)


def masked_softmax(scores, mask, axis=-1):
    s = jnp.where(mask, scores.astype(jnp.float32), NEG_INF)
    p = jax.nn.softmax(s, axis=axis)
    return jnp.where(mask, p, 0.0)


def compress_blocks(kv, pe, w1, w2):
    B, S, G, HD = kv.shape
    n_cmp = (S - CMP_BLOCK) // CMP_STRIDE + 1
    idx = np.arange(n_cmp)[:, None] * CMP_STRIDE + np.arange(CMP_BLOCK)[None, :]
    blocks = kv[:, idx] + pe[:, None, :]
    blocks = blocks.transpose(0, 1, 3, 2, 4).reshape(B, n_cmp, G, CMP_BLOCK * HD)
    return jax.nn.gelu(blocks @ w1) @ w2


def nsa_mixer(q, k_cmp, v_cmp, k_slc, v_slc, k_win, v_win, gate_logits, pos,
              pe_k, w_k1, w_k2, pe_v, w_v1, w_v2):
    B, S = q.shape[:2]
    G, R, HD = NSA_GROUPS, NSA_REP, HEAD_DIM
    scale = HD ** -0.5
    t = np.arange(S)
    qg = q.reshape(B, S, G, R, HD).transpose(0, 2, 3, 1, 4)

    n_cmp = (S - CMP_BLOCK) // CMP_STRIDE + 1
    cmp_start = np.arange(n_cmp) * CMP_STRIDE
    cmp_end = cmp_start + CMP_BLOCK - 1
    kc = rope_partial(compress_blocks(k_cmp, pe_k, w_k1, w_k2), pos[:, cmp_end]).transpose(0, 2, 1, 3)
    vc = compress_blocks(v_cmp, pe_v, w_v1, w_v2).transpose(0, 2, 1, 3)
    s_c = jnp.einsum('bgrsd,bgnd->bgrsn', qg, kc) * scale
    p_c = masked_softmax(s_c, cmp_end[None, :] <= t[:, None])
    o_cmp = jnp.einsum('bgrsn,bgnd->bgrsd', p_c.astype(vc.dtype), vc)

    n_slc = S // SEL_BLOCK
    n_sel = min(SEL_TOPN, n_slc)
    slc_start = np.arange(n_slc) * SEL_BLOCK
    overlap = np.clip(np.minimum(cmp_start[:, None] + CMP_BLOCK, slc_start[None, :] + SEL_BLOCK)
                      - np.maximum(cmp_start[:, None], slc_start[None, :]), 0, None)
    cmp_to_slc = jnp.asarray(overlap / CMP_BLOCK, dtype=jnp.float32)
    imp = jnp.einsum('bgrsn,nj->bgsj', p_c, cmp_to_slc)
    cur = t // SEL_BLOCK
    j = np.arange(n_slc)
    valid = j[None, :] <= cur[:, None]
    forced = (j[None, :] == 0) | (j[None, :] == cur[:, None]) | (j[None, :] == cur[:, None] - 1)
    score = jnp.where(forced, SEL_FORCED, jnp.where(valid, imp, -SEL_FORCED))
    top_val, sel_idx = lax.top_k(score, n_sel)
    sel_ok = top_val > -0.5 * SEL_FORCED

    kb = k_slc.transpose(0, 2, 1, 3).reshape(B, G, n_slc, SEL_BLOCK, HD)
    vb = v_slc.transpose(0, 2, 1, 3).reshape(B, G, n_slc, SEL_BLOCK, HD)
    qc_n = S // NSA_QCHUNK
    q_ch = qg.reshape(B, G, R, qc_n, NSA_QCHUNK, HD).transpose(3, 0, 1, 2, 4, 5)
    idx_ch = sel_idx.reshape(B, G, qc_n, NSA_QCHUNK, n_sel).transpose(2, 0, 1, 3, 4)
    ok_ch = sel_ok.reshape(B, G, qc_n, NSA_QCHUNK, n_sel).transpose(2, 0, 1, 3, 4)
    bi = jnp.arange(B)[:, None, None, None]
    gi = jnp.arange(G)[None, :, None, None]

    def sel_step(args):
        c, qc, ic, okc = args
        kg = kb[bi, gi, ic]
        vg = vb[bi, gi, ic]
        s = jnp.einsum('bgrqd,bgqnkd->bgrqnk', qc, kg) * scale
        tq = c * NSA_QCHUNK + jnp.arange(NSA_QCHUNK)
        kpos = ic[..., None] * SEL_BLOCK + jnp.arange(SEL_BLOCK)
        mask = (okc[..., None] & (kpos <= tq[None, None, :, None, None]))[:, :, None]
        p = masked_softmax(s, mask, axis=(-2, -1))
        return jnp.einsum('bgrqnk,bgqnkd->bgrqd', p.astype(vg.dtype), vg)

    o_slc = lax.map(sel_step, (jnp.arange(qc_n), q_ch, idx_ch, ok_ch))
    o_slc = o_slc.transpose(1, 2, 3, 0, 4, 5).reshape(B, G, R, S, HD)

    nwb = S // WIN_QBLOCK
    nb_back = WINDOW // WIN_QBLOCK
    band = (nb_back + 1) * WIN_QBLOCK
    kw = jnp.pad(k_win.transpose(0, 2, 1, 3).reshape(B, G, nwb, WIN_QBLOCK, HD),
                 ((0, 0), (0, 0), (nb_back, 0), (0, 0), (0, 0)))
    vw = jnp.pad(v_win.transpose(0, 2, 1, 3).reshape(B, G, nwb, WIN_QBLOCK, HD),
                 ((0, 0), (0, 0), (nb_back, 0), (0, 0), (0, 0)))
    k_band = jnp.concatenate([kw[:, :, i:i + nwb] for i in range(nb_back + 1)], axis=3)
    v_band = jnp.concatenate([vw[:, :, i:i + nwb] for i in range(nb_back + 1)], axis=3)
    qw = qg.reshape(B, G, R, nwb, WIN_QBLOCK, HD)
    s_w = jnp.einsum('bgrnqd,bgnkd->bgrnqk', qw, k_band) * scale
    qpos = np.arange(S).reshape(nwb, WIN_QBLOCK)
    kpos = (np.arange(nwb)[:, None] - nb_back) * WIN_QBLOCK + np.arange(band)[None, :]
    dpos = qpos[:, :, None] - kpos[:, None, :]
    mask_w = (dpos >= 0) & (dpos < WINDOW) & (kpos[:, None, :] >= 0)
    p_w = masked_softmax(s_w, mask_w)
    o_win = jnp.einsum('bgrnqk,bgnkd->bgrnqd', p_w.astype(v_band.dtype), v_band).reshape(B, G, R, S, HD)

    g = jax.nn.sigmoid(gate_logits.astype(jnp.float32)).astype(q.dtype)
    g = g.reshape(B, S, 3, G, R).transpose(2, 0, 3, 4, 1)[..., None]
    o = g[0] * o_cmp + g[1] * o_slc + g[2] * o_win
    return o.transpose(0, 3, 1, 2, 4).reshape(B, S, NSA_WIDTH)


def moba_mixer(q, k, v):
    B, S, H, HD = q.shape
    scale = HD ** -0.5
    q = q.transpose(0, 2, 1, 3)
    k = k.transpose(0, 2, 1, 3)
    v = v.transpose(0, 2, 1, 3)
    n_blk = -(-S // MOBA_BLOCK)
    pad = n_blk * MOBA_BLOCK - S
    kb = jnp.pad(k, ((0, 0), (0, 0), (0, pad), (0, 0))).reshape(B, H, n_blk, MOBA_BLOCK, HD)
    vb = jnp.pad(v, ((0, 0), (0, 0), (0, pad), (0, 0))).reshape(B, H, n_blk, MOBA_BLOCK, HD)
    k_mean = jnp.mean(kb.astype(jnp.float32), axis=3)
    gate = jnp.einsum('bhsd,bhnd->bhsn', q.astype(jnp.float32), k_mean)
    t = np.arange(S)
    past = np.arange(n_blk)[None, :] < (t // MOBA_BLOCK)[:, None]
    n_top = min(MOBA_TOPK, n_blk)
    top_val, top_idx = lax.top_k(jnp.where(past, gate, -SEL_FORCED), n_top)
    top_ok = top_val > -0.5 * SEL_FORCED
    QC = MOBA_QCHUNK
    n_ch = S // QC
    q_ch = q.reshape(B, H, n_ch, QC, HD).transpose(2, 0, 1, 3, 4)
    idx_ch = top_idx.reshape(B, H, n_ch, QC, n_top).transpose(2, 0, 1, 3, 4)
    ok_ch = top_ok.reshape(B, H, n_ch, QC, n_top).transpose(2, 0, 1, 3, 4)
    bi = jnp.arange(B)[:, None, None, None]
    hi = jnp.arange(H)[None, :, None, None]
    n_sel_keys = n_top * MOBA_BLOCK

    def step(args):
        c, qc, ic, okc = args
        kg = kb[bi, hi, ic]
        vg = vb[bi, hi, ic]
        own = (c * QC) // MOBA_BLOCK
        k_own = kb[:, :, own]
        v_own = vb[:, :, own]
        s_sel = jnp.einsum('bhqd,bhqnkd->bhqnk', qc, kg).reshape(B, H, QC, n_sel_keys)
        s_own = jnp.einsum('bhqd,bhkd->bhqk', qc, k_own)
        tq = c * QC + jnp.arange(QC)
        kpos = own * MOBA_BLOCK + jnp.arange(MOBA_BLOCK)
        m_sel = jnp.broadcast_to(okc[..., None], (B, H, QC, n_top, MOBA_BLOCK)).reshape(B, H, QC, n_sel_keys)
        m_own = jnp.broadcast_to(kpos[None, :] <= tq[:, None], (B, H, QC, MOBA_BLOCK))
        p = masked_softmax(jnp.concatenate([s_sel, s_own], axis=-1) * scale,
                           jnp.concatenate([m_sel, m_own], axis=-1)).astype(v.dtype)
        p_sel = p[..., :n_sel_keys].reshape(B, H, QC, n_top, MOBA_BLOCK)
        return (jnp.einsum('bhqnk,bhqnkd->bhqd', p_sel, vg)
                + jnp.einsum('bhqk,bhkd->bhqd', p[..., n_sel_keys:], v_own))

    o = lax.map(step, (jnp.arange(n_ch), q_ch, idx_ch, ok_ch))
    return o.transpose(1, 0, 3, 2, 4).reshape(B, S, MOBA_WIDTH)


def moe_ffn(h, w_router, b_router, w_gate_up, b_gate_up, w_down, b_down):
    B, S, D = h.shape
    T = B * S
    ht = h.reshape(T, D)
    logits = (ht @ w_router + b_router).astype(jnp.float32)
    top_logit, top_e = lax.top_k(logits, TOP_K)
    top_w = jax.nn.softmax(top_logit, axis=-1).astype(h.dtype)
    A = T * TOP_K
    e_flat = top_e.reshape(A)
    tok_flat = jnp.repeat(jnp.arange(T, dtype=jnp.int32), TOP_K)
    w_flat = top_w.reshape(A)
    order = jnp.argsort(e_flat)
    e_s, tok_s, w_s = e_flat[order], tok_flat[order], w_flat[order]
    counts = jnp.bincount(e_flat, length=N_EXPERTS)
    padded = (counts + EXPERT_ROW_BLOCK - 1) // EXPERT_ROW_BLOCK * EXPERT_ROW_BLOCK
    p_end = jnp.cumsum(padded)
    p_start = p_end - padded
    c_start = jnp.cumsum(counts) - counts
    dest = p_start[e_s] + jnp.arange(A, dtype=jnp.int32) - c_start[e_s]
    P = A + N_EXPERTS * EXPERT_ROW_BLOCK
    n_blk = P // EXPERT_ROW_BLOCK
    x_pad = jnp.zeros((P, D), h.dtype).at[dest].set(ht[tok_s])
    blk_expert = jnp.minimum(jnp.searchsorted(p_end, jnp.arange(n_blk) * EXPERT_ROW_BLOCK, side='right'),
                             N_EXPERTS - 1)

    def expert_block(args):
        xb, e = args
        gu = xb @ w_gate_up[e] + b_gate_up[e]
        gate = jnp.minimum(gu[:, :D_FF], SWIGLU_LIMIT)
        lin = jnp.clip(gu[:, D_FF:], -SWIGLU_LIMIT, SWIGLU_LIMIT)
        act = gate * jax.nn.sigmoid(SWIGLU_ALPHA * gate) * (lin + 1.0)
        return act @ w_down[e] + b_down[e]

    y_pad = lax.map(expert_block, (x_pad.reshape(n_blk, EXPERT_ROW_BLOCK, D), blk_expert)).reshape(P, D)
    out = jnp.zeros((T, D), h.dtype).at[tok_s].add(y_pad[dest] * w_s[:, None])
    return out.reshape(B, S, D)


def setup_inputs(seed: int = 0) -> dict:
    key = jax.random.key(seed)
    ks = jax.random.split(key, 22)
    f32 = jnp.float32
    L = DEPTH

    def nrm(k, shape, scale):
        return jax.random.normal(k, shape, f32) * scale

    return {
        "x": nrm(ks[0], (BATCH, SEQ, D_MODEL), 1.0),
        "positions": jnp.broadcast_to(jnp.arange(SEQ, dtype=jnp.int32), (BATCH, SEQ)),
        "g_attn_norm": 1.0 + nrm(ks[1], (L, D_MODEL), 0.02),
        "w_in": nrm(ks[2], (L, D_MODEL, IN_WIDTH), D_MODEL ** -0.5),
        "pe_cmp_k": nrm(ks[3], (L, CMP_BLOCK, HEAD_DIM), 0.02),
        "w_cmp_k1": nrm(ks[4], (L, CMP_BLOCK * HEAD_DIM, CMP_HIDDEN), (CMP_BLOCK * HEAD_DIM) ** -0.5),
        "w_cmp_k2": nrm(ks[5], (L, CMP_HIDDEN, HEAD_DIM), CMP_HIDDEN ** -0.5),
        "pe_cmp_v": nrm(ks[6], (L, CMP_BLOCK, HEAD_DIM), 0.02),
        "w_cmp_v1": nrm(ks[7], (L, CMP_BLOCK * HEAD_DIM, CMP_HIDDEN), (CMP_BLOCK * HEAD_DIM) ** -0.5),
        "w_cmp_v2": nrm(ks[8], (L, CMP_HIDDEN, HEAD_DIM), CMP_HIDDEN ** -0.5),
        "w_proj_nsa": nrm(ks[9], (L, NSA_WIDTH, D_MODEL), NSA_WIDTH ** -0.5),
        "w_proj_moba": nrm(ks[10], (L, MOBA_WIDTH, D_MODEL), MOBA_WIDTH ** -0.5),
        "w_out": nrm(ks[11], (L, D_MODEL, D_MODEL), D_MODEL ** -0.5),
        "g_ffn_norm": 1.0 + nrm(ks[12], (L, D_MODEL), 0.02),
        "w_router": nrm(ks[13], (L, D_MODEL, N_EXPERTS), D_MODEL ** -0.5),
        "b_router": nrm(ks[14], (L, N_EXPERTS), 0.01),
        "w_gate_up": nrm(ks[15], (L, N_EXPERTS, D_MODEL, 2 * D_FF), D_MODEL ** -0.5),
        "b_gate_up": nrm(ks[16], (L, N_EXPERTS, 2 * D_FF), 0.01),
        "w_down": nrm(ks[17], (L, N_EXPERTS, D_FF, D_MODEL), D_FF ** -0.5),
        "b_down": nrm(ks[18], (L, N_EXPERTS, D_MODEL), 0.01),
        "g_final_norm": 1.0 + nrm(ks[19], (D_MODEL,), 0.02),
    }


def reference(x, positions, g_attn_norm, w_in, pe_cmp_k, w_cmp_k1, w_cmp_k2, pe_cmp_v, w_cmp_v1, w_cmp_v2,
              w_proj_nsa, w_proj_moba, w_out, g_ffn_norm, w_router, b_router, w_gate_up, b_gate_up,
              w_down, b_down, g_final_norm):
    B, S, D = x.shape
    split_at = np.cumsum(IN_SPLITS)[:-1]
    for layer in range(DEPTH):
        h = rms_norm(x, g_attn_norm[layer])
        proj = h @ w_in[layer]
        q_a, kv_a, g_nsa, qkv_b, g_merge = jnp.split(proj, split_at, axis=-1)
        q_a = rope_partial(q_a.reshape(B, S, NSA_HEADS, HEAD_DIM), positions)
        kv_a = kv_a.reshape(B, S, 6, NSA_GROUPS, HEAD_DIM)
        o_a = nsa_mixer(q_a, kv_a[:, :, 0], kv_a[:, :, 1],
                        rope_partial(kv_a[:, :, 2], positions), kv_a[:, :, 3],
                        rope_partial(kv_a[:, :, 4], positions), kv_a[:, :, 5],
                        g_nsa, positions,
                        pe_cmp_k[layer], w_cmp_k1[layer], w_cmp_k2[layer],
                        pe_cmp_v[layer], w_cmp_v1[layer], w_cmp_v2[layer])
        qkv_b = qkv_b.reshape(B, S, 3, MOBA_HEADS, HEAD_DIM)
        o_b = moba_mixer(rope_partial(qkv_b[:, :, 0], positions),
                         rope_partial(qkv_b[:, :, 1], positions), qkv_b[:, :, 2])
        gm = jax.nn.sigmoid(g_merge.astype(jnp.float32)).astype(x.dtype).reshape(B, S, 2, D)
        mix = gm[:, :, 0] * (o_a @ w_proj_nsa[layer]) + gm[:, :, 1] * (o_b @ w_proj_moba[layer])
        x = x + mix @ w_out[layer]
        h = rms_norm(x, g_ffn_norm[layer])
        x = x + moe_ffn(h, w_router[layer], b_router[layer], w_gate_up[layer], b_gate_up[layer],
                        w_down[layer], b_down[layer])
    return rms_norm(x, g_final_norm)
```

```cpp
#include <hip/hip_runtime.h>
#include <stdint.h>
namespace fk {
#define LAS __attribute__((address_space(3)))
#define GAS __attribute__((address_space(1)))
typedef unsigned short bf16;
typedef unsigned long long u64;
typedef short bf16x8 __attribute__((ext_vector_type(8)));
typedef float f32x4 __attribute__((ext_vector_type(4)));
typedef float f32x16 __attribute__((ext_vector_type(16)));
typedef unsigned u32x4 __attribute__((ext_vector_type(4)));
typedef unsigned u32x2 __attribute__((ext_vector_type(2)));
typedef float f32x2_t __attribute__((ext_vector_type(2)));
typedef __bf16 bf16x2_t __attribute__((ext_vector_type(2)));

constexpr int D = 2048, NB = 4, S = 4096, T = NB * S, HD = 128, NE = 32, FF = 2048, INW = 9752;
constexpr int NTHREADS = 512, NWAVES = 8;

__device__ __forceinline__ unsigned pk2(float lo, float hi) { f32x2_t v = {lo, hi}; bf16x2_t b = __builtin_convertvector(v, bf16x2_t); return __builtin_bit_cast(unsigned, b); }
__device__ __forceinline__ float bf2f(unsigned short b) { return __builtin_bit_cast(float, (unsigned)b << 16); }
__device__ __forceinline__ float wave_sum(float v) {
#pragma unroll
    for (int o = 1; o < 64; o <<= 1) v += __shfl_xor(v, o);
    return v;
}
__device__ __forceinline__ float sigmoid_f(float x) { return 1.0f / (1.0f + __expf(-x)); }

#define XB_TMO      128
#define XB_XCNT(j)  (256  + 64 * (j))
#define XB_XSUB(j)  (1280 + 64 * (j))
#define XB_XGEN(j)  (2304 + 64 * (j))
#define XB_TOP      3328
#define XB_TOPGEN   3392
#define XCD_BAR_WORDS 3456
#define XB_SPIN_CAP (1u << 18)
__device__ __forceinline__ unsigned xb_ld(unsigned* p)              { return __hip_atomic_load(p, __ATOMIC_RELAXED, __HIP_MEMORY_SCOPE_AGENT); }
__device__ __forceinline__ unsigned xb_add(unsigned* p, unsigned v) { return __hip_atomic_fetch_add(p, v, __ATOMIC_RELAXED, __HIP_MEMORY_SCOPE_AGENT); }
__device__ __forceinline__ unsigned xb_xcc_id() { return (unsigned)__builtin_amdgcn_s_getreg((3 << 11) | 20) & 0xFu; }
#define XB_SPIN(cond, bar) do { unsigned _sp = 0; while (cond) { __builtin_amdgcn_s_sleep(1); \
    if ((++_sp & 255u) == 0u) { if (xb_ld(&(bar)[XB_TMO])) break; if (_sp > XB_SPIN_CAP) { atomicAdd(&(bar)[XB_TMO], 1u); break; } } } } while (0)
struct XcdBarrier { unsigned* bar; unsigned x; volatile LAS unsigned* st; };
__device__ __forceinline__ XcdBarrier xcd_barrier_post(unsigned* bar, volatile LAS unsigned* st) {
    XcdBarrier b; b.bar = bar; b.x = xb_xcc_id(); b.st = st;
    if (threadIdx.x == 0) (void)xb_add(&bar[XB_XCNT(b.x)], 1u);
    return b;
}
__device__ __forceinline__ void xcd_barrier_complete(unsigned* bar, unsigned x, unsigned& nloc, unsigned& nx) {
    const unsigned G = gridDim.x * gridDim.y * gridDim.z;
    unsigned sum, cnt, mine, sp = 0u;
    for (;;) {
        sum = 0u; cnt = 0u; mine = 0u;
#pragma unroll
        for (unsigned j = 0; j < 16; ++j) { const unsigned c = xb_ld(&bar[XB_XCNT(j)]); sum += c; cnt += (c > 0u) ? 1u : 0u; mine = (j == x) ? c : mine; }
        if (sum == G) break;
        __builtin_amdgcn_s_sleep(1);
        if ((++sp & 255u) == 0u) { if (xb_ld(&bar[XB_TMO])) break; if (sp > XB_SPIN_CAP) { atomicAdd(&bar[XB_TMO], 1u); break; } }
    }
    nloc = mine > 0u ? mine : 1u; nx = cnt > 0u ? cnt : 1u;
}
__device__ __forceinline__ void xcd_barrier(const XcdBarrier& b) {
    asm volatile("s_waitcnt vmcnt(0)" ::: "memory");
    __syncthreads();
    if (threadIdx.x == 0) {
        unsigned* bar = b.bar;
        __builtin_amdgcn_s_waitcnt(0);
        unsigned nloc = b.st[0], nx = b.st[1];
        if (nloc == 0u) { xcd_barrier_complete(bar, b.x, nloc, nx); b.st[0] = nloc; b.st[1] = nx; }
        const unsigned old = xb_add(&bar[XB_XSUB(b.x)], 1u);
        const unsigned gen = old / nloc;
        if (old + 1u == (gen + 1u) * nloc) {
            __builtin_amdgcn_fence(__ATOMIC_RELEASE, "agent");
            asm volatile("s_waitcnt vmcnt(0)" ::: "memory");
            const unsigned og = xb_add(&bar[XB_TOP], 1u);
            const unsigned tg = og / nx;
            if (og + 1u == (tg + 1u) * nx) xb_add(&bar[XB_TOPGEN], 1u);
            else XB_SPIN(xb_ld(&bar[XB_TOPGEN]) == tg, bar);
            __builtin_amdgcn_fence(__ATOMIC_ACQUIRE, "agent");
            xb_add(&bar[XB_XGEN(b.x)], 1u);
            asm volatile("s_waitcnt vmcnt(0)" ::: "memory");
        } else {
            XB_SPIN(xb_ld(&bar[XB_XGEN(b.x)]) == gen, bar);
            __builtin_amdgcn_fence(__ATOMIC_ACQUIRE, "agent");
            asm volatile("s_waitcnt vmcnt(0)" ::: "memory");
        }
    }
    __syncthreads();
}

constexpr int BM = 256, BK = 64, HALF = 128, HTB = HALF * BK * 2, STAGE_BYTES = 8 * HTB, NXCD = 8, WGM = 8;
__host__ __device__ __forceinline__ int lds_byte(int r, int c) { const int st = (r >> 4) * 2 + (c >> 5), rr = r & 15, cc = c & 31, ob = rr * 64 + cc * 2; return st * 1024 + (ob ^ (((ob >> 9) & 1) << 5)); }
__host__ __device__ __forceinline__ void stage_rc(int b, int& R, int& C) { const int st = b / 1024, sb = b % 1024, swz = sb ^ (((sb >> 9) & 1) << 5); R = (st >> 1) * 16 + swz / 64; C = (st & 1) * 32 + (swz % 64) / 2; }
__host__ __device__ __forceinline__ int perm32(int rho) { const int n = rho >> 4, i = rho & 15; return 8 * (i >> 2) + 4 * n + (i & 3); }

struct Unit { const char* a; const char* b; int pm, pn, kind; };
struct Gemm { int K, lda, ldb; };
__device__ __forceinline__ void tile_map(int L, int nM, int nN, int& pm, int& pn) {
    const int nwg = nM * nN; int wgid = L;
    { const int q = nwg / NXCD, r = nwg % NXCD, xcd = wgid % NXCD, off = wgid / NXCD; wgid = (xcd < r ? xcd * (q + 1) : r * (q + 1) + (xcd - r) * q) + off; }
    const int nig = WGM * nN, gid = wgid / nig, fm = gid * WGM, gsz = (nM - fm) < WGM ? (nM - fm) : WGM;
    pm = fm + ((wgid % nig) % gsz); pn = (wgid % nig) / gsz;
}
template <class Epi, class Sched>
__device__ __forceinline__ void gemm_phase(LAS unsigned char* lds, const Gemm g, const Sched& S, const Epi& E) {
    const int tid = threadIdx.x, wid = __builtin_amdgcn_readfirstlane(tid >> 6), lane = tid & 63, wr = wid >> 2, wc = wid & 3, fr = lane & 15, fq = lane >> 4;
    const int K = g.K, nt = K / BK;
    unsigned voffA[2], voffB[2];
#pragma unroll
    for (int i = 0; i < 2; ++i) { int R, C; stage_rc(tid * 16 + i * 8192, R, C); const int Rb = Epi::PERM ? ((R & ~31) + perm32(R & 31)) : R;
        voffA[i] = (unsigned)(R * g.lda + C) * 2u; voffB[i] = (unsigned)(Rb * g.ldb + C) * 2u; }
    const size_t kstep = (size_t)(BK * 2);
    const size_t hstepA = (size_t)HALF * g.lda * 2, hstepB = (size_t)HALF * g.ldb * 2;
    const unsigned ldsw = (unsigned)wid * 1024u;
    const int aoff = lds_byte(wr * 64 + fr, fq * 8), boff = lds_byte(wc * 32 + fr, fq * 8);
#define PG8_SA(b, h) (((b) * 2 + (h)) * HTB)
#define PG8_SB(b, h) ((4 + (b) * 2 + (h)) * HTB)
#define PG8_STAGE(bufoff, gbase, voff) do { _Pragma("unroll") for (int _i = 0; _i < 2; ++_i) \
        __builtin_amdgcn_global_load_lds((const unsigned*)((const char*)(gbase) + (voff)[_i]), (LAS unsigned*)(lds + (bufoff) + ldsw + _i * 8192), 16, 0, 0); } while (0)
#define PG8_LDA(dst, b, h) do { _Pragma("unroll") for (int m = 0; m < 4; ++m) _Pragma("unroll") for (int k = 0; k < 2; ++k) dst[m][k] = *(const LAS bf16x8*)(lds + PG8_SA(b, h) + aoff + m * 2048 + k * 1024); } while (0)
#define PG8_LDB(dst, b, h) do { _Pragma("unroll") for (int n = 0; n < 2; ++n) _Pragma("unroll") for (int k = 0; k < 2; ++k) dst[n][k] = *(const LAS bf16x8*)(lds + PG8_SB(b, h) + boff + n * 2048 + k * 1024); } while (0)
#define PG8_MMA(ai, bj, At, Bt) do { __builtin_amdgcn_s_setprio(1); _Pragma("unroll") for (int m = 0; m < 4; ++m) _Pragma("unroll") for (int n = 0; n < 2; ++n) _Pragma("unroll") for (int k = 0; k < 2; ++k) \
        acc[ai][bj][m][n] = __builtin_amdgcn_mfma_f32_16x16x32_bf16(Bt[n][k], At[m][k], acc[ai][bj][m][n], 0, 0, 0); __builtin_amdgcn_s_setprio(0); } while (0)
#define PG8_WAIT_V(n) asm volatile("s_waitcnt vmcnt(" #n ")" ::: "memory")
#define PG8_WAIT_L(n) asm volatile("s_waitcnt lgkmcnt(" #n ")" ::: "memory")
#define PG8_BAR __builtin_amdgcn_s_barrier()
#define PG8_SCHED __builtin_amdgcn_sched_barrier(0)
    Unit cur, nxt; int ui = 0;
    if (!S.next(0, cur)) return;
    f32x4 acc[2][2][4][2];
#pragma unroll
    for (int a = 0; a < 2; ++a)
#pragma unroll
        for (int b = 0; b < 2; ++b)
#pragma unroll
            for (int m = 0; m < 4; ++m)
#pragma unroll
                for (int n = 0; n < 2; ++n) acc[a][b][m][n] = (f32x4){0.f, 0.f, 0.f, 0.f};
    bf16x8 At[4][2], B0[2][2], B1[2][2];
    const char* cA = cur.a; const char* cB = cur.b;
    {
        PG8_STAGE(PG8_SB(0, 0), cB, voffB); PG8_STAGE(PG8_SB(0, 1), cB + hstepB, voffB); PG8_STAGE(PG8_SA(0, 0), cA, voffA); PG8_STAGE(PG8_SA(0, 1), cA + hstepA, voffA);
        if (wr == 1) PG8_BAR;
        PG8_WAIT_V(2); PG8_BAR;
        PG8_STAGE(PG8_SB(1, 0), cB + kstep, voffB); PG8_STAGE(PG8_SA(1, 0), cA + kstep, voffA); PG8_STAGE(PG8_SB(1, 1), cB + hstepB + kstep, voffB);
        PG8_WAIT_V(6); PG8_BAR;
    }
    for (;;) {
        const bool has_next = S.next(ui + 1, nxt);
        const char* nA = has_next ? nxt.a : cA; const char* nB = has_next ? nxt.b : cB;
        for (int t = 0; t < nt; t += 2) {
            const bool last = (t == nt - 2);
            const char* a1 = cA + (size_t)(t + 1) * kstep;
            const char* a2 = last ? nA : cA + (size_t)(t + 2) * kstep; const char* b2 = last ? nB : cB + (size_t)(t + 2) * kstep;
            const char* a3 = a2 + kstep; const char* b3 = b2 + kstep;
            PG8_LDB(B0, 0, 0); PG8_LDB(B1, 0, 1); PG8_SCHED; PG8_LDA(At, 0, 0); PG8_STAGE(PG8_SA(1, 1), a1 + hstepA, voffA);
            PG8_WAIT_V(8); PG8_WAIT_L(0); PG8_BAR; PG8_MMA(0, 0, At, B0); PG8_MMA(0, 1, At, B1); PG8_BAR; PG8_SCHED;
            PG8_LDA(At, 0, 1); PG8_STAGE(PG8_SB(0, 0), b2, voffB); PG8_STAGE(PG8_SB(0, 1), b2 + hstepB, voffB); PG8_STAGE(PG8_SA(0, 0), a2, voffA);
            PG8_WAIT_V(8); PG8_WAIT_L(0); PG8_BAR; PG8_MMA(1, 0, At, B0); PG8_MMA(1, 1, At, B1); PG8_BAR; PG8_SCHED;
            PG8_LDB(B0, 1, 0); PG8_LDB(B1, 1, 1); PG8_SCHED; PG8_LDA(At, 1, 0); PG8_STAGE(PG8_SA(0, 1), a2 + hstepA, voffA);
            PG8_WAIT_V(8); PG8_WAIT_L(0); PG8_BAR; PG8_MMA(0, 0, At, B0); PG8_MMA(0, 1, At, B1); PG8_BAR; PG8_SCHED;
            PG8_LDA(At, 1, 1); PG8_STAGE(PG8_SB(1, 0), b3, voffB); PG8_STAGE(PG8_SB(1, 1), b3 + hstepB, voffB); PG8_STAGE(PG8_SA(1, 0), a3, voffA);
            PG8_WAIT_V(8); PG8_WAIT_L(0); PG8_BAR; PG8_MMA(1, 0, At, B0); PG8_MMA(1, 1, At, B1); PG8_BAR; PG8_SCHED;
        }
        if (wr == 0) PG8_BAR;
        E(acc, cur, wr, wc, fr, fq);
        if (!has_next) break;
#pragma unroll
        for (int a = 0; a < 2; ++a)
#pragma unroll
            for (int b = 0; b < 2; ++b)
#pragma unroll
                for (int m = 0; m < 4; ++m)
#pragma unroll
                    for (int n = 0; n < 2; ++n) acc[a][b][m][n] = (f32x4){0.f, 0.f, 0.f, 0.f};
        cur = nxt; cA = nA; cB = nB; ++ui;
        if (wr == 1) PG8_BAR;
    }
    PG8_WAIT_V(0);
    PG8_BAR;
#undef PG8_SA
#undef PG8_SB
#undef PG8_STAGE
#undef PG8_LDA
#undef PG8_LDB
#undef PG8_MMA
#undef PG8_WAIT_V
#undef PG8_WAIT_L
#undef PG8_BAR
#undef PG8_SCHED
}

constexpr size_t al256(size_t x) { return (x + 255) & ~(size_t)255; }
constexpr int PMAX = T * 4 + NE * 256;
constexpr size_t WS_CTL = 0, CTL_BYTES = 1u << 20;
constexpr size_t WS_WIN_T  = CTL_BYTES;
constexpr size_t WS_WK1_T  = WS_WIN_T + al256((size_t)9984 * 2048 * 2);
constexpr size_t WS_WV1_T  = WS_WK1_T + al256((size_t)256 * 4096 * 2);
constexpr size_t WS_WPN_T  = WS_WV1_T + al256((size_t)256 * 4096 * 2);
constexpr size_t WS_WPM_T  = WS_WPN_T + al256((size_t)2048 * 1024 * 2);
constexpr size_t WS_WOUT_T = WS_WPM_T + al256((size_t)2048 * 1024 * 2);
constexpr size_t WS_WGU_T  = WS_WOUT_T + al256((size_t)2048 * 2048 * 2);
constexpr size_t WS_WDN_T  = WS_WGU_T + al256((size_t)NE * 4096 * 2048 * 2);
constexpr size_t WS_H      = WS_WDN_T + al256((size_t)NE * 2048 * 2048 * 2);
constexpr size_t WS_X1     = WS_H + al256((size_t)T * D * 2);
constexpr size_t WS_SELE   = WS_X1 + al256((size_t)T * D * 4);
constexpr size_t WS_SELW   = WS_SELE + al256((size_t)T * 4 * 4);
constexpr size_t WS_SELP   = WS_SELW + al256((size_t)T * 4 * 4);
constexpr size_t WS_ROWDST = WS_SELP + al256((size_t)T * 4 * 4);
constexpr size_t WS_ROWW   = WS_ROWDST + al256((size_t)PMAX * 4);
constexpr size_t WS_U0     = WS_ROWW + al256((size_t)PMAX * 4);
constexpr size_t WS_QN     = WS_U0;
constexpr size_t HB2 = al256((size_t)T * 2 * HD * 2 + 65536);
constexpr size_t HB8 = al256((size_t)T * 8 * HD * 2);
constexpr size_t WS_KCMP   = WS_QN + HB8;
constexpr size_t WS_VCMP   = WS_KCMP + HB2;
constexpr size_t WS_KSLC   = WS_VCMP + HB2;
constexpr size_t WS_KWIN   = WS_KSLC + HB2;
constexpr size_t WS_VSLC   = WS_KWIN + HB2;
constexpr size_t WS_VWIN   = WS_VSLC + HB2;
constexpr size_t WS_MQ     = WS_VWIN + HB2;
constexpr size_t WS_MK     = WS_MQ + HB8;
constexpr size_t WS_MV     = WS_MK + HB8;
constexpr size_t WS_GN     = WS_MV + HB8;
constexpr size_t WS_GM     = WS_GN + al256((size_t)T * 24 * 4);
constexpr size_t WS_CS     = WS_GM + al256((size_t)T * 4096 * 2);
constexpr size_t WS_HIDP   = WS_CS + al256((size_t)T * 32 * 4);
constexpr size_t WS_PEB    = WS_HIDP + al256((size_t)2 * 4 * 2048 * 256 * 4);
constexpr size_t WS_KC     = WS_PEB + al256(2 * 256 * 4);
constexpr size_t WS_VC     = WS_KC + al256((size_t)8 * 4 * 8192 * 2);
constexpr size_t WS_KMEAN  = WS_VC + al256((size_t)8 * 4 * 8192 * 2);
constexpr size_t WS_MSEL   = WS_KMEAN + al256((size_t)NB * 8 * 16 * HD * 4);
constexpr size_t WS_MMOBA  = WS_MSEL + al256((size_t)NB * 2 * S * 8);
constexpr size_t WS_OCMP   = WS_MMOBA + al256((size_t)NB * 8 * S * 8);
constexpr size_t WS_OWIN   = WS_OCMP + al256((size_t)T * 1024 * 4);
constexpr size_t WS_OA     = WS_OWIN + al256((size_t)T * 1024 * 4);
constexpr size_t WS_OB     = WS_OA + al256((size_t)T * 1024 * 2);
constexpr size_t WS_MIXP   = WS_OB + al256((size_t)T * 1024 * 2);
constexpr size_t WS_MIX    = WS_MIXP + al256((size_t)T * D * 4);
constexpr size_t WS_ATT_END = WS_MIX + al256((size_t)T * D * 2);
constexpr size_t WS_XPAD   = WS_U0;
constexpr size_t WS_ACT    = WS_XPAD + al256((size_t)PMAX * D * 2);
constexpr size_t WS_YS     = WS_ACT + al256((size_t)PMAX * FF * 2);
constexpr size_t WS_MOE_END = WS_YS + al256((size_t)T * 4 * D * 2);
constexpr size_t WS_END    = WS_ATT_END > WS_MOE_END ? WS_ATT_END : WS_MOE_END;
constexpr int CW_BAR = 4096;
constexpr int CW_CNT = 16384;
constexpr int CW_Q   = 16384 + 64;
constexpr int RING_BYTES = 131072, MISC_OFF = 131072, LDS_BYTES = 147456;

struct Args { const float* in[21]; float* out; unsigned char* ws; int ph_lo, ph_hi; };

template <class RowMap>
__device__ __forceinline__ void transpose_item(const float* __restrict__ W, int K, int N, bf16* WT, const RowMap& rm, LAS float* scr, int item, int lane) {
    const int nblk = (N + 31) / 32, kb = item / nblk, nb = item % nblk, k0 = 64 * kb, n0 = 32 * nb;
    const bool cok = (n0 + (lane & 31)) < N;
#pragma unroll 8
    for (int i = 0; i < 32; ++i) { const int kk = 2 * i + (lane >> 5); scr[kk * 33 + (lane & 31)] = cok ? W[(size_t)(k0 + kk) * N + n0 + (lane & 31)] : 0.f; }
    asm volatile("s_waitcnt lgkmcnt(0)" ::: "memory");
    const int c = lane & 7;
#pragma unroll
    for (int j = 0; j < 4; ++j) { const int n = (lane >> 3) + 8 * j; const LAS float* s = scr + (8 * c) * 33 + n;
        u32x4 o; o.x = pk2(s[0 * 33], s[1 * 33]); o.y = pk2(s[2 * 33], s[3 * 33]); o.z = pk2(s[4 * 33], s[5 * 33]); o.w = pk2(s[6 * 33], s[7 * 33]);
        const long dr = (n0 + n) < N ? rm(n0 + n) : -1;
        if (dr >= 0) *(u32x4*)(WT + (size_t)dr * K + k0 + 8 * c) = o; }
    asm volatile("s_waitcnt lgkmcnt(0)" ::: "memory");
}
struct RmIdent { long off; __device__ long operator()(int n) const { return off + n; } };
struct RmWin { __device__ long operator()(int n) const {
    if (n < 1024) return n;
    if (n < 2560) { const int c = n - 1024, which = c >> 8, r = c & 255;
        return which == 0 ? 1024 + r : which == 1 ? 1280 + r : which == 2 ? 1536 + r : which == 3 ? 8448 + r : which == 4 ? 1792 + r : 8448 + 256 + r; }
    if (n < 2584) return 8192 + (n - 2560);
    if (n < 5656) { const int c = n - 2584, which = c >> 10, r = c & 1023; return which == 0 ? 2048 + r : which == 1 ? 3072 + r : 8448 + 512 + r; }
    return 4096 + (n - 5656); } };
struct RmGu { long off; __device__ long operator()(int n) const { const int lin = n >= FF, j = lin ? n - FF : n; return off + (j >> 7) * 256 + lin * 128 + (j & 127); } };

struct EpiIn {
    static constexpr bool PERM = true;
    unsigned char* ws; const float* cs;
    __device__ __forceinline__ void operator()(const f32x4 (&acc)[2][2][4][2], const Unit& u, int wr, int wc, int fr, int fq) const {
        const int lane = threadIdx.x & 63;
        if (u.kind == 0) {
            const int pn = u.pn, tok0 = u.pm * 256;
            const bool is_rope = (pn < 4) || pn == 6 || pn == 7 || (pn >= 8 && pn < 16);
#pragma unroll
            for (int ai = 0; ai < 2; ++ai)
#pragma unroll
                for (int m = 0; m < 4; ++m) {
                    const int t = tok0 + ai * 128 + wr * 64 + m * 16 + fr, b = t >> 12, s = t & (S - 1);
#pragma unroll
                    for (int bj = 0; bj < 2; ++bj) {
                        f32x4 v0 = acc[ai][bj][m][0], v1 = acc[ai][bj][m][1];
                        if (pn < 16) {
                            if (is_rope && wc == 0) {
                                f32x4 p0, p1;
#pragma unroll
                                for (int i = 0; i < 4; ++i) { p0[i] = __shfl_xor(v0[i], 32); p1[i] = __shfl_xor(v1[i], 32); }
                                const float* cst = cs + (size_t)t * 32 + 8 * (fq & 1);
                                const f32x4 c0 = *(const f32x4*)cst, c1 = *(const f32x4*)(cst + 4), s0 = *(const f32x4*)(cst + 16), s1 = *(const f32x4*)(cst + 20);
                                if (fq < 2) { v0 = v0 * c0 - p0 * s0; v1 = v1 * c1 - p1 * s1; }
                                else        { v0 = v0 * c0 + p0 * s0; v1 = v1 * c1 + p1 * s1; }
                            }
                            u32x4 w; w.x = pk2(v0[0], v0[1]); w.y = pk2(v0[2], v0[3]); w.z = pk2(v1[0], v1[1]); w.w = pk2(v1[2], v1[3]);
                            const int piece = 4 * wc + fq;
                            size_t off;
                            bf16* dst;
                            if (pn < 4) { dst = (bf16*)(ws + WS_QN); off = (((size_t)b * 8 + 2 * pn + bj) * S + s) * HD + piece * 8; }
                            else if (pn == 4) { dst = (bf16*)(ws + WS_KCMP); off = (((size_t)b * 2 + bj) * S + s) * HD + piece * 8; }
                            else if (pn == 5) { dst = (bf16*)(ws + WS_VCMP); off = (((size_t)b * 2 + bj) * S + s) * HD + piece * 8; }
                            else if (pn < 8) { dst = (bf16*)(ws + (pn == 6 ? WS_KSLC : WS_KWIN)); off = (((size_t)b * 2 + bj) * S + s) * HD + ((piece ^ (s & 15)) * 8); }
                            else if (pn < 12) { dst = (bf16*)(ws + WS_MQ); off = (((size_t)b * 8 + 2 * (pn - 8) + bj) * S + s) * HD + piece * 8; }
                            else { dst = (bf16*)(ws + WS_MK); off = (((size_t)b * 8 + 2 * (pn - 12) + bj) * S + s) * HD + ((piece ^ (s & 15)) * 8); }
                            *(u32x4*)(dst + off) = w;
                        } else if (pn < 32) {
#pragma unroll
                            for (int i = 0; i < 4; ++i) { v0[i] = sigmoid_f(v0[i]); v1[i] = sigmoid_f(v1[i]); }
                            u32x4 w; w.x = pk2(v0[0], v0[1]); w.y = pk2(v0[2], v0[3]); w.z = pk2(v1[0], v1[1]); w.w = pk2(v1[2], v1[3]);
                            *(u32x4*)((bf16*)(ws + WS_GM) + (size_t)t * 4096 + (pn - 16) * 256 + bj * 128 + wc * 32 + fq * 8) = w;
                        } else {
                            if (bj == 0 && wc == 0 && fq < 3) {
#pragma unroll
                                for (int i = 0; i < 4; ++i) { v0[i] = sigmoid_f(v0[i]); v1[i] = sigmoid_f(v1[i]); }
                                float* gp = (float*)(ws + WS_GN) + (size_t)t * 24 + fq * 8;
                                *(f32x4*)gp = v0; *(f32x4*)(gp + 4) = v1;
                            }
                        }
                    }
                }
        } else {
            const int j = u.pm, tok0 = u.pn * 256;
#pragma unroll
            for (int ai = 0; ai < 2; ++ai) {
                bf16* dst; int nh, head;
                if (j == 0) { dst = (bf16*)(ws + WS_VSLC); nh = 2; head = ai; } else if (j == 1) { dst = (bf16*)(ws + WS_VWIN); nh = 2; head = ai; } else { dst = (bf16*)(ws + WS_MV); nh = 8; head = 2 * (j - 2) + ai; }
#pragma unroll
                for (int m = 0; m < 4; ++m) {
                    const int d = wr * 64 + m * 16 + fr;
#pragma unroll
                    for (int bj = 0; bj < 2; ++bj) {
                        const int t = tok0 + bj * 128 + wc * 32 + fq * 8, b = t >> 12, s = t & (S - 1);
                        const f32x4 v0 = acc[ai][bj][m][0], v1 = acc[ai][bj][m][1];
                        bf16* tp = dst + ((size_t)b * nh + head) * S * HD + (size_t)(s >> 6) * 8192 + (((s & 63) >> 2) * 128 + d) * 4;
                        u32x2 q0, q1; q0.x = pk2(v0[0], v0[1]); q0.y = pk2(v0[2], v0[3]); q1.x = pk2(v1[0], v1[1]); q1.y = pk2(v1[2], v1[3]);
                        *(u32x2*)tp = q0; *(u32x2*)(tp + 512) = q1;
                    }
                }
            }
        }
    }
};
struct SchedIn {
    int G, c; const char* Hp; const char* Wp;
    __device__ __forceinline__ bool next(int i, Unit& u) const {
        int L = i * G + c; constexpr size_t ts = (size_t)256 * 2048 * 2;
        if (L < 64 * 33) { tile_map(L, 64, 33, u.pm, u.pn); u.a = Hp + u.pm * ts; u.b = Wp + u.pn * ts; u.kind = 0; return true; }
        L -= 64 * 33;
        if (L < 6 * 64) { tile_map(L, 6, 64, u.pm, u.pn); u.a = Wp + (33 + u.pm) * ts; u.b = Hp + u.pn * ts; u.kind = 1; return true; }
        return false;
    }
};

#define ATT_C 0.12751743074602194f
#define ATT_MFMA(a, b, c) __builtin_amdgcn_mfma_f32_32x32x16_bf16((a), (b), (c), 0, 0, 0)
#define ATT_DMA(j, buf) do { const char* _kp = (const char*)kt + (size_t)(j) * 16384 + so; const char* _vp = (const char*)vt + (size_t)(j) * 16384 + so; \
    __builtin_amdgcn_global_load_lds((const unsigned*)_kp, (LAS unsigned*)(lds + (buf) * 16384 + wbase), 16, 0, 0); \
    __builtin_amdgcn_global_load_lds((const unsigned*)(_kp + 8192), (LAS unsigned*)(lds + (buf) * 16384 + 8192 + wbase), 16, 0, 0); \
    __builtin_amdgcn_global_load_lds((const unsigned*)_vp, (LAS unsigned*)(lds + 32768 + (buf) * 16384 + wbase), 16, 0, 0); \
    __builtin_amdgcn_global_load_lds((const unsigned*)(_vp + 8192), (LAS unsigned*)(lds + 32768 + (buf) * 16384 + 8192 + wbase), 16, 0, 0); } while (0)
#define ATT_SYNC() do { asm volatile("s_waitcnt vmcnt(0)" ::: "memory"); __syncthreads(); } while (0)
#define ATT_QK(buf) do { _Pragma("unroll") for (int _kh = 0; _kh < 2; ++_kh) { _Pragma("unroll") for (int _r = 0; _r < 16; ++_r) sacc[_kh][_r] = 0.f; \
    _Pragma("unroll") for (int _s = 0; _s < 8; ++_s) { const bf16x8 _a = *(const LAS bf16x8*)(lds + (buf) * 16384 + _kh * 8192 + kbase_l + (((2 * _s) ^ kx) << 4)); \
        sacc[_kh] = ATT_MFMA(_a, qf[_s], sacc[_kh]); } } } while (0)
#define ATT_MASK(lo_rel, hi_rel, bit) do { const bool _none = !(bit) || (hi_rel) < 0 || (lo_rel) > 63; const bool _full = (bit) && (lo_rel) <= 0 && (hi_rel) >= 63; \
    if (__all(_none || _full)) { const float _bias = _none ? -INFINITY : 0.f; \
        _Pragma("unroll") for (int _kh = 0; _kh < 2; ++_kh) _Pragma("unroll") for (int _r = 0; _r < 16; ++_r) sacc[_kh][_r] = __builtin_fmaf(sacc[_kh][_r], ATT_C, _bias); } \
    else { _Pragma("unroll") for (int _kh = 0; _kh < 2; ++_kh) _Pragma("unroll") for (int _r = 0; _r < 16; ++_r) { const int _k = 32 * _kh + (_r & 3) + 8 * (_r >> 2) + 4 * h; \
        const bool _ok = (bit) && _k >= (lo_rel) && _k <= (hi_rel); sacc[_kh][_r] = _ok ? sacc[_kh][_r] * ATT_C : -INFINITY; } } } while (0)
#define ATT_TILEMAX(mt) do { float _m = sacc[0][0]; _Pragma("unroll") for (int _r = 1; _r < 16; ++_r) _m = fmaxf(_m, sacc[0][_r]); \
    _Pragma("unroll") for (int _r = 0; _r < 16; ++_r) _m = fmaxf(_m, sacc[1][_r]); mt = fmaxf(_m, __shfl_xor(_m, 32)); } while (0)
#define ATT_PV(buf) do { _Pragma("unroll") for (int _kh = 0; _kh < 2; ++_kh) _Pragma("unroll") for (int _s = 0; _s < 2; ++_s) { \
    u32x4 _p; _p.x = pk2(sacc[_kh][8 * _s + 0], sacc[_kh][8 * _s + 1]); _p.y = pk2(sacc[_kh][8 * _s + 2], sacc[_kh][8 * _s + 3]); \
    _p.z = pk2(sacc[_kh][8 * _s + 4], sacc[_kh][8 * _s + 5]); _p.w = pk2(sacc[_kh][8 * _s + 6], sacc[_kh][8 * _s + 7]); const bf16x8 _pf = __builtin_bit_cast(bf16x8, _p); \
    _Pragma("unroll") for (int _db = 0; _db < 4; ++_db) { const LAS unsigned char* _vp = lds + 32768 + (buf) * 16384 + vbase_l + (8 * _kh + 4 * _s) * 1024 + _db * 256; \
        const u32x2 _v0 = *(const LAS u32x2*)_vp, _v1 = *(const LAS u32x2*)(_vp + 2048); u32x4 _v; _v.x = _v0.x; _v.y = _v0.y; _v.z = _v1.x; _v.w = _v1.y; \
        oacc[_db] = ATT_MFMA(__builtin_bit_cast(bf16x8, _v), _pf, oacc[_db]); } } } while (0)

template <int MODE>
__device__ __forceinline__ void attn_item(LAS unsigned char* lds, const bf16* qrow, const bf16* kt, const bf16* vt, u64 mask, int tq, int W, int tile_lo, int tile_hi,
                                          void* o0, const float* o1, const float* o2, float g0, float g1, float g2) {
    int tid = threadIdx.x; asm volatile("" : "+v"(tid));
    const int lane = tid & 63, r32 = lane & 31, h = lane >> 5;
    const unsigned so = (unsigned)tid * 16u;
    const unsigned kbase_l = (unsigned)r32 * 256u, kx = (unsigned)(h ^ (lane & 15)), vbase_l = (unsigned)(h * 1024 + r32 * 8);
    bf16x8 qf[8];
#pragma unroll
    for (int s = 0; s < 8; ++s) qf[s] = *(const bf16x8*)(qrow + 16 * s + 8 * h);
    f32x16 oacc[4], sacc[2];
#pragma unroll
    for (int d = 0; d < 4; ++d)
#pragma unroll
        for (int r = 0; r < 16; ++r) oacc[d][r] = 0.f;
    float m_run = -1e30f, l_run = 0.f;
    const int khi = tq, klo = (tq - W + 1) > 0 ? (tq - W + 1) : 0;
    const unsigned wbase = (unsigned)__builtin_amdgcn_readfirstlane(tid >> 6) * 1024u;
    ATT_DMA(tile_lo, 0);
    ATT_SYNC();
    for (int j = tile_lo; j < tile_hi; ++j) {
        const int cur = (j - tile_lo) & 1;
        if (j + 1 < tile_hi) ATT_DMA(j + 1, cur ^ 1);
        const bool bit = (mask >> j) & 1ull;
        const int lo_rel = klo - 64 * j, hi_rel = khi - 64 * j;
        const bool none = !bit || hi_rel < 0 || lo_rel > 63;
        if (!__all(none)) {
            ATT_QK(cur);
            ATT_MASK(lo_rel, hi_rel, bit);
            float mt; ATT_TILEMAX(mt);
            const bool upd = mt > m_run + 8.0f;
            if (__any(upd)) {
                const float m_new = upd ? mt : m_run, alpha = __builtin_amdgcn_exp2f(m_run - m_new);
                l_run *= alpha; m_run = m_new;
#pragma unroll
                for (int d = 0; d < 4; ++d)
#pragma unroll
                    for (int r = 0; r < 16; ++r) oacc[d][r] *= alpha;
            }
            float ls = 0.f;
#pragma unroll
            for (int kh = 0; kh < 2; ++kh)
#pragma unroll
                for (int r = 0; r < 16; ++r) { const float p = __builtin_amdgcn_exp2f(sacc[kh][r] - m_run); sacc[kh][r] = p; ls += p; }
            l_run += ls;
            ATT_PV(cur);
        }
        ATT_SYNC();
    }
    const float l_tot = l_run + __shfl_xor(l_run, 32);
    const float inv = l_tot > 0.f ? 1.0f / l_tot : 0.f;
#pragma unroll
    for (int db = 0; db < 4; ++db)
#pragma unroll
        for (int i4 = 0; i4 < 4; ++i4) {
            const int d = 32 * db + 8 * i4 + 4 * h;
            f32x4 v = {oacc[db][4 * i4] * inv, oacc[db][4 * i4 + 1] * inv, oacc[db][4 * i4 + 2] * inv, oacc[db][4 * i4 + 3] * inv};
            if (MODE == 0) { *(f32x4*)((float*)o0 + d) = v; }
            else {
                if (MODE == 2) { const f32x4 a = *(const f32x4*)(o1 + d), c = *(const f32x4*)(o2 + d); v = a * g0 + v * g1 + c * g2; }
                u32x2 w; w.x = pk2(v[0], v[1]); w.y = pk2(v[2], v[3]); *(u32x2*)((bf16*)o0 + d) = w;
            }
        }
}

__device__ __forceinline__ void cmp_item(LAS unsigned char* lds, unsigned char* ws, int bg, int qc) {
    int tid = threadIdx.x; asm volatile("" : "+v"(tid));
    const int lane = tid & 63, wv = tid >> 6, r32 = lane & 31, h = lane >> 5;
    const int b = bg >> 1, g = bg & 1, head = r32 >> 3, qi = 8 * wv + (r32 & 7), tq = qc * 64 + qi;
    const unsigned so = (unsigned)tid * 16u;
    const unsigned kbase_l = (unsigned)r32 * 256u, kx = (unsigned)(h ^ (lane & 15)), vbase_l = (unsigned)(h * 1024 + r32 * 8);
    const bf16* qrow = (const bf16*)(ws + WS_QN) + (((size_t)b * 8 + g * 4 + head) * S + tq) * HD;
    const bf16* kt = (const bf16*)(ws + WS_KC) + (size_t)bg * 4 * 8192;
    const bf16* vt = (const bf16*)(ws + WS_VC) + (size_t)bg * 4 * 8192;
    LAS float* impA = (LAS float*)(lds + 65536);
    LAS float* impB = (LAS float*)(lds + 65536 + 16384);
    f32x16 oacc[4], sacc[2];
#define CMP_LOADQ() bf16x8 qf[8]; { const bf16* _qp = qrow; asm volatile("" : "+v"(_qp)); _Pragma("unroll") for (int _s = 0; _s < 8; ++_s) qf[_s] = *(const bf16x8*)(_qp + 16 * _s + 8 * h); }
#pragma unroll
    for (int d = 0; d < 4; ++d)
#pragma unroll
        for (int r = 0; r < 16; ++r) oacc[d][r] = 0.f;
    const int khi = (tq - 31) >> 4;
    const int nmax = (qc * 64 + 63 - 31) >> 4;
    const int ntile = nmax < 0 ? 0 : (nmax >> 6) + 1;
    for (int i = tid; i < 8192; i += NTHREADS) impA[i] = 0.f;
    float m_run = -1e30f, l_run = 0.f;
    const unsigned wbase = (unsigned)__builtin_amdgcn_readfirstlane(tid >> 6) * 1024u;
    if (ntile > 0) {
        ATT_DMA(0, 0);
        ATT_SYNC();
        for (int j = 0; j < ntile; ++j) {
            const int cur = j & 1;
            if (j + 1 < ntile) ATT_DMA(j + 1, cur ^ 1);
            const int hi_rel = khi - 64 * j;
            { CMP_LOADQ(); ATT_QK(cur); }
            ATT_MASK(0, hi_rel, true);
            float mt; ATT_TILEMAX(mt);
            const float m_new = fmaxf(m_run, mt);
            float ls = 0.f;
#pragma unroll
            for (int kh = 0; kh < 2; ++kh)
#pragma unroll
                for (int r = 0; r < 16; ++r) ls += __builtin_amdgcn_exp2f(sacc[kh][r] - m_new);
            l_run = l_run * __builtin_amdgcn_exp2f(m_run - m_new) + ls; m_run = m_new;
            ATT_SYNC();
        }
        const float l_tot = l_run + __shfl_xor(l_run, 32);
        const float inv = l_tot > 0.f ? 1.0f / l_tot : 0.f;
        ATT_DMA(0, 0);
        ATT_SYNC();
        for (int j = 0; j < ntile; ++j) {
            const int cur = j & 1;
            if (j + 1 < ntile) ATT_DMA(j + 1, cur ^ 1);
            const int hi_rel = khi - 64 * j;
            { CMP_LOADQ(); ATT_QK(cur); }
            ATT_MASK(0, hi_rel, true);
#pragma unroll
            for (int kh = 0; kh < 2; ++kh)
#pragma unroll
                for (int r = 0; r < 16; ++r) sacc[kh][r] = __builtin_amdgcn_exp2f(sacc[kh][r] - m_run) * inv;
#pragma unroll
            for (int kh = 0; kh < 2; ++kh)
#pragma unroll
                for (int i4 = 0; i4 < 4; ++i4) {
                    float a = sacc[kh][4 * i4] + sacc[kh][4 * i4 + 1] + sacc[kh][4 * i4 + 2] + 0.5f * sacc[kh][4 * i4 + 3], bb = 0.5f * sacc[kh][4 * i4 + 3];
                    a += __shfl_xor(a, 8); a += __shfl_xor(a, 16); bb += __shfl_xor(bb, 8); bb += __shfl_xor(bb, 16);
                    if (head == 0) { const int jj = 16 * j + 8 * kh + 2 * i4 + h; impA[qi * 64 + jj] = a; impB[qi * 64 + jj] = bb; }
                }
            ATT_SYNC();
        }
#pragma unroll
        for (int d = 0; d < 4; ++d)
#pragma unroll
            for (int r = 0; r < 16; ++r) oacc[d][r] = 0.f;
        ATT_DMA(0, 0);
        ATT_SYNC();
        for (int j = 0; j < ntile; ++j) {
            const int cur = j & 1;
            if (j + 1 < ntile) ATT_DMA(j + 1, cur ^ 1);
            const int hi_rel = khi - 64 * j;
            { CMP_LOADQ(); ATT_QK(cur); }
            ATT_MASK(0, hi_rel, true);
#pragma unroll
            for (int kh = 0; kh < 2; ++kh)
#pragma unroll
                for (int r = 0; r < 16; ++r) sacc[kh][r] = __builtin_amdgcn_exp2f(sacc[kh][r] - m_run) * inv;
            ATT_PV(cur);
            ATT_SYNC();
        }
    }
    {
        float* orow = (float*)(ws + WS_OCMP) + ((size_t)b * S + tq) * 1024 + (g * 4 + head) * HD;
#pragma unroll
        for (int db = 0; db < 4; ++db)
#pragma unroll
            for (int i4 = 0; i4 < 4; ++i4) { const int d = 32 * db + 8 * i4 + 4 * h;
                f32x4 v = {oacc[db][4 * i4], oacc[db][4 * i4 + 1], oacc[db][4 * i4 + 2], oacc[db][4 * i4 + 3]}; *(f32x4*)(orow + d) = v; }
    }
    __syncthreads();
    {
        const int q = tid >> 3, jg = tid & 7, cur = qc;
        float sc[8];
#pragma unroll
        for (int i = 0; i < 8; ++i) { const int jj = 8 * jg + i; const float v = impA[q * 64 + jj] + (jj > 0 ? impB[q * 64 + jj - 1] : 0.f);
            const bool valid = jj <= cur, forced = (jj == 0) || (jj == cur) || (jj == cur - 1); sc[i] = forced ? 1e9f : (valid ? v : -1e9f); }
        __syncthreads();
#pragma unroll
        for (int i = 0; i < 8; ++i) impA[q * 64 + 8 * jg + i] = sc[i];
        __syncthreads();
        int rank[8];
#pragma unroll
        for (int i = 0; i < 8; ++i) rank[i] = 0;
#pragma unroll 2
        for (int jp = 0; jp < 64; ++jp) { const float v = impA[q * 64 + jp];
#pragma unroll
            for (int i = 0; i < 8; ++i) rank[i] += (v > sc[i] || (v == sc[i] && jp < 8 * jg + i)) ? 1 : 0; }
        unsigned bits = 0;
#pragma unroll
        for (int i = 0; i < 8; ++i) bits |= (rank[i] < 16 && sc[i] > -0.5e9f) ? (1u << i) : 0u;
        unsigned lo = jg < 4 ? (bits << (8 * jg)) : 0u, hi2 = jg >= 4 ? (bits << (8 * (jg - 4))) : 0u;
        lo |= __shfl_xor(lo, 1); lo |= __shfl_xor(lo, 2); lo |= __shfl_xor(lo, 4); hi2 |= __shfl_xor(hi2, 1); hi2 |= __shfl_xor(hi2, 2); hi2 |= __shfl_xor(hi2, 4);
        if (jg == 0) ((u64*)(ws + WS_MSEL))[(size_t)bg * S + qc * 64 + q] = ((u64)hi2 << 32) | lo;
    }
    __syncthreads();
}

struct SchedOne { Unit u; bool has; __device__ __forceinline__ bool next(int i, Unit& o) const { if (i == 0 && has) { o = u; return true; } return false; } };
struct EpiHid {
    static constexpr bool PERM = false; float* dst;
    __device__ __forceinline__ void operator()(const f32x4 (&acc)[2][2][4][2], const Unit& u, int wr, int wc, int fr, int fq) const {
#pragma unroll
        for (int ai = 0; ai < 2; ++ai)
#pragma unroll
            for (int m = 0; m < 4; ++m) { float* rp = dst + (size_t)(ai * 128 + wr * 64 + m * 16 + fr) * 256 + wc * 32 + 4 * fq;
#pragma unroll
                for (int bj = 0; bj < 2; ++bj)
#pragma unroll
                    for (int n = 0; n < 2; ++n) *(f32x4*)(rp + bj * 128 + n * 16) = acc[ai][bj][m][n]; }
    }
};
struct EpiProj {
    static constexpr bool PERM = true; unsigned char* ws;
    __device__ __forceinline__ void operator()(const f32x4 (&acc)[2][2][4][2], const Unit& u, int wr, int wc, int fr, int fq) const {
#pragma unroll
        for (int ai = 0; ai < 2; ++ai)
#pragma unroll
            for (int m = 0; m < 4; ++m) { const int t = u.pm * 256 + ai * 128 + wr * 64 + m * 16 + fr;
#pragma unroll
                for (int bj = 0; bj < 2; ++bj) { const int c = u.pn * 256 + bj * 128 + wc * 32 + fq * 8;
                    const u32x4 gw = *(const u32x4*)((const bf16*)(ws + WS_GM) + (size_t)t * 4096 + u.kind * 2048 + c);
                    f32x4 g0 = {bf2f(gw.x & 0xffff), bf2f(gw.x >> 16), bf2f(gw.y & 0xffff), bf2f(gw.y >> 16)}, g1 = {bf2f(gw.z & 0xffff), bf2f(gw.z >> 16), bf2f(gw.w & 0xffff), bf2f(gw.w >> 16)};
                    f32x4 v0 = acc[ai][bj][m][0] * g0, v1 = acc[ai][bj][m][1] * g1;
                    float* mp = (float*)(ws + WS_MIXP) + (size_t)t * D + c;
                    if (u.kind == 0) { *(f32x4*)mp = v0; *(f32x4*)(mp + 4) = v1; }
                    else { v0 += *(const f32x4*)mp; v1 += *(const f32x4*)(mp + 4);
                        u32x4 w; w.x = pk2(v0[0], v0[1]); w.y = pk2(v0[2], v0[3]); w.z = pk2(v1[0], v1[1]); w.w = pk2(v1[2], v1[3]);
                        *(u32x4*)((bf16*)(ws + WS_MIX) + (size_t)t * D + c) = w; } } }
    }
};
struct SchedProj { int G, c; const char* oa; const char* ob; const char* wn; const char* wm;
    __device__ __forceinline__ bool next(int i, Unit& u) const { const int p = (i >> 1) * G + c; if (p >= 512) return false; tile_map(p, 64, 8, u.pm, u.pn); u.kind = i & 1;
        constexpr size_t ts = (size_t)256 * 1024 * 2; u.a = (u.kind ? ob : oa) + u.pm * ts; u.b = (u.kind ? wm : wn) + u.pn * ts; return true; } };
struct EpiOut {
    static constexpr bool PERM = false; const float* x; float* x1;
    __device__ __forceinline__ void operator()(const f32x4 (&acc)[2][2][4][2], const Unit& u, int wr, int wc, int fr, int fq) const {
#pragma unroll
        for (int ai = 0; ai < 2; ++ai)
#pragma unroll
            for (int m = 0; m < 4; ++m) { const size_t ro = (size_t)(u.pm * 256 + ai * 128 + wr * 64 + m * 16 + fr) * D + u.pn * 256 + wc * 32 + 4 * fq;
#pragma unroll
                for (int bj = 0; bj < 2; ++bj)
#pragma unroll
                    for (int n = 0; n < 2; ++n) *(f32x4*)(x1 + ro + bj * 128 + n * 16) = *(const f32x4*)(x + ro + bj * 128 + n * 16) + acc[ai][bj][m][n]; }
    }
};
struct SchedOut { int G, c; const char* a; const char* b;
    __device__ __forceinline__ bool next(int i, Unit& u) const { const int L = i * G + c; if (L >= 512) return false; tile_map(L, 64, 8, u.pm, u.pn); constexpr size_t ts = (size_t)256 * 2048 * 2;
        u.a = a + u.pm * ts; u.b = b + u.pn * ts; u.kind = 0; return true; } };
struct SchedMoe { int G, c, nN; const LAS int* offs; const char* A; const char* W; size_t wstride;
    __device__ __forceinline__ bool next(int i, Unit& u) const { const int ntile = offs[NE] >> 8, L = i * G + c; if (L >= ntile * nN) return false; tile_map(L, ntile, nN, u.pm, u.pn);
        int e = 0;
        for (int k = 1; k < NE; ++k) e = (offs[k] <= u.pm * 256) ? k : e;
        constexpr size_t ts = (size_t)256 * 2048 * 2; u.kind = e; u.a = A + u.pm * ts; u.b = W + e * wstride + u.pn * ts; return true; } };
struct EpiAct {
    static constexpr bool PERM = true; const float* bgu; bf16* act;
    __device__ __forceinline__ void operator()(const f32x4 (&acc)[2][2][4][2], const Unit& u, int wr, int wc, int fr, int fq) const {
        const int c = u.pn * 128 + wc * 32 + fq * 8; const float* bp = bgu + (size_t)u.kind * 2 * FF + c;
        const f32x4 bg0 = *(const f32x4*)bp, bg1 = *(const f32x4*)(bp + 4), bl0 = *(const f32x4*)(bp + FF), bl1 = *(const f32x4*)(bp + FF + 4);
#pragma unroll
        for (int ai = 0; ai < 2; ++ai)
#pragma unroll
            for (int m = 0; m < 4; ++m) { const size_t row = (size_t)u.pm * 256 + ai * 128 + wr * 64 + m * 16 + fr;
                f32x4 g0 = acc[ai][0][m][0] + bg0, g1 = acc[ai][0][m][1] + bg1, l0 = acc[ai][1][m][0] + bl0, l1 = acc[ai][1][m][1] + bl1, a0, a1;
#pragma unroll
                for (int i = 0; i < 4; ++i) { const float ga = fminf(g0[i], 7.0f), gb = fminf(g1[i], 7.0f), la = fminf(fmaxf(l0[i], -7.0f), 7.0f), lb = fminf(fmaxf(l1[i], -7.0f), 7.0f);
                    a0[i] = ga * sigmoid_f(1.702f * ga) * (la + 1.0f); a1[i] = gb * sigmoid_f(1.702f * gb) * (lb + 1.0f); }
                u32x4 w; w.x = pk2(a0[0], a0[1]); w.y = pk2(a0[2], a0[3]); w.z = pk2(a1[0], a1[1]); w.w = pk2(a1[2], a1[3]);
                *(u32x4*)(act + row * FF + c) = w; }
    }
};
struct EpiDown {
    static constexpr bool PERM = true; const float* bdn; const int* rowdst; const float* roww; bf16* ys;
    __device__ __forceinline__ void operator()(const f32x4 (&acc)[2][2][4][2], const Unit& u, int wr, int wc, int fr, int fq) const {
#pragma unroll
        for (int ai = 0; ai < 2; ++ai)
#pragma unroll
            for (int m = 0; m < 4; ++m) { const int row = u.pm * 256 + ai * 128 + wr * 64 + m * 16 + fr; const int dst = rowdst[row]; const float w = roww[row];
                if (dst >= 0) {
#pragma unroll
                    for (int bj = 0; bj < 2; ++bj) { const int c = u.pn * 256 + bj * 128 + wc * 32 + fq * 8; const float* bp = bdn + (size_t)u.kind * D + c;
                        const f32x4 v0 = (acc[ai][bj][m][0] + *(const f32x4*)bp) * w, v1 = (acc[ai][bj][m][1] + *(const f32x4*)(bp + 4)) * w;
                        u32x4 o; o.x = pk2(v0[0], v0[1]); o.y = pk2(v0[2], v0[3]); o.z = pk2(v1[0], v1[1]); o.w = pk2(v1[2], v1[3]);
                        *(u32x4*)(ys + (size_t)dst * D + c) = o; } } }
    }
};
__device__ __forceinline__ float gelu_tanh_f(float x) { const float u = 0.7978845608028654f * (x + 0.044715f * x * x * x); const float e = __expf(2.0f * u); return 0.5f * x * (1.0f + (1.0f - 2.0f / (e + 1.0f))); }

__device__ __forceinline__ int queue_pop(volatile LAS unsigned* misc, unsigned* head) {
    __syncthreads();
    if (threadIdx.x == 0) misc[4] = __hip_atomic_fetch_add(head, 1u, __ATOMIC_RELAXED, __HIP_MEMORY_SCOPE_AGENT);
    __syncthreads();
    return (int)misc[4];
}
__device__ __forceinline__ void moe_offsets(volatile LAS unsigned* misc, const unsigned* counts) {
    __syncthreads();
    if (threadIdx.x == 0) { int o = 0; for (int e = 0; e < NE; ++e) { misc[16 + e] = (unsigned)o; o += ((int)__hip_atomic_load(counts + e, __ATOMIC_RELAXED, __HIP_MEMORY_SCOPE_AGENT) + 255) / 256 * 256; } misc[16 + NE] = (unsigned)o; }
    __syncthreads();
}

constexpr int NPHASE = 13;
__global__ void __launch_bounds__(NTHREADS, 2) fwd(Args args) {
    extern __shared__ __attribute__((aligned(16))) unsigned char lds_raw[];
    LAS unsigned char* lds = (LAS unsigned char*)lds_raw;
    volatile LAS unsigned* misc = (volatile LAS unsigned*)(lds + MISC_OFF);
    const int tid = threadIdx.x, lane = tid & 63, wave = __builtin_amdgcn_readfirstlane(tid >> 6);
    const int G = gridDim.x, blk = blockIdx.x, gw = blk * NWAVES + wave, NGW = G * NWAVES;
    unsigned char* ws = args.ws;
    unsigned* ctl = (unsigned*)(ws + WS_CTL);
    const float* x = args.in[0]; const int* positions = (const int*)args.in[1];
    for (int u = tid; u < 64; u += NTHREADS) misc[u] = 0u;
    __syncthreads();
    const int lo = args.ph_lo, hi = args.ph_hi;
    XcdBarrier bar; bar.bar = ctl + CW_BAR; bar.x = 0; bar.st = nullptr;
    if (hi - lo > 1) bar = xcd_barrier_post(ctl + CW_BAR, misc);
#ifndef FK_PHASE_MASK
#define FK_PHASE_MASK 0xFFFF
#endif
#define IN(k) (((FK_PHASE_MASK >> (k)) & 1) && lo <= (k) && (k) < hi)
#define SEAM(k) do { if (IN(k) && IN((k) + 1)) xcd_barrier(bar); } while (0)

    if (IN(0)) {
        LAS float* scr = (LAS float*)(lds + wave * 16384);
        constexpr int I_IN = 32 * 305, I_K1 = 64 * 8, I_PN = 16 * 64, I_OUT = 32 * 64, I_GU = 32 * 128, I_DN = 32 * 64;
        constexpr int NIT = I_IN + 2 * I_K1 + 2 * I_PN + I_OUT + NE * (I_GU + I_DN);
        for (int it = gw; it < NIT; it += NGW) {
            int r = it;
            if (r < I_IN) { transpose_item(args.in[3], D, INW, (bf16*)(ws + WS_WIN_T), RmWin{}, scr, r, lane); continue; } r -= I_IN;
            if (r < I_K1) { transpose_item(args.in[5], 4096, 256, (bf16*)(ws + WS_WK1_T), RmIdent{0}, scr, r, lane); continue; } r -= I_K1;
            if (r < I_K1) { transpose_item(args.in[8], 4096, 256, (bf16*)(ws + WS_WV1_T), RmIdent{0}, scr, r, lane); continue; } r -= I_K1;
            if (r < I_PN) { transpose_item(args.in[10], 1024, D, (bf16*)(ws + WS_WPN_T), RmIdent{0}, scr, r, lane); continue; } r -= I_PN;
            if (r < I_PN) { transpose_item(args.in[11], 1024, D, (bf16*)(ws + WS_WPM_T), RmIdent{0}, scr, r, lane); continue; } r -= I_PN;
            if (r < I_OUT) { transpose_item(args.in[12], D, D, (bf16*)(ws + WS_WOUT_T), RmIdent{0}, scr, r, lane); continue; } r -= I_OUT;
            if (r < NE * I_GU) { const int e = r / I_GU; transpose_item(args.in[16] + (size_t)e * D * 2 * FF, D, 2 * FF, (bf16*)(ws + WS_WGU_T), RmGu{(long)e * 4096}, scr, r % I_GU, lane); continue; } r -= NE * I_GU;
            { const int e = r / I_DN; transpose_item(args.in[18] + (size_t)e * FF * D, FF, D, (bf16*)(ws + WS_WDN_T), RmIdent{(long)e * 2048}, scr, r % I_DN, lane); }
        }
        for (int row = gw; row < T; row += NGW) {
            const f32x4* xr = (const f32x4*)(x + (size_t)row * D); f32x4 v[8]; float ss = 0.f;
#pragma unroll
            for (int i = 0; i < 8; ++i) { v[i] = xr[lane + 64 * i]; ss += v[i][0] * v[i][0] + v[i][1] * v[i][1] + v[i][2] * v[i][2] + v[i][3] * v[i][3]; }
            ss = wave_sum(ss); const float rs = rsqrtf(ss * (1.0f / D) + 1e-5f);
            u32x2* hr = (u32x2*)((bf16*)(ws + WS_H) + (size_t)row * D);
#pragma unroll
            for (int i = 0; i < 8; ++i) { const f32x4 gg = ((const f32x4*)args.in[2])[lane + 64 * i]; const f32x4 o = v[i] * rs * gg; u32x2 w; w.x = pk2(o[0], o[1]); w.y = pk2(o[2], o[3]); hr[lane + 64 * i] = w; }
        }
        for (int i = blk * NTHREADS + tid; i < T * 16; i += G * NTHREADS) { const int t = i >> 4, f = i & 15; const float inv = powf(500000.0f, -(float)(2 * f) / 32.0f); const float ang = (float)positions[t] * inv;
            float* cs = (float*)(ws + WS_CS) + (size_t)t * 32; cs[f] = cosf(ang); cs[16 + f] = sinf(ang); }
        if (blk < 16) {
            __syncthreads();
            const int kv = blk >> 3, c = (blk & 7) * 32 + (tid & 31), ks = tid >> 5; const float* pe = args.in[kv ? 7 : 4]; const float* w1 = args.in[kv ? 8 : 5]; float a = 0.f;
            for (int k = ks * 256; k < ks * 256 + 256; ++k) a += pe[k] * w1[(size_t)k * 256 + c];
            LAS float* red = (LAS float*)lds; red[tid] = a; __syncthreads();
            if (tid < 32) { float s = 0.f; for (int q = 0; q < 16; ++q) s += red[q * 32 + tid]; ((float*)(ws + WS_PEB))[kv * 256 + (blk & 7) * 32 + tid] = s; }
            __syncthreads();
        }
    }
    SEAM(0);
    if (IN(1)) {
        SchedIn Sc{G, blk, (const char*)(ws + WS_H), (const char*)(ws + WS_WIN_T)}; EpiIn E{ws, (const float*)(ws + WS_CS)};
        gemm_phase<EpiIn, SchedIn>(lds, Gemm{D, D, D}, Sc, E);
    }
    SEAM(1);
    if (IN(2)) {
        {
            SchedOne Sc; Sc.has = blk < 64;
            const int kv = blk >> 5, pm = (blk & 31) >> 2, ks = blk & 3;
            Sc.u.a = (const char*)(ws + (kv ? WS_VCMP : WS_KCMP)) + ((size_t)pm * 256 * 2048 + ks * 1024) * 2; Sc.u.b = (const char*)(ws + (kv ? WS_WV1_T : WS_WK1_T)) + (size_t)ks * 1024 * 2; Sc.u.pm = pm; Sc.u.pn = 0; Sc.u.kind = 0;
            EpiHid E{(float*)(ws + WS_HIDP) + ((size_t)(kv * 4 + ks) * 2048 + pm * 256) * 256};
            gemm_phase<EpiHid, SchedOne>(lds, Gemm{1024, 2048, 4096}, Sc, E);
        }
        for (;;) {
            const int it = queue_pop(misc, ctl + CW_Q + 64 * 0);
            if (it >= 1024) break;
            if (it < 512) {
                const int bg = it & 7, qc = it >> 3, b = bg >> 1, g = bg & 1, head = g * 4 + (wave >> 1), tq = qc * 64 + (wave & 1) * 32 + (lane & 31);
                const bf16* qrow = (const bf16*)(ws + WS_QN) + (((size_t)b * 8 + head) * S + tq) * HD;
                float* orow = (float*)(ws + WS_OWIN) + ((size_t)b * S + tq) * 1024 + head * HD;
                attn_item<0>(lds, qrow, (const bf16*)(ws + WS_KWIN) + (size_t)bg * S * HD, (const bf16*)(ws + WS_VWIN) + (size_t)bg * S * HD, ~0ull, tq, 512, qc > 8 ? qc - 8 : 0, qc + 1, orow, nullptr, nullptr, 0.f, 0.f, 0.f);
            } else {
                const int id = it - 512, bh = id >> 4, nb = id & 15, p = tid & 15, kg = tid >> 4;
                const bf16* kb = (const bf16*)(ws + WS_MK) + ((size_t)bh * S + nb * 256) * HD; float a[8];
#pragma unroll
                for (int i = 0; i < 8; ++i) a[i] = 0.f;
                for (int kk = 0; kk < 8; ++kk) { const int key = kg * 8 + kk; const u32x4 w = *(const u32x4*)(kb + (size_t)key * HD + ((p ^ (key & 15)) * 8));
                    a[0] += bf2f(w.x & 0xffff); a[1] += bf2f(w.x >> 16); a[2] += bf2f(w.y & 0xffff); a[3] += bf2f(w.y >> 16); a[4] += bf2f(w.z & 0xffff); a[5] += bf2f(w.z >> 16); a[6] += bf2f(w.w & 0xffff); a[7] += bf2f(w.w >> 16); }
                LAS float* red = (LAS float*)lds;
#pragma unroll
                for (int i = 0; i < 8; ++i) red[kg * 128 + p * 8 + i] = a[i];
                __syncthreads();
                if (tid < 128) { float s = 0.f; for (int q = 0; q < 32; ++q) s += red[q * 128 + tid]; ((float*)(ws + WS_KMEAN))[((size_t)bh * 16 + nb) * HD + tid] = s * (1.0f / 256.0f); }
            }
        }
    }
    SEAM(2);
    if (IN(3)) {
        for (int it = blk; it < 256 + 4096; it += G) {
            __syncthreads();
            if (it < 256) {
                const int kv = it >> 7, m0 = (it & 127) * 16;
                LAS float* hid = (LAS float*)lds;
                LAS float* outb = (LAS float*)(lds + 16384);
                const float* hp = (const float*)(ws + WS_HIDP) + (size_t)kv * 4 * 2048 * 256; const float* peb = (const float*)(ws + WS_PEB) + kv * 256;
                for (int i = tid; i < 16 * 256; i += NTHREADS) { const int r = i >> 8, c = i & 255; const size_t o = (size_t)(m0 + r) * 256 + c;
                    const float v = ((hp[o] + hp[o + 2048 * 256]) + (hp[o + 2 * 2048 * 256] + hp[o + 3 * 2048 * 256])) + peb[c]; hid[i] = gelu_tanh_f(v); }
                __syncthreads();
                { const int n = tid & 127, rg = tid >> 7; const float* w2 = args.in[kv ? 9 : 6]; float a0 = 0.f, a1 = 0.f, a2 = 0.f, a3 = 0.f;
                  for (int j = 0; j < 256; ++j) { const float w = w2[j * 128 + n]; a0 += hid[(rg * 4 + 0) * 256 + j] * w; a1 += hid[(rg * 4 + 1) * 256 + j] * w; a2 += hid[(rg * 4 + 2) * 256 + j] * w; a3 += hid[(rg * 4 + 3) * 256 + j] * w; }
                  outb[(rg * 4 + 0) * 128 + n] = a0; outb[(rg * 4 + 1) * 128 + n] = a1; outb[(rg * 4 + 2) * 128 + n] = a2; outb[(rg * 4 + 3) * 128 + n] = a3; }
                __syncthreads();
                const int bg = m0 >> 8, i0 = m0 & 255;
                if (kv == 0) {
                    if (tid < 256) { const int r = tid >> 4, p = tid & 15, i = i0 + r; float v[8];
#pragma unroll
                        for (int e = 0; e < 8; ++e) v[e] = outb[r * 128 + p * 8 + e];
                        if (p < 4) { int tk = 16 * i + 31; tk = tk < S ? tk : S - 1; const float* cs = (const float*)(ws + WS_CS) + ((size_t)(bg >> 1) * S + tk) * 32 + 8 * (p & 1);
#pragma unroll
                            for (int e = 0; e < 8; ++e) { const float o = outb[r * 128 + (p ^ 2) * 8 + e]; v[e] = p < 2 ? v[e] * cs[e] - o * cs[16 + e] : v[e] * cs[e] + o * cs[16 + e]; } }
                        u32x4 w; w.x = pk2(v[0], v[1]); w.y = pk2(v[2], v[3]); w.z = pk2(v[4], v[5]); w.w = pk2(v[6], v[7]);
                        *(u32x4*)((bf16*)(ws + WS_KC) + (size_t)bg * 4 * 8192 + (size_t)i * HD + ((p ^ (i & 15)) * 8)) = w; }
                } else {
                    const int qd = tid >> 7, d = tid & 127, i = i0 + 4 * qd;
                    u32x2 w; w.x = pk2(outb[(4 * qd) * 128 + d], outb[(4 * qd + 1) * 128 + d]); w.y = pk2(outb[(4 * qd + 2) * 128 + d], outb[(4 * qd + 3) * 128 + d]);
                    *(u32x2*)((bf16*)(ws + WS_VC) + (size_t)bg * 4 * 8192 + (size_t)(i >> 6) * 8192 + (((i & 63) >> 2) * 128 + d) * 4) = w;
                }
            } else {
                const int id = it - 256, bh = id >> 7, t = (id & 127) * 32 + (tid >> 4), n = tid & 15, own = t >> 8;
                float gate = -1e9f;
                if (n < own) { const bf16* qr = (const bf16*)(ws + WS_MQ) + ((size_t)bh * S + t) * HD; const float* km = (const float*)(ws + WS_KMEAN) + ((size_t)bh * 16 + n) * HD; float a = 0.f;
                    for (int d8 = 0; d8 < 16; ++d8) { const u32x4 w = *(const u32x4*)(qr + d8 * 8); const f32x4 k0 = *(const f32x4*)(km + d8 * 8), k1 = *(const f32x4*)(km + d8 * 8 + 4);
                        a += bf2f(w.x & 0xffff) * k0[0] + bf2f(w.x >> 16) * k0[1] + bf2f(w.y & 0xffff) * k0[2] + bf2f(w.y >> 16) * k0[3] + bf2f(w.z & 0xffff) * k1[0] + bf2f(w.z >> 16) * k1[1] + bf2f(w.w & 0xffff) * k1[2] + bf2f(w.w >> 16) * k1[3]; }
                    gate = a; }
                int rank = 0;
                for (int np = 0; np < 16; ++np) { const float o = __shfl(gate, (lane & 48) + np); rank += (o > gate || (o == gate && np < n)) ? 1 : 0; }
                const bool sel = rank < 3 && gate > -0.5e9f;
                const u64 bm = __ballot(sel);
                if (n == 0) { const unsigned grp = (unsigned)(bm >> (lane & 48)) & 0xffffu; u64 m = 0;
                    for (int k = 0; k < 16; ++k) if ((grp >> k) & 1u) m |= (0xFull << (4 * k));
                    m |= (0xFull << (4 * own)); ((u64*)(ws + WS_MMOBA))[(size_t)bh * S + t] = m; }
            }
        }
    }
    SEAM(3);
    if (IN(4)) {
        for (;;) {
            const int it = queue_pop(misc, ctl + CW_Q + 64 * 1);
            if (it >= 1024) break;
            if (it < 512) {
                const int qb = 15 - (it >> 5), bh = it & 31, b = bh >> 3, head = bh & 7, tq = qb * 256 + wave * 32 + (lane & 31);
                const bf16* qrow = (const bf16*)(ws + WS_MQ) + ((size_t)bh * S + tq) * HD;
                const u64 mk = ((const u64*)(ws + WS_MMOBA))[(size_t)bh * S + tq];
                bf16* orow = (bf16*)(ws + WS_OB) + ((size_t)b * S + tq) * 1024 + head * HD;
                attn_item<1>(lds, qrow, (const bf16*)(ws + WS_MK) + (size_t)bh * S * HD, (const bf16*)(ws + WS_MV) + (size_t)bh * S * HD, mk, tq, 1 << 30, 0, 4 * (qb + 1), orow, nullptr, nullptr, 0.f, 0.f, 0.f);
            } else { const int id = it - 512; cmp_item(lds, ws, id & 7, 63 - (id >> 3)); }
        }
    }
    SEAM(4);
    if (IN(5)) {
        for (;;) {
            const int it = queue_pop(misc, ctl + CW_Q + 64 * 2);
            if (it >= 512) break;
            const int bg = it & 7, qc = 63 - (it >> 3), b = bg >> 1, g = bg & 1, head = g * 4 + (wave >> 1), tq = qc * 64 + (wave & 1) * 32 + (lane & 31);
            const size_t trow = (size_t)b * S + tq;
            const bf16* qrow = (const bf16*)(ws + WS_QN) + (((size_t)b * 8 + head) * S + tq) * HD;
            const u64 mk = ((const u64*)(ws + WS_MSEL))[(size_t)bg * S + tq];
            const float* gn = (const float*)(ws + WS_GN) + trow * 24;
            attn_item<2>(lds, qrow, (const bf16*)(ws + WS_KSLC) + (size_t)bg * S * HD, (const bf16*)(ws + WS_VSLC) + (size_t)bg * S * HD, mk, tq, 1 << 30, 0, qc + 1,
                         (bf16*)(ws + WS_OA) + trow * 1024 + head * HD, (const float*)(ws + WS_OCMP) + trow * 1024 + head * HD, (const float*)(ws + WS_OWIN) + trow * 1024 + head * HD, gn[head], gn[8 + head], gn[16 + head]);
        }
    }
    SEAM(5);
    if (IN(6)) {
        SchedProj Sc{G, blk, (const char*)(ws + WS_OA), (const char*)(ws + WS_OB), (const char*)(ws + WS_WPN_T), (const char*)(ws + WS_WPM_T)}; EpiProj E{ws};
        gemm_phase<EpiProj, SchedProj>(lds, Gemm{1024, 1024, 1024}, Sc, E);
    }
    SEAM(6);
    if (IN(7)) {
        SchedOut Sc{G, blk, (const char*)(ws + WS_MIX), (const char*)(ws + WS_WOUT_T)}; EpiOut E{x, (float*)(ws + WS_X1)};
        gemm_phase<EpiOut, SchedOut>(lds, Gemm{D, D, D}, Sc, E);
    }
    SEAM(7);
    if (IN(8)) {
        LAS float* hT = (LAS float*)lds;
        LAS float* part = (LAS float*)(lds + 65536);
        for (int bt = blk; bt < T / 8; bt += G) {
            __syncthreads();
            { const int tok = bt * 8 + wave; const f32x4* xr = (const f32x4*)((const float*)(ws + WS_X1) + (size_t)tok * D); f32x4 v[8]; float ss = 0.f;
#pragma unroll
              for (int i = 0; i < 8; ++i) { v[i] = xr[lane + 64 * i]; ss += v[i][0] * v[i][0] + v[i][1] * v[i][1] + v[i][2] * v[i][2] + v[i][3] * v[i][3]; }
              ss = wave_sum(ss); const float rs = rsqrtf(ss * (1.0f / D) + 1e-5f);
              u32x2* hr = (u32x2*)((bf16*)(ws + WS_H) + (size_t)tok * D);
#pragma unroll
              for (int i = 0; i < 8; ++i) { const f32x4 gg = ((const f32x4*)args.in[13])[lane + 64 * i]; const f32x4 o = v[i] * rs * gg; u32x2 w; w.x = pk2(o[0], o[1]); w.y = pk2(o[2], o[3]); hr[lane + 64 * i] = w;
                  const int k = 4 * (lane + 64 * i); hT[(k + 0) * 8 + wave] = o[0]; hT[(k + 1) * 8 + wave] = o[1]; hT[(k + 2) * 8 + wave] = o[2]; hT[(k + 3) * 8 + wave] = o[3]; } }
            __syncthreads();
            { const int e = lane & 31, kp = lane >> 5; float a[8];
#pragma unroll
              for (int t8 = 0; t8 < 8; ++t8) a[t8] = 0.f;
              const float* wr_ = args.in[14];
              for (int kk = 0; kk < 128; ++kk) { const int k = 256 * wave + 2 * kk + kp; const float w = wr_[(size_t)k * NE + e]; const f32x4 h0 = *(const LAS f32x4*)(hT + k * 8), h1 = *(const LAS f32x4*)(hT + k * 8 + 4);
                  a[0] += w * h0[0]; a[1] += w * h0[1]; a[2] += w * h0[2]; a[3] += w * h0[3]; a[4] += w * h1[0]; a[5] += w * h1[1]; a[6] += w * h1[2]; a[7] += w * h1[3]; }
#pragma unroll
              for (int t8 = 0; t8 < 8; ++t8) { a[t8] += __shfl_xor(a[t8], 32); if (kp == 0) part[(wave * 8 + t8) * 32 + e] = a[t8]; } }
            __syncthreads();
            if (tid < 256) { const int t8 = tid >> 5, e = tid & 31, tok = bt * 8 + t8; float lg = args.in[15][e];
#pragma unroll
                for (int w8 = 0; w8 < 8; ++w8) lg += part[(w8 * 8 + t8) * 32 + e];
                int rank = 0; float mx = lg;
                for (int ep = 0; ep < 32; ++ep) { const float o = __shfl(lg, (lane & 32) + ep); rank += (o > lg || (o == lg && ep < e)) ? 1 : 0; mx = fmaxf(mx, o); }
                const bool sel = rank < 4; const float ex = sel ? __expf(lg - mx) : 0.f; float sum = ex;
#pragma unroll
                for (int o = 1; o < 32; o <<= 1) sum += __shfl_xor(sum, o);
                if (sel) { const unsigned pos = __hip_atomic_fetch_add(ctl + CW_CNT + e, 1u, __ATOMIC_RELAXED, __HIP_MEMORY_SCOPE_AGENT);
                    ((int*)(ws + WS_SELE))[tok * 4 + rank] = e; ((float*)(ws + WS_SELW))[tok * 4 + rank] = ex / sum; ((int*)(ws + WS_SELP))[tok * 4 + rank] = (int)pos; } }
        }
    }
    SEAM(8);
    if (IN(9)) {
        moe_offsets(misc, ctl + CW_CNT);
        if (blk < NE) { const int e = blk, beg = (int)misc[16 + e] + (int)__hip_atomic_load(ctl + CW_CNT + e, __ATOMIC_RELAXED, __HIP_MEMORY_SCOPE_AGENT), end = (int)misc[16 + e + 1];
            for (int r = beg + tid; r < end; r += NTHREADS) ((int*)(ws + WS_ROWDST))[r] = -1; }
        for (int i = gw; i < T * 4; i += NGW) {
            const int e = ((const int*)(ws + WS_SELE))[i], dest = (int)misc[16 + e] + ((const int*)(ws + WS_SELP))[i];
            const u32x4* src = (const u32x4*)((const bf16*)(ws + WS_H) + (size_t)(i >> 2) * D); u32x4* dp = (u32x4*)((bf16*)(ws + WS_XPAD) + (size_t)dest * D);
            const u32x4 v0 = src[lane], v1 = src[lane + 64], v2 = src[lane + 128], v3 = src[lane + 192];
            dp[lane] = v0; dp[lane + 64] = v1; dp[lane + 128] = v2; dp[lane + 192] = v3;
            if (lane == 0) { ((int*)(ws + WS_ROWDST))[dest] = i; ((float*)(ws + WS_ROWW))[dest] = ((const float*)(ws + WS_SELW))[i]; }
        }
    }
    SEAM(9);
    if (IN(10)) {
        moe_offsets(misc, ctl + CW_CNT);
        SchedMoe Sc{G, blk, 16, (const LAS int*)(misc + 16), (const char*)(ws + WS_XPAD), (const char*)(ws + WS_WGU_T), (size_t)4096 * 2048 * 2}; EpiAct E{args.in[17], (bf16*)(ws + WS_ACT)};
        gemm_phase<EpiAct, SchedMoe>(lds, Gemm{D, D, D}, Sc, E);
    }
    SEAM(10);
    if (IN(11)) {
        moe_offsets(misc, ctl + CW_CNT);
        SchedMoe Sc{G, blk, 8, (const LAS int*)(misc + 16), (const char*)(ws + WS_ACT), (const char*)(ws + WS_WDN_T), (size_t)2048 * 2048 * 2}; EpiDown E{args.in[19], (const int*)(ws + WS_ROWDST), (const float*)(ws + WS_ROWW), (bf16*)(ws + WS_YS)};
        gemm_phase<EpiDown, SchedMoe>(lds, Gemm{FF, FF, FF}, Sc, E);
    }
    SEAM(11);
    if (IN(12)) {
        for (int tok = gw; tok < T; tok += NGW) {
            f32x4 v[8]; float ss = 0.f;
#pragma unroll
            for (int i = 0; i < 8; ++i) { f32x4 a = ((const f32x4*)((const float*)(ws + WS_X1) + (size_t)tok * D))[lane + 64 * i];
#pragma unroll
                for (int k = 0; k < 4; ++k) { const u32x2 y = ((const u32x2*)((const bf16*)(ws + WS_YS) + ((size_t)tok * 4 + k) * D))[lane + 64 * i];
                    a[0] += bf2f(y.x & 0xffff); a[1] += bf2f(y.x >> 16); a[2] += bf2f(y.y & 0xffff); a[3] += bf2f(y.y >> 16); }
                v[i] = a; ss += a[0] * a[0] + a[1] * a[1] + a[2] * a[2] + a[3] * a[3]; }
            ss = wave_sum(ss); const float rs = rsqrtf(ss * (1.0f / D) + 1e-5f);
#pragma unroll
            for (int i = 0; i < 8; ++i) { const f32x4 gg = ((const f32x4*)args.in[20])[lane + 64 * i]; ((f32x4*)(args.out + (size_t)tok * D))[lane + 64 * i] = v[i] * rs * gg; }
        }
    }
#undef IN
#undef SEAM
}

static void launch_phases(void* const* d_in, void* d_out, void* d_ws, hipStream_t stream, int lo, int hi, bool per_phase) {
    static int grid = 0;
    if (grid == 0) {
        int dev = 0, cus = 0;
        (void)hipGetDevice(&dev); (void)hipDeviceGetAttribute(&cus, hipDeviceAttributeMultiprocessorCount, dev);
        (void)hipFuncSetAttribute((const void*)fwd, hipFuncAttributeMaxDynamicSharedMemorySize, LDS_BYTES);
        grid = cus > 0 ? cus : 256;
    }
    Args a{};
    for (int i = 0; i < 21; ++i) a.in[i] = (const float*)d_in[i];
    a.out = (float*)d_out; a.ws = (unsigned char*)d_ws;
    if (per_phase) { for (int p = lo; p < hi; ++p) { a.ph_lo = p; a.ph_hi = p + 1; hipLaunchKernelGGL(fwd, dim3(grid), dim3(NTHREADS), LDS_BYTES, stream, a); } }
    else { a.ph_lo = lo; a.ph_hi = hi; hipLaunchKernelGGL(fwd, dim3(grid), dim3(NTHREADS), LDS_BYTES, stream, a); }
}
}
extern "C" void kernel_launch(void* const* d_in, const int* in_sizes, int n_in, void* d_out, int out_size, void* d_ws, size_t ws_size, hipStream_t stream) {
    using namespace fk;
    (void)hipMemsetAsync((char*)d_ws + WS_CTL, 0, CTL_BYTES, stream);
    launch_phases(d_in, d_out, d_ws, stream, 0, NPHASE, false);
}
```

```cpp
#include <hip/hip_runtime.h>
#include <stdint.h>
namespace fk {
#define LAS __attribute__((address_space(3)))
#define GAS __attribute__((address_space(1)))
typedef unsigned short bf16;
typedef unsigned long long u64;
typedef short bf16x8 __attribute__((ext_vector_type(8)));
typedef float f32x4 __attribute__((ext_vector_type(4)));
typedef float f32x16 __attribute__((ext_vector_type(16)));
typedef unsigned u32x4 __attribute__((ext_vector_type(4)));
typedef unsigned u32x2 __attribute__((ext_vector_type(2)));
typedef float f32x2_t __attribute__((ext_vector_type(2)));
typedef __bf16 bf16x2_t __attribute__((ext_vector_type(2)));

constexpr int D = 2048, NB = 4, S = 4096, T = NB * S, HD = 128, NE = 32, FF = 2048, INW = 9752;
constexpr int NTHREADS = 512, NWAVES = 8;

__device__ __forceinline__ unsigned pk2(float lo, float hi) { f32x2_t v = {lo, hi}; bf16x2_t b = __builtin_convertvector(v, bf16x2_t); return __builtin_bit_cast(unsigned, b); }
__device__ __forceinline__ float bf2f(unsigned short b) { return __builtin_bit_cast(float, (unsigned)b << 16); }
__device__ __forceinline__ float wave_sum(float v) {
#pragma unroll
    for (int o = 1; o < 64; o <<= 1) v += __shfl_xor(v, o);
    return v;
}
__device__ __forceinline__ float sigmoid_f(float x) { return __builtin_amdgcn_rcpf(1.0f + __expf(-x)); }

#define XB_TMO      128
#define XB_XCNT(j)  (256  + 64 * (j))
#define XB_XSUB(j)  (1280 + 64 * (j))
#define XB_XGEN(j)  (2304 + 64 * (j))
#define XB_TOP      3328
#define XB_TOPGEN   3392
#define XCD_BAR_WORDS 3456
#define XB_SPIN_CAP (1u << 18)
__device__ __forceinline__ unsigned xb_ld(unsigned* p)              { return __hip_atomic_load(p, __ATOMIC_RELAXED, __HIP_MEMORY_SCOPE_AGENT); }
__device__ __forceinline__ unsigned xb_add(unsigned* p, unsigned v) { return __hip_atomic_fetch_add(p, v, __ATOMIC_RELAXED, __HIP_MEMORY_SCOPE_AGENT); }
__device__ __forceinline__ unsigned xb_xcc_id() { return (unsigned)__builtin_amdgcn_s_getreg((3 << 11) | 20) & 0xFu; }
#define XB_SPIN(cond, bar) do { unsigned _sp = 0; while (cond) { __builtin_amdgcn_s_sleep(1); \
    if ((++_sp & 255u) == 0u) { if (xb_ld(&(bar)[XB_TMO])) break; if (_sp > XB_SPIN_CAP) { atomicAdd(&(bar)[XB_TMO], 1u); break; } } } } while (0)
struct XcdBarrier { unsigned* bar; unsigned x; volatile LAS unsigned* st; };
__device__ __forceinline__ XcdBarrier xcd_barrier_post(unsigned* bar, volatile LAS unsigned* st) {
    XcdBarrier b; b.bar = bar; b.x = xb_xcc_id(); b.st = st;
    if (threadIdx.x == 0) (void)xb_add(&bar[XB_XCNT(b.x)], 1u);
    return b;
}
__device__ __forceinline__ void xcd_barrier_complete(unsigned* bar, unsigned x, unsigned& nloc, unsigned& nx) {
    const unsigned G = gridDim.x * gridDim.y * gridDim.z;
    unsigned sum, cnt, mine, sp = 0u;
    for (;;) {
        sum = 0u; cnt = 0u; mine = 0u;
#pragma unroll
        for (unsigned j = 0; j < 16; ++j) { const unsigned c = xb_ld(&bar[XB_XCNT(j)]); sum += c; cnt += (c > 0u) ? 1u : 0u; mine = (j == x) ? c : mine; }
        if (sum == G) break;
        __builtin_amdgcn_s_sleep(1);
        if ((++sp & 255u) == 0u) { if (xb_ld(&bar[XB_TMO])) break; if (sp > XB_SPIN_CAP) { atomicAdd(&bar[XB_TMO], 1u); break; } }
    }
    nloc = mine > 0u ? mine : 1u; nx = cnt > 0u ? cnt : 1u;
}
__device__ __forceinline__ void xcd_barrier(const XcdBarrier& b) {
    asm volatile("s_waitcnt vmcnt(0)" ::: "memory");
    __syncthreads();
    if (threadIdx.x == 0) {
        unsigned* bar = b.bar;
        __builtin_amdgcn_s_waitcnt(0);
        unsigned nloc = b.st[0], nx = b.st[1];
        if (nloc == 0u) { xcd_barrier_complete(bar, b.x, nloc, nx); b.st[0] = nloc; b.st[1] = nx; }
        const unsigned old = xb_add(&bar[XB_XSUB(b.x)], 1u);
        const unsigned gen = old / nloc;
        if (old + 1u == (gen + 1u) * nloc) {
            __builtin_amdgcn_fence(__ATOMIC_RELEASE, "agent");
            asm volatile("s_waitcnt vmcnt(0)" ::: "memory");
            const unsigned og = xb_add(&bar[XB_TOP], 1u);
            const unsigned tg = og / nx;
            if (og + 1u == (tg + 1u) * nx) xb_add(&bar[XB_TOPGEN], 1u);
            else XB_SPIN(xb_ld(&bar[XB_TOPGEN]) == tg, bar);
            __builtin_amdgcn_fence(__ATOMIC_ACQUIRE, "agent");
            xb_add(&bar[XB_XGEN(b.x)], 1u);
            asm volatile("s_waitcnt vmcnt(0)" ::: "memory");
        } else {
            XB_SPIN(xb_ld(&bar[XB_XGEN(b.x)]) == gen, bar);
            __builtin_amdgcn_fence(__ATOMIC_ACQUIRE, "agent");
            asm volatile("s_waitcnt vmcnt(0)" ::: "memory");
        }
    }
    __syncthreads();
}

constexpr int BM = 256, BK = 64, HALF = 128, HTB = HALF * BK * 2, STAGE_BYTES = 8 * HTB, NXCD = 8, WGM = 8;
__host__ __device__ __forceinline__ int lds_byte(int r, int c) { const int st = (r >> 4) * 2 + (c >> 5), rr = r & 15, cc = c & 31, ob = rr * 64 + cc * 2; return st * 1024 + (ob ^ (((ob >> 9) & 1) << 5)); }
__host__ __device__ __forceinline__ void stage_rc(int b, int& R, int& C) { const int st = b / 1024, sb = b % 1024, swz = sb ^ (((sb >> 9) & 1) << 5); R = (st >> 1) * 16 + swz / 64; C = (st & 1) * 32 + (swz % 64) / 2; }
__host__ __device__ __forceinline__ int lds_byte8(int r, int q) { return ((r >> 4) * 2 + (q >> 2)) * 1024 + (((r & 15) * 64 + (q & 3) * 16) ^ (((r >> 3) & 1) << 4)); }
__host__ __device__ __forceinline__ void stage_rc8(int b, int& R, int& C) { const int st = b / 1024, sb = b % 1024, rr = sb / 64, swz = sb ^ (((rr >> 3) & 1) << 4); R = (st >> 1) * 16 + rr; C = ((st & 1) * 4 + (swz % 64) / 16) * 8; }
__host__ __device__ __forceinline__ int perm32(int rho) { const int n = rho >> 4, i = rho & 15; return 8 * (i >> 2) + 4 * n + (i & 3); }

struct Unit { const char* a; const char* b; int pm, pn, kind; };
struct Gemm { int K, lda, ldb; };
__device__ __forceinline__ void tile_map(int L, int nM, int nN, int& pm, int& pn) {
    const int nwg = nM * nN; int wgid = L;
    { const int q = nwg / NXCD, r = nwg % NXCD, xcd = wgid % NXCD, off = wgid / NXCD; wgid = (xcd < r ? xcd * (q + 1) : r * (q + 1) + (xcd - r) * q) + off; }
    const int nig = WGM * nN, gid = wgid / nig, fm = gid * WGM, gsz = (nM - fm) < WGM ? (nM - fm) : WGM;
    pm = fm + ((wgid % nig) % gsz); pn = (wgid % nig) / gsz;
}
typedef int i32x8 __attribute__((ext_vector_type(8)));
typedef int i32x4 __attribute__((ext_vector_type(4)));
template <class Epi, class Sched, bool GATHER = false, bool FP8 = false, int DBG = 0, bool DMAX = false>
__device__ __forceinline__ void gemm_phase(LAS unsigned char* lds, const Gemm g, const Sched& S, const Epi& E, const char* A0 = nullptr, const LAS unsigned short* gtab = nullptr, const bool skip_epi = false) {
    const int tid = threadIdx.x, wid = __builtin_amdgcn_readfirstlane(tid >> 6), lane = tid & 63, wr = wid >> 2, wc = wid & 3, fr = lane & 15, fq = lane >> 4;
    const int K = g.K, nt = K / BK;
    unsigned voffA[2], voffB[2]; int gR[2], gC[2];
#pragma unroll
    for (int i = 0; i < 2; ++i) { int R, C; if constexpr (FP8) stage_rc8(tid * 16 + i * 8192, R, C); else stage_rc(tid * 16 + i * 8192, R, C); const int Rb = Epi::PERM ? ((R & ~31) + perm32(R & 31)) : R; gR[i] = R; gC[i] = C * 2;
        voffA[i] = (unsigned)(R * g.lda + C) * 2u; voffB[i] = (unsigned)(Rb * g.ldb + C) * 2u; }
    unsigned gaC[2][2], gaN[2][2];
#define PG8_GA(ga, slot) do { _Pragma("unroll") for (int _h = 0; _h < 2; ++_h) _Pragma("unroll") for (int _i = 0; _i < 2; ++_i) \
        ga[_h][_i] = (unsigned)gtab[(slot) * 256 + _h * 128 + gR[_i]] * (unsigned)(g.lda * 2) + (unsigned)gC[_i]; } while (0)
#define PG8_STAGEA(bufoff, h, kofs, nx) do { if constexpr (GATHER) { const char* _gb = A0 + (kofs); asm volatile("" : "+s"(_gb)); _Pragma("unroll") for (int _i = 0; _i < 2; ++_i) \
        __builtin_amdgcn_global_load_lds((const unsigned*)(_gb + ((nx) ? gaN[h][_i] : gaC[h][_i])), (LAS unsigned*)(lds + (bufoff) + ldsw + _i * 8192), 16, 0, 0); } \
    else { PG8_STAGE(bufoff, ((nx) ? nA : cA) + (kofs) + (h) * hstepA, voffA); } } while (0)
    const size_t kstep = (size_t)(BK * 2);
    const size_t hstepA = (size_t)HALF * g.lda * 2, hstepB = (size_t)HALF * g.ldb * 2;
    const unsigned ldsw = (unsigned)wid * 1024u;
    const int aoff = lds_byte(wr * 64 + fr, fq * 8), boff = lds_byte(wc * 32 + fr, fq * 8);
    const int aoff80 = lds_byte8(wr * 64 + fr, 2 * fq), aoff81 = lds_byte8(wr * 64 + fr, 2 * fq + 1), boff80 = lds_byte8(wc * 32 + fr, 2 * fq), boff81 = lds_byte8(wc * 32 + fr, 2 * fq + 1);
#define PG8_SA(b, h) (((b) * 2 + (h)) * HTB)
#define PG8_SB(b, h) ((4 + (b) * 2 + (h)) * HTB)
#define PG8_STAGE(bufoff, gbase, voff) do { const char* _gb = (const char*)(gbase); asm volatile("" : "+s"(_gb)); _Pragma("unroll") for (int _i = 0; _i < 2; ++_i) \
        __builtin_amdgcn_global_load_lds((const unsigned*)(_gb + (voff)[_i]), (LAS unsigned*)(lds + (bufoff) + ldsw + _i * 8192), 16, 0, 0); } while (0)
#define PG8_FRAG8(dst, p0, p1) do { const i32x4 _lo = *(const LAS i32x4*)(p0), _hi = *(const LAS i32x4*)(p1); dst = __builtin_shufflevector(_lo, _hi, 0, 1, 2, 3, 4, 5, 6, 7); } while (0)
#define PG8_LDA(dst, b, h) do { if constexpr (DBG == 2) { } else if constexpr (FP8) { _Pragma("unroll") for (int m = 0; m < 4; ++m) PG8_FRAG8(dst##8[m], lds + PG8_SA(b, h) + aoff80 + m * 2048, lds + PG8_SA(b, h) + aoff81 + m * 2048); } \
    else { _Pragma("unroll") for (int m = 0; m < 4; ++m) _Pragma("unroll") for (int k = 0; k < 2; ++k) dst[m][k] = *(const LAS bf16x8*)(lds + PG8_SA(b, h) + aoff + m * 2048 + k * 1024); } } while (0)
#define PG8_LDB(dst, b, h) do { if constexpr (DBG == 2) { } else if constexpr (FP8) { _Pragma("unroll") for (int n = 0; n < 2; ++n) PG8_FRAG8(dst##8[n], lds + PG8_SB(b, h) + boff80 + n * 2048, lds + PG8_SB(b, h) + boff81 + n * 2048); } \
    else { _Pragma("unroll") for (int n = 0; n < 2; ++n) _Pragma("unroll") for (int k = 0; k < 2; ++k) dst[n][k] = *(const LAS bf16x8*)(lds + PG8_SB(b, h) + boff + n * 2048 + k * 1024); } } while (0)
#define PG8_MMA(ai, bj, At, Bt) do { __builtin_amdgcn_s_setprio(1); if constexpr (DBG == 1) { _Pragma("unroll") for (int m = 0; m < 4; ++m) asm volatile("" :: "v"(At##8[m])); _Pragma("unroll") for (int n = 0; n < 2; ++n) asm volatile("" :: "v"(Bt##8[n])); } else if constexpr (FP8) { _Pragma("unroll") for (int m = 0; m < 4; ++m) _Pragma("unroll") for (int n = 0; n < 2; ++n) \
        asm volatile("v_mfma_scale_f32_16x16x128_f8f6f4 %0, %1, %2, %0, %3, %3 op_sel_hi:[0,0,0]" : "+v"(acc[ai][bj][m][n]) : "v"(Bt##8[n]), "v"(At##8[m]), "v"(sc8)); } \
    else { _Pragma("unroll") for (int m = 0; m < 4; ++m) _Pragma("unroll") for (int n = 0; n < 2; ++n) _Pragma("unroll") for (int k = 0; k < 2; ++k) \
        acc[ai][bj][m][n] = __builtin_amdgcn_mfma_f32_16x16x32_bf16(Bt[n][k], At[m][k], acc[ai][bj][m][n], 0, 0, 0); } __builtin_amdgcn_s_setprio(0); } while (0)
#define PG8_MF8(ai, bj, At, Bt, m, n) asm volatile("v_mfma_scale_f32_16x16x128_f8f6f4 %0, %1, %2, %0, %3, %3 op_sel_hi:[0,0,0]" : "+v"(acc[ai][bj][m][n]) : "v"(Bt##8[n]), "v"(At##8[m]), "v"(sc8))
#define PG8_MMAX(ai, bj, At, Bt, X1, X2) do { __builtin_amdgcn_s_setprio(1); PG8_MF8(ai, bj, At, Bt, 0, 0); PG8_MF8(ai, bj, At, Bt, 0, 1); X1; PG8_MF8(ai, bj, At, Bt, 1, 0); PG8_MF8(ai, bj, At, Bt, 1, 1); \
        PG8_MF8(ai, bj, At, Bt, 2, 0); PG8_MF8(ai, bj, At, Bt, 2, 1); X2; PG8_MF8(ai, bj, At, Bt, 3, 0); PG8_MF8(ai, bj, At, Bt, 3, 1); __builtin_amdgcn_s_setprio(0); } while (0)
#define PG8_WAIT_V(n) asm volatile("s_waitcnt vmcnt(" #n ")" ::: "memory")
#define PG8_WAIT_L(n) asm volatile("s_waitcnt lgkmcnt(" #n ")" ::: "memory")
#define PG8_BAR __builtin_amdgcn_s_barrier()
#define PG8_SCHED __builtin_amdgcn_sched_barrier(0)
    Unit cur, nxt; int ui = 0;
    if (!S.next(0, cur)) return;
    f32x4 acc[2][2][4][2];
#pragma unroll
    for (int a = 0; a < 2; ++a)
#pragma unroll
        for (int b = 0; b < 2; ++b)
#pragma unroll
            for (int m = 0; m < 4; ++m)
#pragma unroll
                for (int n = 0; n < 2; ++n) acc[a][b][m][n] = (f32x4){0.f, 0.f, 0.f, 0.f};
    bf16x8 At[4][2], B0[2][2], B1[2][2];
    i32x8 At8[4], B08[2], B18[2];
    if constexpr (DBG == 2) {
#pragma unroll
        for (int m = 0; m < 4; ++m) { At8[m] = (i32x8){0, 0, 0, 0, 0, 0, 0, 0}; asm volatile("" : "+v"(At8[m])); }
#pragma unroll
        for (int n = 0; n < 2; ++n) { B08[n] = (i32x8){0, 0, 0, 0, 0, 0, 0, 0}; B18[n] = B08[n]; asm volatile("" : "+v"(B08[n]), "+v"(B18[n])); } }
    const int sc8 = 0x7f7f7f7f;
    const char* cA = cur.a; const char* cB = cur.b; const char* nA = cA;
    if constexpr (GATHER) { PG8_GA(gaC, 0); }
    {
        PG8_STAGE(PG8_SB(0, 0), cB, voffB); PG8_STAGE(PG8_SB(0, 1), cB + hstepB, voffB); PG8_STAGEA(PG8_SA(0, 0), 0, (size_t)0, false); PG8_STAGEA(PG8_SA(0, 1), 1, (size_t)0, false);
        if (wr == 1) PG8_BAR;
        PG8_WAIT_V(2); PG8_BAR;
        PG8_STAGE(PG8_SB(1, 0), cB + kstep, voffB); PG8_STAGEA(PG8_SA(1, 0), 0, kstep, false); PG8_STAGE(PG8_SB(1, 1), cB + hstepB + kstep, voffB);
        PG8_WAIT_V(6); PG8_BAR;
    }
    for (;;) {
        const bool has_next = S.next(ui + 1, nxt);
        nA = has_next ? nxt.a : cA; const char* nB = has_next ? nxt.b : cB;
        if constexpr (GATHER) { if (has_next) { PG8_GA(gaN, ui + 1); } else {
#pragma unroll
            for (int _h = 0; _h < 2; ++_h)
#pragma unroll
                for (int _i = 0; _i < 2; ++_i) gaN[_h][_i] = gaC[_h][_i]; } }
        for (int t = 0; t < nt; t += 2) {
            const bool last = (t == nt - 2);
            const size_t k1 = (size_t)(t + 1) * kstep, k2 = last ? (size_t)0 : (size_t)(t + 2) * kstep, k3 = k2 + kstep;
            const char* b2 = last ? nB : cB + (size_t)(t + 2) * kstep;
            const char* b3 = b2 + kstep;
            if constexpr (FP8 && DMAX) {
            PG8_LDB(B0, 0, 0); PG8_LDB(B1, 0, 1); PG8_SCHED; PG8_LDA(At, 0, 0); PG8_STAGEA(PG8_SA(1, 1), 1, k1, false);
            PG8_WAIT_V(8); PG8_WAIT_L(0); PG8_BAR; PG8_MMAX(0, 0, At, B0, (void)0, (void)0); PG8_MMAX(0, 1, At, B1, (void)0, (void)0); PG8_BAR; PG8_SCHED;
            PG8_LDA(At, 0, 1); PG8_STAGE(PG8_SB(0, 0), b2, voffB); PG8_STAGEA(PG8_SA(0, 0), 0, k2, last);
            PG8_WAIT_V(6); PG8_WAIT_L(0); PG8_BAR; PG8_MMAX(1, 0, At, B0, PG8_STAGE(PG8_SB(0, 1), b2 + hstepB, voffB), (void)0); PG8_MMAX(1, 1, At, B1, (void)0, (void)0); PG8_BAR; PG8_SCHED;
            PG8_LDB(B0, 1, 0); PG8_LDB(B1, 1, 1); PG8_SCHED; PG8_LDA(At, 1, 0); PG8_STAGEA(PG8_SA(0, 1), 1, k2, last);
            PG8_WAIT_V(8); PG8_WAIT_L(0); PG8_BAR; PG8_MMAX(0, 0, At, B0, (void)0, (void)0); PG8_MMAX(0, 1, At, B1, (void)0, (void)0); PG8_BAR; PG8_SCHED;
            PG8_LDA(At, 1, 1); PG8_STAGE(PG8_SB(1, 0), b3, voffB); PG8_STAGEA(PG8_SA(1, 0), 0, k3, last);
            PG8_WAIT_V(6); PG8_WAIT_L(0); PG8_BAR; PG8_MMAX(1, 0, At, B0, PG8_STAGE(PG8_SB(1, 1), b3 + hstepB, voffB), (void)0); PG8_MMAX(1, 1, At, B1, (void)0, (void)0); PG8_BAR; PG8_SCHED;
            continue; }
            PG8_STAGEA(PG8_SA(1, 1), 1, k1, false); PG8_SCHED; PG8_LDB(B0, 0, 0); PG8_LDB(B1, 0, 1); PG8_SCHED; PG8_LDA(At, 0, 0);
            PG8_WAIT_V(8); PG8_WAIT_L(0); PG8_BAR; PG8_MMA(0, 0, At, B0); PG8_MMA(0, 1, At, B1); PG8_BAR; PG8_SCHED;
            PG8_STAGE(PG8_SB(0, 0), b2, voffB); PG8_STAGE(PG8_SB(0, 1), b2 + hstepB, voffB); PG8_STAGEA(PG8_SA(0, 0), 0, k2, last); PG8_SCHED; PG8_LDA(At, 0, 1);
            PG8_WAIT_V(8); PG8_WAIT_L(0); PG8_BAR; PG8_MMA(1, 0, At, B0); PG8_MMA(1, 1, At, B1); PG8_BAR; PG8_SCHED;
            PG8_STAGEA(PG8_SA(0, 1), 1, k2, last); PG8_SCHED; PG8_LDB(B0, 1, 0); PG8_LDB(B1, 1, 1); PG8_SCHED; PG8_LDA(At, 1, 0);
            PG8_WAIT_V(8); PG8_WAIT_L(0); PG8_BAR; PG8_MMA(0, 0, At, B0); PG8_MMA(0, 1, At, B1); PG8_BAR; PG8_SCHED;
            PG8_STAGE(PG8_SB(1, 0), b3, voffB); PG8_STAGE(PG8_SB(1, 1), b3 + hstepB, voffB); PG8_STAGEA(PG8_SA(1, 0), 0, k3, last); PG8_SCHED; PG8_LDA(At, 1, 1);
            PG8_WAIT_V(8); PG8_WAIT_L(0); PG8_BAR; PG8_MMA(1, 0, At, B0); PG8_MMA(1, 1, At, B1); PG8_BAR; PG8_SCHED;
        }
        if (wr == 0) PG8_BAR;
        if constexpr (FP8) asm volatile("s_nop 15\n\ts_nop 15" ::: "memory");
        { int fr_ = fr, fq_ = fq; asm volatile("" : "+v"(fr_), "+v"(fq_));
          if (!skip_epi) E(acc, cur, wr, wc, fr_, fq_); }
        if (!has_next) break;
#pragma unroll
        for (int a = 0; a < 2; ++a)
#pragma unroll
            for (int b = 0; b < 2; ++b)
#pragma unroll
                for (int m = 0; m < 4; ++m)
#pragma unroll
                    for (int n = 0; n < 2; ++n) acc[a][b][m][n] = (f32x4){0.f, 0.f, 0.f, 0.f};
        cur = nxt; cA = nA; cB = nB; ++ui;
        if constexpr (GATHER) {
#pragma unroll
            for (int _h = 0; _h < 2; ++_h)
#pragma unroll
                for (int _i = 0; _i < 2; ++_i) gaC[_h][_i] = gaN[_h][_i]; }
        if (wr == 1) PG8_BAR;
    }
    PG8_WAIT_V(0);
    PG8_BAR;
#undef PG8_SA
#undef PG8_SB
#undef PG8_STAGE
#undef PG8_STAGEA
#undef PG8_GA
#undef PG8_LDA
#undef PG8_FRAG8
#undef PG8_LDB
#undef PG8_MMA
#undef PG8_WAIT_V
#undef PG8_WAIT_L
#undef PG8_BAR
#undef PG8_SCHED
}

constexpr size_t al256(size_t x) { return (x + 255) & ~(size_t)255; }
constexpr int PMAX = T * 4 + NE * 256;
constexpr size_t WS_CTL = 0, CTL_BYTES = 1u << 20;
constexpr size_t WS_WIN_T  = CTL_BYTES;
constexpr size_t WS_WK1_T  = WS_WIN_T + al256((size_t)9984 * 2048 * 2);
constexpr size_t WS_WV1_T  = WS_WK1_T + al256((size_t)256 * 4096 * 2);
constexpr size_t WS_WPN_T  = WS_WV1_T + al256((size_t)256 * 4096 * 2);
constexpr size_t WS_WPM_T  = WS_WPN_T + al256((size_t)2048 * 1024 * 2);
constexpr size_t WS_WOUT_T = WS_WPM_T + al256((size_t)2048 * 1024 * 2);
constexpr size_t WS_WGU_T  = WS_WOUT_T + al256((size_t)2048 * 2048 * 2);
constexpr size_t WS_WDN_T  = WS_WGU_T + al256((size_t)NE * 4096 * 2048 * 2);
constexpr size_t WS_H      = WS_WDN_T + al256((size_t)NE * 2048 * 2048 * 2);
constexpr size_t WS_X1     = WS_H + al256((size_t)T * D * 2);
constexpr size_t WS_SELE   = WS_X1 + al256((size_t)T * D * 4);
constexpr size_t WS_SELW   = WS_SELE + al256((size_t)T * 4 * 4);
constexpr size_t WS_SELP   = WS_SELW + al256((size_t)T * 4 * 4);
constexpr size_t WS_ROWDST = WS_SELP + al256((size_t)T * 4 * 4);
constexpr size_t WS_ROWW   = WS_ROWDST + al256((size_t)NE * T * 4);
constexpr size_t WS_H8     = WS_ROWW + al256((size_t)NE * T * 4);
constexpr size_t WS_WGM8   = WS_H8 + al256((size_t)T * D);
constexpr size_t WS_U0     = WS_WGM8 + al256((size_t)4096 * 2048);
constexpr size_t WS_QN     = WS_U0;
constexpr size_t HB2 = al256((size_t)T * 2 * HD * 2 + 65536);
constexpr size_t HB8 = al256((size_t)T * 8 * HD * 2);
constexpr size_t WS_KCMP   = WS_QN + HB8;
constexpr size_t WS_VCMP   = WS_KCMP + HB2;
constexpr size_t WS_KSLC   = WS_VCMP + HB2;
constexpr size_t WS_KWIN   = WS_KSLC + HB2;
constexpr size_t WS_VSLC   = WS_KWIN + HB2;
constexpr size_t WS_VWIN   = WS_VSLC + HB2;
constexpr size_t WS_MQ     = WS_VWIN + HB2;
constexpr size_t WS_MK     = WS_MQ + HB8;
constexpr size_t WS_MV     = WS_MK + HB8;
constexpr size_t WS_GN     = WS_MV + HB8;
constexpr size_t WS_GM     = WS_GN + al256((size_t)T * 24 * 4);
constexpr size_t WS_CS     = WS_GM + al256((size_t)T * 4096 * 2);
constexpr size_t WS_HIDP   = WS_CS + al256((size_t)T * 32 * 4);
constexpr size_t WS_PEB    = WS_HIDP + al256((size_t)2 * 4 * 2048 * 256 * 4);
constexpr size_t WS_KC     = WS_PEB + al256(2 * 256 * 4);
constexpr size_t WS_VC     = WS_KC + al256((size_t)8 * 4 * 8192 * 2);
constexpr size_t WS_KMEAN  = WS_VC + al256((size_t)8 * 4 * 8192 * 2);
constexpr size_t WS_MSEL   = WS_KMEAN + al256((size_t)NB * 8 * 16 * HD * 4);
constexpr size_t WS_MMOBA  = WS_MSEL + al256((size_t)NB * 2 * S * 8);
constexpr size_t WS_OCMP   = WS_MMOBA + al256((size_t)NB * 8 * S * 8);
constexpr size_t WS_OWIN   = WS_OCMP + al256((size_t)T * 1024 * 4);
constexpr size_t WS_OA     = WS_OWIN + al256((size_t)T * 1024 * 4);
constexpr size_t WS_OB     = WS_OA + al256((size_t)T * 1024 * 2);
constexpr size_t WS_MIXP   = WS_OB + al256((size_t)T * 1024 * 2);
constexpr size_t WS_MIX    = WS_MIXP + al256((size_t)T * D * 4);
constexpr size_t WS_ATT_END = WS_MIX + al256((size_t)T * D * 2);
constexpr size_t WS_XPAD   = WS_U0;
constexpr size_t WS_ACT    = WS_XPAD + al256((size_t)PMAX * D * 2);
constexpr size_t WS_YS     = WS_ACT + al256((size_t)PMAX * FF * 2);
constexpr size_t WS_MOE_END = WS_YS + al256((size_t)T * 4 * D * 2);
constexpr size_t WS_END    = WS_ATT_END > WS_MOE_END ? WS_ATT_END : WS_MOE_END;
constexpr int CW_BAR = 4096;
constexpr int CW_CNT = 16384;
constexpr int CW_Q   = 16384 + 64 * 32;
constexpr int RING_BYTES = 131072, MISC_OFF = 131072, LDS_BYTES = 147456;

constexpr float A8_SCALE = 64.0f;
constexpr float YS_SCALE = 32.0f;
constexpr float W8_SCALE = 64.0f;
struct Args { const float* in[21]; float* out; unsigned char* ws; int ph_lo, ph_hi; };

template <class RowMap>
__device__ __forceinline__ void transpose_item(const float* __restrict__ W, int K, int N, bf16* WT, const RowMap& rm, LAS float* scr, int item, int lane, int nblk_use = 0) {
    const int nblk = nblk_use ? nblk_use : (N + 31) / 32, kb = item / nblk, nb = item % nblk, k0 = 64 * kb, n0 = 32 * nb;
    const bool cok = (n0 + (lane & 31)) < N;
#pragma unroll 8
    for (int i = 0; i < 32; ++i) { const int kk = 2 * i + (lane >> 5); scr[kk * 33 + (lane & 31)] = cok ? W[(size_t)(k0 + kk) * N + n0 + (lane & 31)] : 0.f; }
    asm volatile("s_waitcnt lgkmcnt(0)" ::: "memory");
    const int c = lane & 7;
#pragma unroll
    for (int j = 0; j < 4; ++j) { const int n = (lane >> 3) + 8 * j; const LAS float* s = scr + (8 * c) * 33 + n;
        u32x4 o; o.x = pk2(s[0 * 33], s[1 * 33]); o.y = pk2(s[2 * 33], s[3 * 33]); o.z = pk2(s[4 * 33], s[5 * 33]); o.w = pk2(s[6 * 33], s[7 * 33]);
        const long dr = (n0 + n) < N ? rm(n0 + n) : -1;
        if (dr >= 0) *(u32x4*)(WT + (size_t)dr * K + k0 + 8 * c) = o; }
    asm volatile("s_waitcnt lgkmcnt(0)" ::: "memory");
}
__device__ __forceinline__ unsigned pk4_fp8(float a, float b, float c, float d) { int p = __builtin_amdgcn_cvt_pk_fp8_f32(a, b, 0, false); p = __builtin_amdgcn_cvt_pk_fp8_f32(c, d, p, true); return (unsigned)p; }
struct ConvItem { const float* src; unsigned char* dst; int N, n0, gu; long roff; };
__device__ __forceinline__ ConvItem conv_item(int it, const float* wgu, const float* wdn, unsigned char* wgu8, unsigned char* wdn8, int lane) {
    constexpr int I_GU = 16 * 128, I_DN = 16 * 64; ConvItem c; int e, r, nblk;
    if (it < NE * I_GU) { e = it / I_GU; r = it % I_GU; nblk = 128; c.N = 2 * FF; c.gu = 1; c.roff = (long)e * 4096; c.src = wgu + (size_t)e * D * 2 * FF; c.dst = wgu8; }
    else { it -= NE * I_GU; e = it / I_DN; r = it % I_DN; nblk = 64; c.N = D; c.gu = 0; c.roff = (long)e * 2048; c.src = wdn + (size_t)e * FF * D; c.dst = wdn8; }
    const int kb = r / nblk, nb = r % nblk; c.n0 = 32 * nb;
    c.src += (size_t)(128 * kb + (lane >> 3)) * c.N + c.n0 + 4 * (lane & 7); c.dst += 128 * kb + 16 * (lane & 7);
    return c;
}
#define CONV_LOAD(v, c) do { _Pragma("unroll") for (int _i = 0; _i < 16; ++_i) v[_i] = __builtin_nontemporal_load((const f32x4*)((c).src + (size_t)(8 * _i) * (c).N)); } while (0)
#define CONV_PROC(v, c) do { const int _lr = lane >> 3, _lg = lane & 7; \
    _Pragma("unroll") for (int _i = 0; _i < 16; ++_i) { const int _k = 8 * _i + _lr; *(LAS f32x4*)(scr + _k * 32 + 4 * (_lg ^ (((_k >> 4) ^ _k) & 7))) = v[_i] * W8_SCALE; } \
    asm volatile("s_waitcnt lgkmcnt(0)" ::: "memory"); \
    _Pragma("unroll") for (int _jj = 0; _jj < 4; ++_jj) { const int _n = _lr + 8 * _jj; float _f[16]; \
        _Pragma("unroll") for (int _j = 0; _j < 16; ++_j) { const int _k = 16 * _lg + _j; _f[_j] = scr[_k * 32 + 4 * ((_n >> 2) ^ (((_k >> 4) ^ _k) & 7)) + (_n & 3)]; } \
        u32x4 _o; _o.x = pk4_fp8(_f[0], _f[1], _f[2], _f[3]); _o.y = pk4_fp8(_f[4], _f[5], _f[6], _f[7]); _o.z = pk4_fp8(_f[8], _f[9], _f[10], _f[11]); _o.w = pk4_fp8(_f[12], _f[13], _f[14], _f[15]); \
        const int _nn = (c).n0 + _n; const long _dr = (c).gu ? ((c).roff + ((_nn >= FF ? _nn - FF : _nn) >> 7) * 256 + (_nn >= FF ? 128 : 0) + (_nn & 127)) : ((c).roff + _nn); \
        *(u32x4*)((c).dst + (size_t)_dr * 2048) = _o; } \
    asm volatile("s_waitcnt lgkmcnt(0)" ::: "memory"); } while (0)
__device__ __forceinline__ ConvItem conv_item_gm(int it, const float* win, unsigned char* wgm8, int lane) {
    ConvItem c; const int kb = it >> 7, nb = it & 127; c.N = INW; c.gu = 0; c.roff = 0; c.n0 = 32 * nb;
    c.src = win + 5656 + (size_t)(128 * kb + (lane >> 3)) * INW + c.n0 + 4 * (lane & 7); c.dst = wgm8 + 128 * kb + 16 * (lane & 7); return c;
}
template <bool PIPE>
__device__ __forceinline__ int moe_convert(const float* wgu, const float* wdn, unsigned char* wgu8, unsigned char* wdn8, LAS float* scr, int first, int stride, int lane, int maxn) {
    constexpr int NTOT = NE * (16 * 128 + 16 * 64);
    int it = first; if (it >= NTOT || maxn <= 0) return it;
    const long lim = (long)first + (long)maxn * stride; const int end = lim < NTOT ? (int)lim : NTOT;
    if constexpr (!PIPE) { f32x4 va[16];
        for (; it < end; it += stride) { asm volatile("" : "+v"(lane)); const ConvItem ca = conv_item(it, wgu, wdn, wgu8, wdn8, lane); CONV_LOAD(va, ca); CONV_PROC(va, ca); }
        return it; }
    f32x4 va[16], vb[16];
    ConvItem ca = conv_item(it, wgu, wdn, wgu8, wdn8, lane), cb = ca; CONV_LOAD(va, ca);
    for (;;) {
        const int itb = it + stride; if (itb < end) { cb = conv_item(itb, wgu, wdn, wgu8, wdn8, lane); CONV_LOAD(vb, cb); }
        CONV_PROC(va, ca);
        if (itb >= end) return itb;
        const int ita = itb + stride; if (ita < end) { ca = conv_item(ita, wgu, wdn, wgu8, wdn8, lane); CONV_LOAD(va, ca); }
        CONV_PROC(vb, cb);
        if (ita >= end) return ita;
        it = ita;
    }
}
struct RmIdent { long off; __device__ long operator()(int n) const { return off + n; } };
struct RmWin { __device__ long operator()(int n) const {
    if (n < 1024) return n;
    if (n < 2560) { const int c = n - 1024, which = c >> 8, r = c & 255;
        return which == 0 ? 1024 + r : which == 1 ? 1280 + r : which == 2 ? 1536 + r : which == 3 ? 8448 + r : which == 4 ? 1792 + r : 8448 + 256 + r; }
    if (n < 2584) return 8192 + (n - 2560);
    if (n < 5656) { const int c = n - 2584, which = c >> 10, r = c & 1023; return which == 0 ? 2048 + r : which == 1 ? 3072 + r : 8448 + 512 + r; }
    return 4096 + (n - 5656); } };
__device__ __forceinline__ void conv_win_item(int it, const float* win, unsigned char* w8, LAS float* scr, int lane) {
    const int kb = it / 305, nb = it % 305, k0 = 128 * kb, n0 = 32 * nb, lr = lane >> 3, lg = lane & 7;
    const bool cok = n0 + 4 * lg < INW;
    f32x4 v[16];
#pragma unroll
    for (int i = 0; i < 16; ++i) v[i] = cok ? __builtin_nontemporal_load((const f32x4*)(win + (size_t)(k0 + lr + 8 * i) * INW + n0 + 4 * lg)) : (f32x4){0.f, 0.f, 0.f, 0.f};
#pragma unroll
    for (int i = 0; i < 16; ++i) { const int k = 8 * i + lr; *(LAS f32x4*)(scr + k * 32 + 4 * (lg ^ (((k >> 4) ^ k) & 7))) = v[i] * W8_SCALE; }
    asm volatile("s_waitcnt lgkmcnt(0)" ::: "memory");
#pragma unroll
    for (int jj = 0; jj < 4; ++jj) { const int n = lr + 8 * jj; float f[16];
#pragma unroll
        for (int j = 0; j < 16; ++j) { const int k = 16 * lg + j; f[j] = scr[k * 32 + 4 * ((n >> 2) ^ (((k >> 4) ^ k) & 7)) + (n & 3)]; }
        u32x4 o; o.x = pk4_fp8(f[0], f[1], f[2], f[3]); o.y = pk4_fp8(f[4], f[5], f[6], f[7]); o.z = pk4_fp8(f[8], f[9], f[10], f[11]); o.w = pk4_fp8(f[12], f[13], f[14], f[15]);
        if (n0 + n < INW) *(u32x4*)(w8 + (size_t)RmWin{}(n0 + n) * 2048 + k0 + 16 * lg) = o; }
    asm volatile("s_waitcnt lgkmcnt(0)" ::: "memory");
}
__device__ __forceinline__ void conv_plain_item(int it, const float* W, int K, int N, unsigned char* w8, LAS float* scr, int lane) {
    const int nblk = N / 32, kb = it / nblk, nb = it % nblk, k0 = 128 * kb, n0 = 32 * nb, lr = lane >> 3, lg = lane & 7;
    f32x4 v[16];
#pragma unroll
    for (int i = 0; i < 16; ++i) v[i] = __builtin_nontemporal_load((const f32x4*)(W + (size_t)(k0 + lr + 8 * i) * N + n0 + 4 * lg));
#pragma unroll
    for (int i = 0; i < 16; ++i) { const int k = 8 * i + lr; *(LAS f32x4*)(scr + k * 32 + 4 * (lg ^ (((k >> 4) ^ k) & 7))) = v[i] * W8_SCALE; }
    asm volatile("s_waitcnt lgkmcnt(0)" ::: "memory");
#pragma unroll
    for (int jj = 0; jj < 4; ++jj) { const int n = lr + 8 * jj; float f[16];
#pragma unroll
        for (int j = 0; j < 16; ++j) { const int k = 16 * lg + j; f[j] = scr[k * 32 + 4 * ((n >> 2) ^ (((k >> 4) ^ k) & 7)) + (n & 3)]; }
        u32x4 o; o.x = pk4_fp8(f[0], f[1], f[2], f[3]); o.y = pk4_fp8(f[4], f[5], f[6], f[7]); o.z = pk4_fp8(f[8], f[9], f[10], f[11]); o.w = pk4_fp8(f[12], f[13], f[14], f[15]);
        *(u32x4*)(w8 + (size_t)(n0 + n) * K + k0 + 16 * lg) = o; }
    asm volatile("s_waitcnt lgkmcnt(0)" ::: "memory");
}
struct RmGu { long off; __device__ long operator()(int n) const { const int lin = n >= FF, j = lin ? n - FF : n; return off + (j >> 7) * 256 + lin * 128 + (j & 127); } };

struct EpiIn {
    static constexpr bool PERM = true;
    unsigned char* ws; const float* cs;
    __device__ __forceinline__ void operator()(const f32x4 (&acc)[2][2][4][2], const Unit& u, int wr, int wc, int fr, int fq) const {
        const int lane = threadIdx.x & 63;
        if (u.kind != 1) {
            const int pn = u.pn, tok0 = u.pm * 256; constexpr float usc = 1.0f / W8_SCALE;
            const bool is_rope = (pn < 4) || pn == 6 || pn == 7 || (pn >= 8 && pn < 16);
#pragma unroll
            for (int ai = 0; ai < 2; ++ai)
#pragma unroll
              for (int mh = 0; mh < 2; ++mh) { f32x4 csv[2][4];
                if (is_rope && wc == 0) {
#pragma unroll
                    for (int mm = 0; mm < 2; ++mm) { const float* cst = cs + (size_t)(tok0 + ai * 128 + wr * 64 + (2 * mh + mm) * 16 + fr) * 32 + 8 * (fq & 1);
                        csv[mm][0] = *(const f32x4*)cst; csv[mm][1] = *(const f32x4*)(cst + 4); csv[mm][2] = *(const f32x4*)(cst + 16); csv[mm][3] = *(const f32x4*)(cst + 20); } }
#pragma unroll
                for (int m = 2 * mh; m < 2 * mh + 2; ++m) {
                    const int t = tok0 + ai * 128 + wr * 64 + m * 16 + fr, b = t >> 12, s = t & (S - 1);
#pragma unroll
                    for (int bj = 0; bj < 2; ++bj) {
                        f32x4 v0 = acc[ai][bj][m][0] * usc, v1 = acc[ai][bj][m][1] * usc;
                        if (pn < 16) {
                            if (is_rope && wc == 0) {
                                f32x4 p0, p1;
#pragma unroll
                                for (int i = 0; i < 4; ++i) { p0[i] = __shfl_xor(v0[i], 32); p1[i] = __shfl_xor(v1[i], 32); }
                                const f32x4 c0 = csv[m & 1][0], c1 = csv[m & 1][1], s0 = csv[m & 1][2], s1 = csv[m & 1][3];
                                if (fq < 2) { v0 = v0 * c0 - p0 * s0; v1 = v1 * c1 - p1 * s1; }
                                else        { v0 = v0 * c0 + p0 * s0; v1 = v1 * c1 + p1 * s1; }
                            }
                            u32x4 w; w.x = pk2(v0[0], v0[1]); w.y = pk2(v0[2], v0[3]); w.z = pk2(v1[0], v1[1]); w.w = pk2(v1[2], v1[3]);
                            const int piece = 4 * wc + fq;
                            size_t off;
                            bf16* dst;
                            if (pn < 4) { dst = (bf16*)(ws + WS_QN); off = (((size_t)b * 8 + 2 * pn + bj) * S + s) * HD + piece * 8; }
                            else if (pn == 4) { dst = (bf16*)(ws + WS_KCMP); off = (((size_t)b * 2 + bj) * S + s) * HD + piece * 8; }
                            else if (pn == 5) { dst = (bf16*)(ws + WS_VCMP); off = (((size_t)b * 2 + bj) * S + s) * HD + piece * 8; }
                            else if (pn < 8) { dst = (bf16*)(ws + (pn == 6 ? WS_KSLC : WS_KWIN)); off = (((size_t)b * 2 + bj) * S + s) * HD + ((piece ^ (s & 15)) * 8); }
                            else if (pn < 12) { dst = (bf16*)(ws + WS_MQ); off = (((size_t)b * 8 + 2 * (pn - 8) + bj) * S + s) * HD + piece * 8; }
                            else { dst = (bf16*)(ws + WS_MK); off = (((size_t)b * 8 + 2 * (pn - 12) + bj) * S + s) * HD + ((piece ^ (s & 15)) * 8); }
                            *(u32x4*)(dst + off) = w;
                        } else if (pn < 32) {
                            unsigned q0[4], q1[4];
#pragma unroll
                            for (int i = 0; i < 4; ++i) { q0[i] = (unsigned)(255.0f * sigmoid_f(v0[i]) + 0.5f); q1[i] = (unsigned)(255.0f * sigmoid_f(v1[i]) + 0.5f); }
                            u32x2 w; w.x = q0[0] | (q0[1] << 8) | (q0[2] << 16) | (q0[3] << 24); w.y = q1[0] | (q1[1] << 8) | (q1[2] << 16) | (q1[3] << 24);
                            *(u32x2*)(ws + WS_GM + (size_t)t * 4096 + (pn - 16) * 256 + bj * 128 + wc * 32 + fq * 8) = w;
                        } else {
                            if (bj == 0 && wc == 0 && fq < 3) {
#pragma unroll
                                for (int i = 0; i < 4; ++i) { v0[i] = sigmoid_f(v0[i]); v1[i] = sigmoid_f(v1[i]); }
                                float* gp = (float*)(ws + WS_GN) + (size_t)t * 24 + fq * 8;
                                *(f32x4*)gp = v0; *(f32x4*)(gp + 4) = v1;
                            }
                        }
                    }
                } }
        } else {
            const int j = u.pm, tok0 = u.pn * 256;
#pragma unroll
            for (int ai = 0; ai < 2; ++ai) {
                bf16* dst; int nh, head;
                if (j == 0) { dst = (bf16*)(ws + WS_VSLC); nh = 2; head = ai; } else if (j == 1) { dst = (bf16*)(ws + WS_VWIN); nh = 2; head = ai; } else { dst = (bf16*)(ws + WS_MV); nh = 8; head = 2 * (j - 2) + ai; }
#pragma unroll
                for (int m = 0; m < 4; ++m) {
                    const int d = wr * 64 + m * 16 + fr;
#pragma unroll
                    for (int bj = 0; bj < 2; ++bj) {
                        const int t = tok0 + bj * 128 + wc * 32 + fq * 8, b = t >> 12, s = t & (S - 1);
                        const f32x4 v0 = acc[ai][bj][m][0] * (1.0f / W8_SCALE), v1 = acc[ai][bj][m][1] * (1.0f / W8_SCALE);
                        bf16* tp = dst + ((size_t)b * nh + head) * S * HD + (size_t)(s >> 6) * 8192 + (((s & 63) >> 2) * 128 + d) * 4;
                        u32x2 q0, q1; q0.x = pk2(v0[0], v0[1]); q0.y = pk2(v0[2], v0[3]); q1.x = pk2(v1[0], v1[1]); q1.y = pk2(v1[2], v1[3]);
                        *(u32x2*)tp = q0; *(u32x2*)(tp + 512) = q1;
                    }
                }
            }
        }
    }
};
struct SchedGm {
    int G, c; const char* Hp; const char* Wp;
    __device__ __forceinline__ bool next(int i, Unit& u) const { const int L = i * G + c; if (L >= 64 * 16) return false; int pj; tile_map(L, 64, 16, u.pm, pj); constexpr size_t ts = (size_t)256 * 2048;
        u.pn = 16 + pj; u.kind = 2; u.a = Hp + u.pm * ts; u.b = Wp + pj * ts; return true; }
};
struct SchedIn {
    int G, c; const char* Hp; const char* Wp; int lo, hi;
    __device__ __forceinline__ bool next(int i, Unit& u) const {
        if (lo + i >= hi) return false;
        int L = (lo + i) * G + c; constexpr size_t ts = (size_t)256 * 2048;
        if (L < 64 * 33) { tile_map(L, 64, 33, u.pm, u.pn); u.a = Hp + u.pm * ts; u.b = Wp + u.pn * ts; u.kind = 0; return true; }
        L -= 64 * 33;
        if (L < 6 * 64) { tile_map(L, 6, 64, u.pm, u.pn); u.a = Wp + (33 + u.pm) * ts; u.b = Hp + u.pn * ts; u.kind = 1; return true; }
        return false;
    }
};

#define ATT_C 0.12751743074602194f
#define ATT_MFMA(a, b, c) __builtin_amdgcn_mfma_f32_32x32x16_bf16((a), (b), (c), 0, 0, 0)
#define ATT_DMA(j, buf) do { const char* _kp = (const char*)kt + (size_t)(j) * 16384 + so; const char* _vp = (const char*)vt + (size_t)(j) * 16384 + so; \
    __builtin_amdgcn_global_load_lds((const unsigned*)_kp, (LAS unsigned*)(lds + (buf) * 16384 + wbase), 16, 0, 0); \
    __builtin_amdgcn_global_load_lds((const unsigned*)(_kp + 8192), (LAS unsigned*)(lds + (buf) * 16384 + 8192 + wbase), 16, 0, 0); \
    __builtin_amdgcn_global_load_lds((const unsigned*)_vp, (LAS unsigned*)(lds + 32768 + (buf) * 16384 + wbase), 16, 0, 0); \
    __builtin_amdgcn_global_load_lds((const unsigned*)(_vp + 8192), (LAS unsigned*)(lds + 32768 + (buf) * 16384 + 8192 + wbase), 16, 0, 0); } while (0)
#define ATT_SYNC() do { asm volatile("s_waitcnt vmcnt(0)" ::: "memory"); __syncthreads(); } while (0)
#define ATT_QK(buf) do { _Pragma("unroll") for (int _kh = 0; _kh < 2; ++_kh) { _Pragma("unroll") for (int _r = 0; _r < 16; ++_r) sacc[_kh][_r] = 0.f; \
    _Pragma("unroll") for (int _s = 0; _s < 8; ++_s) { const bf16x8 _a = *(const LAS bf16x8*)(lds + (buf) * 16384 + _kh * 8192 + kbase_l + (((2 * _s) ^ kx) << 4)); \
        sacc[_kh] = ATT_MFMA(_a, qf[_s], sacc[_kh]); } } } while (0)
#define ATT_MASK(lo_rel, hi_rel, bit) do { const bool _none = !(bit) || (hi_rel) < 0 || (lo_rel) > 63; const bool _full = (bit) && (lo_rel) <= 0 && (hi_rel) >= 63; \
    if (__all(_none || _full)) { const float _bias = _none ? -INFINITY : 0.f; \
        _Pragma("unroll") for (int _kh = 0; _kh < 2; ++_kh) _Pragma("unroll") for (int _r = 0; _r < 16; ++_r) sacc[_kh][_r] = __builtin_fmaf(sacc[_kh][_r], ATT_C, _bias); } \
    else { _Pragma("unroll") for (int _kh = 0; _kh < 2; ++_kh) _Pragma("unroll") for (int _r = 0; _r < 16; ++_r) { const int _k = 32 * _kh + (_r & 3) + 8 * (_r >> 2) + 4 * h; \
        const bool _ok = (bit) && _k >= (lo_rel) && _k <= (hi_rel); sacc[_kh][_r] = _ok ? sacc[_kh][_r] * ATT_C : -INFINITY; } } } while (0)
#define ATT_TILEMAX(mt) do { float _m = sacc[0][0]; _Pragma("unroll") for (int _r = 1; _r < 16; ++_r) _m = fmaxf(_m, sacc[0][_r]); \
    _Pragma("unroll") for (int _r = 0; _r < 16; ++_r) _m = fmaxf(_m, sacc[1][_r]); mt = fmaxf(_m, __shfl_xor(_m, 32)); } while (0)
#define ATT_PV(buf) do { _Pragma("unroll") for (int _kh = 0; _kh < 2; ++_kh) _Pragma("unroll") for (int _s = 0; _s < 2; ++_s) { \
    u32x4 _p; _p.x = pk2(sacc[_kh][8 * _s + 0], sacc[_kh][8 * _s + 1]); _p.y = pk2(sacc[_kh][8 * _s + 2], sacc[_kh][8 * _s + 3]); \
    _p.z = pk2(sacc[_kh][8 * _s + 4], sacc[_kh][8 * _s + 5]); _p.w = pk2(sacc[_kh][8 * _s + 6], sacc[_kh][8 * _s + 7]); const bf16x8 _pf = __builtin_bit_cast(bf16x8, _p); \
    _Pragma("unroll") for (int _db = 0; _db < 4; ++_db) { const LAS unsigned char* _vp = lds + 32768 + (buf) * 16384 + vbase_l + (8 * _kh + 4 * _s) * 1024 + _db * 256; \
        const u32x2 _v0 = *(const LAS u32x2*)_vp, _v1 = *(const LAS u32x2*)(_vp + 2048); u32x4 _v; _v.x = _v0.x; _v.y = _v0.y; _v.z = _v1.x; _v.w = _v1.y; \
        oacc[_db] = ATT_MFMA(__builtin_bit_cast(bf16x8, _v), _pf, oacc[_db]); } } } while (0)

#define ATT_DMA_KV(j, kb, vb) do { const char* _kp = (const char*)kt + (size_t)(j) * 16384 + so; const char* _vp = (const char*)vt + (size_t)(j) * 16384 + so; \
    __builtin_amdgcn_global_load_lds((const unsigned*)_kp, (LAS unsigned*)(lds + (kb) * 16384 + wbase), 16, 0, 0); \
    __builtin_amdgcn_global_load_lds((const unsigned*)(_kp + 8192), (LAS unsigned*)(lds + (kb) * 16384 + 8192 + wbase), 16, 0, 0); \
    __builtin_amdgcn_global_load_lds((const unsigned*)_vp, (LAS unsigned*)(lds + 32768 + (vb) * 16384 + wbase), 16, 0, 0); \
    __builtin_amdgcn_global_load_lds((const unsigned*)(_vp + 8192), (LAS unsigned*)(lds + 32768 + (vb) * 16384 + 8192 + wbase), 16, 0, 0); } while (0)
#define ATT_DMA_KV3(j, st) do { const char* _kp = (const char*)kt + (size_t)(j) * 16384 + so; const char* _vp = (const char*)vt + (size_t)(j) * 16384 + so; \
    __builtin_amdgcn_global_load_lds((const unsigned*)_kp, (LAS unsigned*)(lds + (st) * 16384 + wbase), 16, 0, 0); \
    __builtin_amdgcn_global_load_lds((const unsigned*)(_kp + 8192), (LAS unsigned*)(lds + (st) * 16384 + 8192 + wbase), 16, 0, 0); \
    __builtin_amdgcn_global_load_lds((const unsigned*)_vp, (LAS unsigned*)(lds + 49152 + (st) * 16384 + wbase), 16, 0, 0); \
    __builtin_amdgcn_global_load_lds((const unsigned*)(_vp + 8192), (LAS unsigned*)(lds + 49152 + (st) * 16384 + 8192 + wbase), 16, 0, 0); } while (0)
#define ATT_QK3(buf) ATT_QK(buf)
#define ATT_PVP3(vb) do { _Pragma("unroll") for (int _ks = 0; _ks < 4; ++_ks) _Pragma("unroll") for (int _db = 0; _db < 4; ++_db) { const LAS unsigned char* _vp = lds + 49152 + (vb) * 16384 + vbase_l + (4 * _ks) * 1024 + _db * 256; \
        const u32x2 _v0 = *(const LAS u32x2*)_vp, _v1 = *(const LAS u32x2*)(_vp + 2048); u32x4 _v; _v.x = _v0.x; _v.y = _v0.y; _v.z = _v1.x; _v.w = _v1.y; \
        oacc[_db] = ATT_MFMA(__builtin_bit_cast(bf16x8, _v), pf[_ks], oacc[_db]); } } while (0)
#define ATT_PACKP() do { _Pragma("unroll") for (int _kh = 0; _kh < 2; ++_kh) _Pragma("unroll") for (int _s = 0; _s < 2; ++_s) { u32x4 _p; _p.x = pk2(sacc[_kh][8 * _s + 0], sacc[_kh][8 * _s + 1]); _p.y = pk2(sacc[_kh][8 * _s + 2], sacc[_kh][8 * _s + 3]); \
    _p.z = pk2(sacc[_kh][8 * _s + 4], sacc[_kh][8 * _s + 5]); _p.w = pk2(sacc[_kh][8 * _s + 6], sacc[_kh][8 * _s + 7]); pf[2 * _kh + _s] = __builtin_bit_cast(bf16x8, _p); } } while (0)
#define ATT_PVP(vb) do { _Pragma("unroll") for (int _ks = 0; _ks < 4; ++_ks) _Pragma("unroll") for (int _db = 0; _db < 4; ++_db) { const LAS unsigned char* _vp = lds + 32768 + (vb) * 16384 + vbase_l + (4 * _ks) * 1024 + _db * 256; \
        const u32x2 _v0 = *(const LAS u32x2*)_vp, _v1 = *(const LAS u32x2*)(_vp + 2048); u32x4 _v; _v.x = _v0.x; _v.y = _v0.y; _v.z = _v1.x; _v.w = _v1.y; \
        oacc[_db] = ATT_MFMA(__builtin_bit_cast(bf16x8, _v), pf[_ks], oacc[_db]); } } while (0)
template <int MODE, bool SKEW>
__device__ __forceinline__ void attn_item(LAS unsigned char* lds, const bf16* qrow, const bf16* kt, const bf16* vt, u64 mask, int tq, int W, int tile_lo, int tile_hi,
                                          void* o0, const bf16* o1, const bf16* o2, float g0, float g1, float g2) {
    int tid = threadIdx.x; asm volatile("" : "+v"(tid));
    const int lane = tid & 63, r32 = lane & 31, h = lane >> 5;
    const unsigned so = (unsigned)tid * 16u;
    const unsigned kbase_l = (unsigned)r32 * 256u, kx = (unsigned)(h ^ (lane & 15)), vbase_l = (unsigned)(h * 1024 + r32 * 8);
    bf16x8 qf[8];
#pragma unroll
    for (int s = 0; s < 8; ++s) qf[s] = *(const bf16x8*)(qrow + 16 * s + 8 * h);
    f32x16 oacc[4], sacc[2]; bf16x8 pf[4];
#pragma unroll
    for (int d = 0; d < 4; ++d)
#pragma unroll
        for (int r = 0; r < 16; ++r) oacc[d][r] = 0.f;
    float m_run = 0.f, l_run = 0.f;
    const int khi = tq, klo = (tq - W + 1) > 0 ? (tq - W + 1) : 0;
    const int wv_ = __builtin_amdgcn_readfirstlane(tid >> 6);
    const unsigned wbase = (unsigned)wv_ * 1024u;
    if (SKEW) { ATT_DMA_KV3(tile_lo, 0); if (tile_lo + 1 < tile_hi) { ATT_DMA_KV3(tile_lo + 1, 1); asm volatile("s_waitcnt vmcnt(4)" ::: "memory"); } else asm volatile("s_waitcnt vmcnt(0)" ::: "memory"); __builtin_amdgcn_s_barrier(); asm volatile("" ::: "memory"); }
    else { ATT_DMA_KV(tile_lo, 0, 0); ATT_SYNC(); }
    int kb = 0, vb = 0;
    for (int j = tile_lo; j < tile_hi; ++j) {
        const int kbn = SKEW ? (kb == 2 ? 0 : kb + 1) : (kb ^ 1), vbn = kbn;
        if (SKEW) { if (j + 2 < tile_hi) ATT_DMA_KV3(j + 2, (kbn == 2 ? 0 : kbn + 1)); }
        else { if (j + 1 < tile_hi) ATT_DMA_KV(j + 1, kbn, vbn); }
        const bool bit = (mask >> j) & 1ull;
        const int lo_rel = klo - 64 * j, hi_rel = khi - 64 * j;
        const bool none = !bit || hi_rel < 0 || lo_rel > 63;
        if (!__all(none)) {
            if (SKEW) { ATT_QK3(kb); } else { ATT_QK(kb); }
            float ls = 0.f;
            if (((j - tile_lo) & 3) == 0) {
                ATT_MASK(lo_rel, hi_rel, bit);
                float mt; ATT_TILEMAX(mt); const bool upd = mt > m_run + 8.0f;
                if (__any(upd)) {
                    const float m_new = upd ? mt : m_run, alpha = __builtin_amdgcn_exp2f(m_run - m_new);
                    l_run *= alpha; m_run = m_new;
#pragma unroll
                    for (int d = 0; d < 4; ++d)
#pragma unroll
                        for (int r = 0; r < 16; ++r) oacc[d][r] *= alpha;
                }
#pragma unroll
                for (int kh = 0; kh < 2; ++kh)
#pragma unroll
                    for (int r = 0; r < 16; ++r) { const float p = __builtin_amdgcn_exp2f(sacc[kh][r] - m_run); sacc[kh][r] = p; ls += p; }
            } else {
                const bool full_ = bit && lo_rel <= 0 && hi_rel >= 63;
                if (__all(none || full_)) { const float bm = none ? -INFINITY : -m_run;
#pragma unroll
                    for (int kh = 0; kh < 2; ++kh)
#pragma unroll
                        for (int r = 0; r < 16; ++r) { const float p = __builtin_amdgcn_exp2f(__builtin_fmaf(sacc[kh][r], ATT_C, bm)); sacc[kh][r] = p; ls += p; } }
                else {
#pragma unroll
                    for (int kh = 0; kh < 2; ++kh)
#pragma unroll
                        for (int r = 0; r < 16; ++r) { const int k_ = 32 * kh + (r & 3) + 8 * (r >> 2) + 4 * h; const bool ok_ = bit && k_ >= lo_rel && k_ <= hi_rel;
                            const float p = ok_ ? __builtin_amdgcn_exp2f(__builtin_fmaf(sacc[kh][r], ATT_C, -m_run)) : 0.f; sacc[kh][r] = p; ls += p; } }
            }
            l_run += ls;
            ATT_PACKP();
            if (SKEW) { ATT_PVP3(vb); } else { ATT_PVP(vb); }
        }
        if (SKEW) { if (j + 2 < tile_hi) asm volatile("s_waitcnt vmcnt(4) lgkmcnt(0)" ::: "memory"); else asm volatile("s_waitcnt vmcnt(0) lgkmcnt(0)" ::: "memory"); __builtin_amdgcn_s_barrier(); asm volatile("" ::: "memory"); }
        else ATT_SYNC();
        kb = kbn; vb = vbn;
    }
    const float l_tot = l_run + __shfl_xor(l_run, 32);
    const float inv = l_tot > 0.f ? 1.0f / l_tot : 0.f;
#pragma unroll
    for (int db = 0; db < 4; ++db)
#pragma unroll
        for (int i4 = 0; i4 < 4; ++i4) {
            const int d = 32 * db + 8 * i4 + 4 * h;
            f32x4 v = {oacc[db][4 * i4] * inv, oacc[db][4 * i4 + 1] * inv, oacc[db][4 * i4 + 2] * inv, oacc[db][4 * i4 + 3] * inv};
            if (MODE == 0) { u32x2 w; w.x = pk2(v[0], v[1]); w.y = pk2(v[2], v[3]); *(u32x2*)((bf16*)o0 + d) = w; }
            else {
                if (MODE == 2) { const u32x2 aw = *(const u32x2*)((const bf16*)o1 + d), cw = *(const u32x2*)((const bf16*)o2 + d);
                    const f32x4 a = {bf2f(aw.x & 0xffff), bf2f(aw.x >> 16), bf2f(aw.y & 0xffff), bf2f(aw.y >> 16)}, c = {bf2f(cw.x & 0xffff), bf2f(cw.x >> 16), bf2f(cw.y & 0xffff), bf2f(cw.y >> 16)}; v = a * g0 + v * g1 + c * g2; }
                v = v * A8_SCALE; *(unsigned*)((unsigned char*)o0 + d) = pk4_fp8(v[0], v[1], v[2], v[3]);
            }
        }
}

__device__ __forceinline__ void cmp_item(LAS unsigned char* lds, unsigned char* ws, int bg, int qc) {
    int tid = threadIdx.x; asm volatile("" : "+v"(tid));
    const int lane = tid & 63, wv = tid >> 6, r32 = lane & 31, h = lane >> 5;
    const int b = bg >> 1, g = bg & 1, head = r32 >> 3, qi = 8 * wv + (r32 & 7), tq = qc * 64 + qi;
    const unsigned so = (unsigned)tid * 16u;
    const unsigned kbase_l = (unsigned)r32 * 256u, kx = (unsigned)(h ^ (lane & 15)), vbase_l = (unsigned)(h * 1024 + r32 * 8);
    const bf16* qrow = (const bf16*)(ws + WS_QN) + (((size_t)b * 8 + g * 4 + head) * S + tq) * HD;
    const bf16* kt = (const bf16*)(ws + WS_KC) + (size_t)bg * 4 * 8192;
    const bf16* vt = (const bf16*)(ws + WS_VC) + (size_t)bg * 4 * 8192;
    LAS float* impA = (LAS float*)(lds + 65536);
    LAS float* impB = (LAS float*)(lds + 65536 + 16384);
    f32x16 oacc[4], sacc[2];
#define CMP_LOADQ() bf16x8 qf[8]; { const bf16* _qp = qrow; asm volatile("" : "+v"(_qp)); _Pragma("unroll") for (int _s = 0; _s < 8; ++_s) qf[_s] = *(const bf16x8*)(_qp + 16 * _s + 8 * h); }
#pragma unroll
    for (int d = 0; d < 4; ++d)
#pragma unroll
        for (int r = 0; r < 16; ++r) oacc[d][r] = 0.f;
    const int khi = (tq - 31) >> 4;
    const int nmax = (qc * 64 + 63 - 31) >> 4;
    const int ntile = nmax < 0 ? 0 : (nmax >> 6) + 1;
    for (int i = tid; i < 8192; i += NTHREADS) impA[i] = 0.f;
    float m_run = -1e30f, l_run = 0.f;
    const unsigned wbase = (unsigned)__builtin_amdgcn_readfirstlane(tid >> 6) * 1024u;
    if (ntile > 0) {
        ATT_DMA(0, 0);
        { CMP_LOADQ();
        ATT_SYNC();
        for (int j = 0; j < ntile; ++j) {
            const int cur = j & 1;
            if (j + 1 < ntile) ATT_DMA(j + 1, cur ^ 1);
            const int hi_rel = khi - 64 * j;
            ATT_QK(cur);
            ATT_MASK(0, hi_rel, true);
            float mt; ATT_TILEMAX(mt);
            const float m_new = fmaxf(m_run, mt);
            float ls = 0.f;
#pragma unroll
            for (int kh = 0; kh < 2; ++kh)
#pragma unroll
                for (int r = 0; r < 16; ++r) ls += __builtin_amdgcn_exp2f(sacc[kh][r] - m_new);
            l_run = l_run * __builtin_amdgcn_exp2f(m_run - m_new) + ls; m_run = m_new;
            ATT_SYNC();
        } }
        const float l_tot = l_run + __shfl_xor(l_run, 32);
        const float inv = l_tot > 0.f ? 1.0f / l_tot : 0.f;
        ATT_DMA(0, 0);
        { CMP_LOADQ();
        ATT_SYNC();
        for (int j = 0; j < ntile; ++j) {
            const int cur = j & 1;
            if (j + 1 < ntile) ATT_DMA(j + 1, cur ^ 1);
            const int hi_rel = khi - 64 * j;
            ATT_QK(cur);
            ATT_MASK(0, hi_rel, true);
#pragma unroll
            for (int kh = 0; kh < 2; ++kh)
#pragma unroll
                for (int r = 0; r < 16; ++r) sacc[kh][r] = __builtin_amdgcn_exp2f(sacc[kh][r] - m_run) * inv;
#pragma unroll
            for (int kh = 0; kh < 2; ++kh)
#pragma unroll
                for (int i4 = 0; i4 < 4; ++i4) {
                    float a = sacc[kh][4 * i4] + sacc[kh][4 * i4 + 1] + sacc[kh][4 * i4 + 2] + 0.5f * sacc[kh][4 * i4 + 3], bb = 0.5f * sacc[kh][4 * i4 + 3];
                    a += __shfl_xor(a, 8); a += __shfl_xor(a, 16); bb += __shfl_xor(bb, 8); bb += __shfl_xor(bb, 16);
                    if (head == 0) { const int jj = 16 * j + 8 * kh + 2 * i4 + h; impA[qi * 64 + jj] = a; impB[qi * 64 + jj] = bb; }
                }
            ATT_SYNC();
        } }
#pragma unroll
        for (int d = 0; d < 4; ++d)
#pragma unroll
            for (int r = 0; r < 16; ++r) oacc[d][r] = 0.f;
        ATT_DMA(0, 0);
        ATT_SYNC();
        for (int j = 0; j < ntile; ++j) {
            const int cur = j & 1;
            if (j + 1 < ntile) ATT_DMA(j + 1, cur ^ 1);
            const int hi_rel = khi - 64 * j;
            { CMP_LOADQ(); ATT_QK(cur); }
            ATT_MASK(0, hi_rel, true);
#pragma unroll
            for (int kh = 0; kh < 2; ++kh)
#pragma unroll
                for (int r = 0; r < 16; ++r) sacc[kh][r] = __builtin_amdgcn_exp2f(sacc[kh][r] - m_run) * inv;
            ATT_PV(cur);
            ATT_SYNC();
        }
    }
    {
        bf16* orow = (bf16*)(ws + WS_OCMP) + ((size_t)b * S + tq) * 1024 + (g * 4 + head) * HD;
#pragma unroll
        for (int db = 0; db < 4; ++db)
#pragma unroll
            for (int i4 = 0; i4 < 4; ++i4) { const int d = 32 * db + 8 * i4 + 4 * h;
                f32x4 v = {oacc[db][4 * i4], oacc[db][4 * i4 + 1], oacc[db][4 * i4 + 2], oacc[db][4 * i4 + 3]}; u32x2 w; w.x = pk2(v[0], v[1]); w.y = pk2(v[2], v[3]); *(u32x2*)(orow + d) = w; }
    }
    __syncthreads();
    {
        const int q = tid >> 3, jg = tid & 7, cur = qc;
        float sc[8];
#pragma unroll
        for (int i = 0; i < 8; ++i) { const int jj = 8 * jg + i; const float v = impA[q * 64 + jj] + (jj > 0 ? impB[q * 64 + jj - 1] : 0.f);
            const bool valid = jj <= cur, forced = (jj == 0) || (jj == cur) || (jj == cur - 1); sc[i] = forced ? 1e9f : (valid ? v : -1e9f); }
        __syncthreads();
#pragma unroll
        for (int i = 0; i < 8; ++i) impA[q * 64 + 8 * jg + i] = sc[i];
        __syncthreads();
        int rank[8];
#pragma unroll
        for (int i = 0; i < 8; ++i) rank[i] = 0;
#pragma unroll 2
        for (int jp = 0; jp < 64; ++jp) { const float v = impA[q * 64 + jp];
#pragma unroll
            for (int i = 0; i < 8; ++i) rank[i] += (v > sc[i] || (v == sc[i] && jp < 8 * jg + i)) ? 1 : 0; }
        unsigned bits = 0;
#pragma unroll
        for (int i = 0; i < 8; ++i) bits |= (rank[i] < 16 && sc[i] > -0.5e9f) ? (1u << i) : 0u;
        unsigned lo = jg < 4 ? (bits << (8 * jg)) : 0u, hi2 = jg >= 4 ? (bits << (8 * (jg - 4))) : 0u;
        lo |= __shfl_xor(lo, 1); lo |= __shfl_xor(lo, 2); lo |= __shfl_xor(lo, 4); hi2 |= __shfl_xor(hi2, 1); hi2 |= __shfl_xor(hi2, 2); hi2 |= __shfl_xor(hi2, 4);
        if (jg == 0) ((u64*)(ws + WS_MSEL))[(size_t)bg * S + qc * 64 + q] = ((u64)hi2 << 32) | lo;
    }
    __syncthreads();
}

struct SchedOne { Unit u; bool has; __device__ __forceinline__ bool next(int i, Unit& o) const { if (i == 0 && has) { o = u; return true; } return false; } };
struct EpiHid {
    static constexpr bool PERM = false; float* dst;
    __device__ __forceinline__ void operator()(const f32x4 (&acc)[2][2][4][2], const Unit& u, int wr, int wc, int fr, int fq) const {
#pragma unroll
        for (int ai = 0; ai < 2; ++ai)
#pragma unroll
            for (int m = 0; m < 4; ++m) { float* rp = dst + (size_t)(ai * 128 + wr * 64 + m * 16 + fr) * 256 + wc * 32 + 4 * fq;
#pragma unroll
                for (int bj = 0; bj < 2; ++bj)
#pragma unroll
                    for (int n = 0; n < 2; ++n) *(f32x4*)(rp + bj * 128 + n * 16) = acc[ai][bj][m][n]; }
    }
};
struct EpiProj {
    static constexpr bool PERM = true; unsigned char* ws;
    __device__ __forceinline__ void operator()(const f32x4 (&acc)[2][2][4][2], const Unit& u, int wr, int wc, int fr, int fq) const {
#pragma unroll
        for (int ai = 0; ai < 2; ++ai) { u32x2 gw[4][2]; u32x4 pw[4][2];
#pragma unroll
            for (int m = 0; m < 4; ++m) { const int t = u.pm * 256 + ai * 128 + wr * 64 + m * 16 + fr;
#pragma unroll
                for (int bj = 0; bj < 2; ++bj) { const int c = u.pn * 256 + bj * 128 + wc * 32 + fq * 8;
                    gw[m][bj] = *(const u32x2*)(ws + WS_GM + (size_t)t * 4096 + u.kind * 2048 + c);
                    if (u.kind != 0) pw[m][bj] = *(const u32x4*)((const bf16*)(ws + WS_MIXP) + (size_t)t * D + c); } }
#pragma unroll
            for (int m = 0; m < 4; ++m) { const int t = u.pm * 256 + ai * 128 + wr * 64 + m * 16 + fr;
#pragma unroll
                for (int bj = 0; bj < 2; ++bj) { const int c = u.pn * 256 + bj * 128 + wc * 32 + fq * 8; const u32x2 g = gw[m][bj];
                    f32x4 g0 = {(float)(g.x & 0xff), (float)((g.x >> 8) & 0xff), (float)((g.x >> 16) & 0xff), (float)(g.x >> 24)}, g1 = {(float)(g.y & 0xff), (float)((g.y >> 8) & 0xff), (float)((g.y >> 16) & 0xff), (float)(g.y >> 24)};
                    constexpr float us = 1.0f / (W8_SCALE * A8_SCALE * 255.0f);
                    f32x4 v0 = acc[ai][bj][m][0] * us * g0, v1 = acc[ai][bj][m][1] * us * g1;
                    bf16* mp = (bf16*)(ws + WS_MIXP) + (size_t)t * D + c;
                    if (u.kind == 0) { u32x4 w; w.x = pk2(v0[0], v0[1]); w.y = pk2(v0[2], v0[3]); w.z = pk2(v1[0], v1[1]); w.w = pk2(v1[2], v1[3]); *(u32x4*)mp = w; }
                    else { const u32x4 q = pw[m][bj]; v0 += (f32x4){bf2f(q.x & 0xffff), bf2f(q.x >> 16), bf2f(q.y & 0xffff), bf2f(q.y >> 16)}; v1 += (f32x4){bf2f(q.z & 0xffff), bf2f(q.z >> 16), bf2f(q.w & 0xffff), bf2f(q.w >> 16)};
                        v0 = v0 * A8_SCALE; v1 = v1 * A8_SCALE; u32x2 w; w.x = pk4_fp8(v0[0], v0[1], v0[2], v0[3]); w.y = pk4_fp8(v1[0], v1[1], v1[2], v1[3]);
                        *(u32x2*)(ws + WS_MIX + (size_t)t * D + c) = w; } } } }
    }
};
struct SchedProj { int G, c; const char* oa; const char* ob; const char* wn; const char* wm;
    __device__ __forceinline__ bool next(int i, Unit& u) const { const int p = (i >> 1) * G + c; if (p >= 512) return false; tile_map(p, 64, 8, u.pm, u.pn); u.kind = i & 1;
        constexpr size_t ts = (size_t)256 * 1024; u.a = (u.kind ? ob : oa) + u.pm * ts; u.b = (u.kind ? wm : wn) + u.pn * ts; return true; } };
struct EpiOut {
    static constexpr bool PERM = true; const float* x; bf16* x1;
    __device__ __forceinline__ void operator()(const f32x4 (&acc)[2][2][4][2], const Unit& u, int wr, int wc, int fr, int fq) const {
#pragma unroll
        for (int ai = 0; ai < 2; ++ai) { f32x4 xv[4][2][2];
#pragma unroll
            for (int m = 0; m < 4; ++m) { const size_t ro = (size_t)(u.pm * 256 + ai * 128 + wr * 64 + m * 16 + fr) * D + u.pn * 256 + wc * 32 + 8 * fq;
#pragma unroll
                for (int bj = 0; bj < 2; ++bj) { xv[m][bj][0] = __builtin_nontemporal_load((const f32x4*)(x + ro + bj * 128)); xv[m][bj][1] = __builtin_nontemporal_load((const f32x4*)(x + ro + bj * 128 + 4)); } }
#pragma unroll
            for (int m = 0; m < 4; ++m) { const size_t ro = (size_t)(u.pm * 256 + ai * 128 + wr * 64 + m * 16 + fr) * D + u.pn * 256 + wc * 32 + 8 * fq;
#pragma unroll
                for (int bj = 0; bj < 2; ++bj) { constexpr float us = 1.0f / (W8_SCALE * A8_SCALE);
                    const f32x4 v0 = xv[m][bj][0] + acc[ai][bj][m][0] * us, v1 = xv[m][bj][1] + acc[ai][bj][m][1] * us;
                    u32x4 w; w.x = pk2(v0[0], v0[1]); w.y = pk2(v0[2], v0[3]); w.z = pk2(v1[0], v1[1]); w.w = pk2(v1[2], v1[3]);
                    *(u32x4*)(x1 + ro + bj * 128) = w; } } }
    }
};
struct SchedOut { int G, c; const char* a; const char* b;
    __device__ __forceinline__ bool next(int i, Unit& u) const { const int L = i * G + c; if (L >= 512) return false; tile_map(L, 64, 8, u.pm, u.pn); constexpr size_t ts = (size_t)256 * 2048;
        u.a = a + u.pm * ts; u.b = b + u.pn * ts; u.kind = 0; return true; } };
struct SchedMoe { int G, c, nN; const LAS int* offs; const char* A; const char* W; size_t wstride, ts;
    __device__ __forceinline__ bool next(int i, Unit& u) const { const int ntile = __builtin_amdgcn_readfirstlane(offs[NE]) >> 8, L = i * G + c; if (L >= ntile * nN) return false; tile_map(L, ntile, nN, u.pm, u.pn);
        int e = 0;
        for (int k = 1; k < NE; ++k) e = (__builtin_amdgcn_readfirstlane(offs[k]) <= u.pm * 256) ? k : e;
        u.kind = e; u.a = A + u.pm * ts; u.b = W + e * wstride + u.pn * ts; return true; } };
typedef _Float16 h2_t __attribute__((ext_vector_type(2)));
typedef short s2_t __attribute__((ext_vector_type(2)));
struct EpiAct {
    static constexpr bool PERM = true; const float* bgu; unsigned char* act;
    __device__ __forceinline__ void operator()(const f32x4 (&acc)[2][2][4][2], const Unit& u, int wr, int wc, int fr, int fq) const {
        const int c = u.pn * 128 + wc * 32 + fq * 8; const float* bp = bgu + (size_t)u.kind * 2 * FF + c;
        const f32x4 bg0 = *(const f32x4*)bp, bg1 = *(const f32x4*)(bp + 4), bl0 = *(const f32x4*)(bp + FF), bl1 = *(const f32x4*)(bp + FF + 4);
        h2_t bg[4], bl[4];
        bg[0] = (h2_t){(_Float16)bg0[0], (_Float16)bg0[1]}; bg[1] = (h2_t){(_Float16)bg0[2], (_Float16)bg0[3]}; bg[2] = (h2_t){(_Float16)bg1[0], (_Float16)bg1[1]}; bg[3] = (h2_t){(_Float16)bg1[2], (_Float16)bg1[3]};
        bl[0] = (h2_t){(_Float16)bl0[0], (_Float16)bl0[1]}; bl[1] = (h2_t){(_Float16)bl0[2], (_Float16)bl0[3]}; bl[2] = (h2_t){(_Float16)bl1[0], (_Float16)bl1[1]}; bl[3] = (h2_t){(_Float16)bl1[2], (_Float16)bl1[3]};
        const h2_t us = {(_Float16)(1.0f / W8_SCALE), (_Float16)(1.0f / W8_SCALE)}, seven = {(_Float16)7.0f, (_Float16)7.0f}, one = {(_Float16)1.0f, (_Float16)1.0f}, na = {(_Float16)(-1.702f * 1.4426950408889634f), (_Float16)(-1.702f * 1.4426950408889634f)};
#pragma unroll
        for (int ai = 0; ai < 2; ++ai)
#pragma unroll
            for (int m = 0; m < 4; ++m) { const size_t row = (size_t)u.pm * 256 + ai * 128 + wr * 64 + m * 16 + fr; h2_t a2[4];
#pragma unroll
                for (int p = 0; p < 4; ++p) { const f32x4 gv = acc[ai][0][m][p >> 1], lv = acc[ai][1][m][p >> 1];
                    h2_t g = __builtin_bit_cast(h2_t, __builtin_amdgcn_cvt_pkrtz(gv[2 * (p & 1)], gv[2 * (p & 1) + 1])), l = __builtin_bit_cast(h2_t, __builtin_amdgcn_cvt_pkrtz(lv[2 * (p & 1)], lv[2 * (p & 1) + 1]));
                    g = __builtin_elementwise_min(g * us + bg[p], seven); l = __builtin_elementwise_max(__builtin_elementwise_min(l * us + bl[p], seven), -seven);
                    const h2_t den = __builtin_elementwise_exp2(g * na) + one;
                    const h2_t sg = {(_Float16)__builtin_amdgcn_rcph(den[0]), (_Float16)__builtin_amdgcn_rcph(den[1])};
                    a2[p] = g * sg * (l + one); }
                s2_t w0 = {0, 0}, w1 = {0, 0};
                w0 = __builtin_amdgcn_cvt_scalef32_pk_fp8_f16(w0, a2[0], 1.0f, false); w0 = __builtin_amdgcn_cvt_scalef32_pk_fp8_f16(w0, a2[1], 1.0f, true);
                w1 = __builtin_amdgcn_cvt_scalef32_pk_fp8_f16(w1, a2[2], 1.0f, false); w1 = __builtin_amdgcn_cvt_scalef32_pk_fp8_f16(w1, a2[3], 1.0f, true);
                u32x2 w; w.x = __builtin_bit_cast(unsigned, w0); w.y = __builtin_bit_cast(unsigned, w1);
                *(u32x2*)(act + row * FF + c) = w; }
    }
};
struct EpiDown {
    static constexpr bool PERM = true; const float* bdn; const int* rowdst; const float* roww; unsigned char* ys; const LAS int* offs;
    __device__ __forceinline__ void operator()(const f32x4 (&acc)[2][2][4][2], const Unit& u, int wr, int wc, int fr, int fq) const {
        int dsts[2][4]; float ws_[2][4]; f32x4 bb[2][2];
#pragma unroll
        for (int ai = 0; ai < 2; ++ai)
#pragma unroll
            for (int m = 0; m < 4; ++m) { const int row = u.kind * T - offs[u.kind] + u.pm * 256 + ai * 128 + wr * 64 + m * 16 + fr; dsts[ai][m] = rowdst[row]; ws_[ai][m] = roww[row]; }
#pragma unroll
        for (int bj = 0; bj < 2; ++bj) { const float* bp = bdn + (size_t)u.kind * D + u.pn * 256 + bj * 128 + wc * 32 + fq * 8; bb[bj][0] = *(const f32x4*)bp; bb[bj][1] = *(const f32x4*)(bp + 4); }
#pragma unroll
        for (int ai = 0; ai < 2; ++ai)
#pragma unroll
            for (int m = 0; m < 4; ++m) { const int dst = dsts[ai][m]; const float w = ws_[ai][m] * YS_SCALE;
                if (dst >= 0) {
#pragma unroll
                    for (int bj = 0; bj < 2; ++bj) { const int c = u.pn * 256 + bj * 128 + wc * 32 + fq * 8;
                        constexpr float us = 1.0f / W8_SCALE;
                        const f32x4 v0 = (acc[ai][bj][m][0] * us + bb[bj][0]) * w, v1 = (acc[ai][bj][m][1] * us + bb[bj][1]) * w;
                        u32x2 o; o.x = pk4_fp8(v0[0], v0[1], v0[2], v0[3]); o.y = pk4_fp8(v1[0], v1[1], v1[2], v1[3]);
                        *(u32x2*)(ys + (size_t)dst * D + c) = o; } } }
    }
};
__device__ __forceinline__ float gelu_tanh_f(float x) { const float u = 0.7978845608028654f * (x + 0.044715f * x * x * x); const float e = __expf(2.0f * u); return 0.5f * x * (1.0f + (1.0f - 2.0f / (e + 1.0f))); }

__device__ __forceinline__ int queue_pop(volatile LAS unsigned* misc, unsigned* head) {
    __syncthreads();
    if (threadIdx.x == 0) misc[4] = __hip_atomic_fetch_add(head, 1u, __ATOMIC_RELAXED, __HIP_MEMORY_SCOPE_AGENT);
    __syncthreads();
    return (int)misc[4];
}
__device__ __forceinline__ void moe_offsets(volatile LAS unsigned* misc, const unsigned* counts) {
    __syncthreads();
    if (threadIdx.x < NE) misc[96 + threadIdx.x] = ((unsigned)__hip_atomic_load(counts + 64 * threadIdx.x, __ATOMIC_RELAXED, __HIP_MEMORY_SCOPE_AGENT) + 255u) / 256u * 256u;
    __syncthreads();
    if (threadIdx.x == 0) { unsigned o = 0; for (int e = 0; e < NE; ++e) { misc[16 + e] = o; o += misc[96 + e]; } misc[16 + NE] = o; }
    __syncthreads();
}

constexpr int NPHASE = 13;
__global__ void __launch_bounds__(NTHREADS, 2) fwd(Args args) {
    extern __shared__ __attribute__((aligned(16))) unsigned char lds_raw[];
    LAS unsigned char* lds = (LAS unsigned char*)lds_raw;
    volatile LAS unsigned* misc = (volatile LAS unsigned*)(lds + MISC_OFF);
    const int tid = threadIdx.x, lane = tid & 63, wave = __builtin_amdgcn_readfirstlane(tid >> 6);
    const int G = gridDim.x, blk = blockIdx.x, gw = blk * NWAVES + wave, NGW = G * NWAVES;
    unsigned char* ws = args.ws;
    unsigned* ctl = (unsigned*)(ws + WS_CTL);
    const float* x = args.in[0]; const int* positions = (const int*)args.in[1];
    for (int u = tid; u < 64; u += NTHREADS) misc[u] = 0u;
    __syncthreads();
    const int lo = args.ph_lo, hi = args.ph_hi;
    int cv_it = gw; constexpr int CV_P1 = 1 << 20;
    XcdBarrier bar; bar.bar = ctl + CW_BAR; bar.x = 0; bar.st = nullptr;
    if (hi - lo > 1) bar = xcd_barrier_post(ctl + CW_BAR, misc);
#ifndef FK_PHASE_MASK
#define FK_PHASE_MASK 0xFFFF
#endif
#define IN(k) (((FK_PHASE_MASK >> (k)) & 1) && lo <= (k) && (k) < hi)
#ifdef FK_TS
#define STAMP(k) do { if (blk == 0 && tid == 0) { const unsigned long long _t = __builtin_amdgcn_s_memrealtime(); misc[64 + 2 * (k)] = (unsigned)_t; misc[65 + 2 * (k)] = (unsigned)(_t >> 32); } } while (0)
#else
#define STAMP(k) do { } while (0)
#endif
#define SEAM(k) do { if (IN(k) && IN((k) + 1)) xcd_barrier(bar); STAMP((k) + 1); } while (0)

#ifdef FK_TS
    unsigned long long fk_pa = 0, fk_pb = 0;
#endif
    STAMP(0);
    if (IN(0)) {
        if (blk >= G - 16) { const int pb = blk - (G - 16);
            const int kv = pb >> 3, c = (pb & 7) * 32 + (tid & 31), ks = tid >> 5; const float* pe = args.in[kv ? 7 : 4]; const float* w1 = args.in[kv ? 8 : 5]; float a = 0.f;
            for (int k = ks * 256; k < ks * 256 + 256; k += 16) { float pv[16], wv[16];
#pragma unroll
                for (int i = 0; i < 16; ++i) { pv[i] = pe[k + i]; wv[i] = w1[(size_t)(k + i) * 256 + c]; }
#pragma unroll
                for (int i = 0; i < 16; ++i) a += pv[i] * wv[i]; }
            LAS float* red = (LAS float*)lds; red[tid] = a; __syncthreads();
            if (tid < 32) { float s2 = 0.f; for (int q = 0; q < 16; ++q) s2 += red[q * 32 + tid]; ((float*)(ws + WS_PEB))[kv * 256 + (pb & 7) * 32 + tid] = s2; }
            __syncthreads();
        }
        LAS float* scr = (LAS float*)(lds + wave * 16384);
        constexpr int I_IN = 16 * 305, I_K1 = 64 * 8, I_PN = 8 * 64, I_OUT = 16 * 64, I_GU = 16 * 128, I_DN = 16 * 64;
        constexpr int NIT = I_IN + 2 * I_K1 + 2 * I_PN + I_OUT;
        { const int nw = NGW - 16 * NWAVES, U = 4 * nw + 3 * 16 * NWAVES, us = gw < nw ? 4 * gw : 4 * nw + 3 * (gw - nw), ue = us + (gw < nw ? 4 : 3);
          const int it0 = (int)((long long)us * NIT / U), it1 = (int)((long long)ue * NIT / U);
          for (int it = it0; it < it1; ++it) { int r = it;
            if (r < I_IN) { conv_win_item(r, args.in[3], (unsigned char*)(ws + WS_WIN_T), scr, lane); continue; } r -= I_IN;
            if (r < I_K1) { transpose_item(args.in[5], 4096, 256, (bf16*)(ws + WS_WK1_T), RmIdent{0}, scr, r, lane); continue; } r -= I_K1;
            if (r < I_K1) { transpose_item(args.in[8], 4096, 256, (bf16*)(ws + WS_WV1_T), RmIdent{0}, scr, r, lane); continue; } r -= I_K1;
            if (r < I_PN) { conv_plain_item(r, args.in[10], 1024, D, (unsigned char*)(ws + WS_WPN_T), scr, lane); continue; } r -= I_PN;
            if (r < I_PN) { conv_plain_item(r, args.in[11], 1024, D, (unsigned char*)(ws + WS_WPM_T), scr, lane); continue; } r -= I_PN;
            conv_plain_item(r, args.in[12], D, D, (unsigned char*)(ws + WS_WOUT_T), scr, lane);
          } }
        for (int row = gw; row < T; row += NGW) {
            const f32x4* xr = (const f32x4*)(x + (size_t)row * D); f32x4 v[8]; float ss = 0.f;
#pragma unroll
            for (int i = 0; i < 8; ++i) { v[i] = xr[lane + 64 * i]; ss += v[i][0] * v[i][0] + v[i][1] * v[i][1] + v[i][2] * v[i][2] + v[i][3] * v[i][3]; }
            ss = wave_sum(ss); const float rs = rsqrtf(ss * (1.0f / D) + 1e-5f);
            unsigned* hr8 = (unsigned*)(ws + WS_H8 + (size_t)row * D);
#pragma unroll
            for (int i = 0; i < 8; ++i) { const f32x4 gg = ((const f32x4*)args.in[2])[lane + 64 * i]; const f32x4 o = v[i] * rs * gg; hr8[lane + 64 * i] = pk4_fp8(o[0], o[1], o[2], o[3]); }
        }
        for (int i = blk * NTHREADS + tid; i < NE * T; i += G * NTHREADS) ((int*)(ws + WS_ROWDST))[i] = -1;
        for (int i = blk * NTHREADS + tid; i < T * 16; i += G * NTHREADS) { const int t = i >> 4, f = i & 15; const float inv = powf(500000.0f, -(float)(2 * f) / 32.0f); const float ang = (float)positions[t] * inv;
            float* cs = (float*)(ws + WS_CS) + (size_t)t * 32; cs[f] = cosf(ang); cs[16 + f] = sinf(ang); }
    }
    SEAM(0);
    if (IN(1)) {
        EpiIn E{ws, (const float*)(ws + WS_CS)};
        const int gsplit = blk % 10;
        { SchedIn Sc{G, blk, (const char*)(ws + WS_H8), (const char*)(ws + WS_WIN_T), 0, gsplit}; gemm_phase<EpiIn, SchedIn, false, true>(lds, Gemm{D / 2, D / 2, D / 2}, Sc, E); }
        { LAS float* scr = (LAS float*)(lds + wave * 16384);
          { constexpr int NTOT = NE * (16 * 128 + 16 * 64); const int per = (NTOT + NGW - 1) / NGW;
            cv_it = moe_convert<true>(args.in[16], args.in[18], (unsigned char*)(ws + WS_WGU_T), (unsigned char*)(ws + WS_WDN_T), scr, gw * per, 1, lane, per); }
          __syncthreads(); }
        { SchedIn Sc{G, blk, (const char*)(ws + WS_H8), (const char*)(ws + WS_WIN_T), gsplit, 1 << 20}; gemm_phase<EpiIn, SchedIn, false, true>(lds, Gemm{D / 2, D / 2, D / 2}, Sc, E); }
    }
    SEAM(1);
    if (IN(2)) {
        {
#if defined(FK_TS) && defined(FK_EXP) && FK_EXP == 12
            fk_pa = __builtin_amdgcn_s_memrealtime();
#endif
            SchedOne Sc; Sc.has = blk < 64;
            const int kv = blk >> 5, pm = (blk & 31) >> 2, ks = blk & 3;
            Sc.u.a = (const char*)(ws + (kv ? WS_VCMP : WS_KCMP)) + ((size_t)pm * 256 * 2048 + ks * 1024) * 2; Sc.u.b = (const char*)(ws + (kv ? WS_WV1_T : WS_WK1_T)) + (size_t)ks * 1024 * 2; Sc.u.pm = pm; Sc.u.pn = 0; Sc.u.kind = 0;
            EpiHid E{(float*)(ws + WS_HIDP) + ((size_t)(kv * 4 + ks) * 2048 + pm * 256) * 256};
            gemm_phase<EpiHid, SchedOne>(lds, Gemm{1024, 2048, 4096}, Sc, E);
#if defined(FK_TS) && defined(FK_EXP) && FK_EXP == 12
            fk_pb = __builtin_amdgcn_s_memrealtime();
#endif
        }
#if defined(FK_TS) && defined(FK_EXP) && FK_EXP == 11
        for (int rep = 0; rep < 2; ++rep) { if (rep == 1) { xcd_barrier(bar); fk_pa = __builtin_amdgcn_s_memrealtime(); }
#else
        for (int rep = 0; rep < 1; ++rep) {
#endif
        for (;;) {
            const int it = queue_pop(misc, ctl + CW_Q + 64 * (rep ? 7 : 0));
            if (it >= 1024) break;
            if (it < 512) {
                const int bg = it & 7, qc = it >> 3, b = bg >> 1, g = bg & 1, head = g * 4 + (wave >> 1), tq = qc * 64 + (wave & 1) * 32 + (lane & 31);
                const bf16* qrow = (const bf16*)(ws + WS_QN) + (((size_t)b * 8 + head) * S + tq) * HD;
                bf16* orow = (bf16*)(ws + WS_OWIN) + ((size_t)b * S + tq) * 1024 + head * HD;
                attn_item<0, false>(lds, qrow, (const bf16*)(ws + WS_KWIN) + (size_t)bg * S * HD, (const bf16*)(ws + WS_VWIN) + (size_t)bg * S * HD, ~0ull, tq, 512, qc > 8 ? qc - 8 : 0, qc + 1, orow, nullptr, nullptr, 0.f, 0.f, 0.f);
            } else {
                const int id = it - 512, bh = id >> 4, nb = id & 15, p = tid & 15, kg = tid >> 4;
                const bf16* kb = (const bf16*)(ws + WS_MK) + ((size_t)bh * S + nb * 256) * HD; float a[8];
#pragma unroll
                for (int i = 0; i < 8; ++i) a[i] = 0.f;
                for (int kk = 0; kk < 8; ++kk) { const int key = kg * 8 + kk; const u32x4 w = *(const u32x4*)(kb + (size_t)key * HD + ((p ^ (key & 15)) * 8));
                    a[0] += bf2f(w.x & 0xffff); a[1] += bf2f(w.x >> 16); a[2] += bf2f(w.y & 0xffff); a[3] += bf2f(w.y >> 16); a[4] += bf2f(w.z & 0xffff); a[5] += bf2f(w.z >> 16); a[6] += bf2f(w.w & 0xffff); a[7] += bf2f(w.w >> 16); }
                LAS float* red = (LAS float*)lds;
#pragma unroll
                for (int i = 0; i < 8; ++i) red[kg * 128 + p * 8 + i] = a[i];
                __syncthreads();
                if (tid < 128) { float s = 0.f; for (int q = 0; q < 32; ++q) s += red[q * 128 + tid]; ((float*)(ws + WS_KMEAN))[((size_t)bh * 16 + nb) * HD + tid] = s * (1.0f / 256.0f); }
            }
        }
#if defined(FK_TS) && defined(FK_EXP) && FK_EXP == 11
        if (rep == 1) { xcd_barrier(bar); fk_pb = __builtin_amdgcn_s_memrealtime(); }
#endif
        }
    }
    SEAM(2);
    if (IN(3)) {
        for (int it = blk; it < 256; it += G) {
            __syncthreads();
            {
                const int kv = it >> 7, m0 = (it & 127) * 16;
                LAS float* hid = (LAS float*)lds;
                LAS float* outb = (LAS float*)(lds + 16384);
                const float* hp = (const float*)(ws + WS_HIDP) + (size_t)kv * 4 * 2048 * 256; const float* peb = (const float*)(ws + WS_PEB) + kv * 256;
                for (int i = tid; i < 16 * 256; i += NTHREADS) { const int r = i >> 8, c = i & 255; const size_t o = (size_t)(m0 + r) * 256 + c;
                    const float v = ((hp[o] + hp[o + 2048 * 256]) + (hp[o + 2 * 2048 * 256] + hp[o + 3 * 2048 * 256])) + peb[c]; hid[i] = gelu_tanh_f(v); }
                __syncthreads();
                { const int n = tid & 127, rg = tid >> 7; const float* w2 = args.in[kv ? 9 : 6]; float a0 = 0.f, a1 = 0.f, a2 = 0.f, a3 = 0.f;
                  for (int j = 0; j < 256; ++j) { const float w = w2[j * 128 + n]; a0 += hid[(rg * 4 + 0) * 256 + j] * w; a1 += hid[(rg * 4 + 1) * 256 + j] * w; a2 += hid[(rg * 4 + 2) * 256 + j] * w; a3 += hid[(rg * 4 + 3) * 256 + j] * w; }
                  outb[(rg * 4 + 0) * 128 + n] = a0; outb[(rg * 4 + 1) * 128 + n] = a1; outb[(rg * 4 + 2) * 128 + n] = a2; outb[(rg * 4 + 3) * 128 + n] = a3; }
                __syncthreads();
                const int bg = m0 >> 8, i0 = m0 & 255;
                if (kv == 0) {
                    if (tid < 256) { const int r = tid >> 4, p = tid & 15, i = i0 + r; float v[8];
#pragma unroll
                        for (int e = 0; e < 8; ++e) v[e] = outb[r * 128 + p * 8 + e];
                        if (p < 4) { int tk = 16 * i + 31; tk = tk < S ? tk : S - 1; const float* cs = (const float*)(ws + WS_CS) + ((size_t)(bg >> 1) * S + tk) * 32 + 8 * (p & 1);
#pragma unroll
                            for (int e = 0; e < 8; ++e) { const float o = outb[r * 128 + (p ^ 2) * 8 + e]; v[e] = p < 2 ? v[e] * cs[e] - o * cs[16 + e] : v[e] * cs[e] + o * cs[16 + e]; } }
                        u32x4 w; w.x = pk2(v[0], v[1]); w.y = pk2(v[2], v[3]); w.z = pk2(v[4], v[5]); w.w = pk2(v[6], v[7]);
                        *(u32x4*)((bf16*)(ws + WS_KC) + (size_t)bg * 4 * 8192 + (size_t)i * HD + ((p ^ (i & 15)) * 8)) = w; }
                } else {
                    const int qd = tid >> 7, d = tid & 127, i = i0 + 4 * qd;
                    u32x2 w; w.x = pk2(outb[(4 * qd) * 128 + d], outb[(4 * qd + 1) * 128 + d]); w.y = pk2(outb[(4 * qd + 2) * 128 + d], outb[(4 * qd + 3) * 128 + d]);
                    *(u32x2*)((bf16*)(ws + WS_VC) + (size_t)bg * 4 * 8192 + (size_t)(i >> 6) * 8192 + (((i & 63) >> 2) * 128 + d) * 4) = w;
                }
            }
        }
        for (int it = blk; it < 256; it += G) {
            __syncthreads();
            const int bh = it >> 3, t = (it & 7) * 512 + tid, own = t >> 8;
            LAS float* km = (LAS float*)lds;
            for (int i = tid; i < 16 * HD; i += NTHREADS) km[i] = ((const float*)(ws + WS_KMEAN))[(size_t)bh * 16 * HD + i];
            __syncthreads();
            const bf16* qr = (const bf16*)(ws + WS_MQ) + ((size_t)bh * S + t) * HD;
            u32x4 qw[16];
#pragma unroll
            for (int d8 = 0; d8 < 16; ++d8) qw[d8] = *(const u32x4*)(qr + d8 * 8);
            float gt[16];
#pragma unroll
            for (int n = 0; n < 16; ++n) { float a = 0.f;
                if (n < own) {
#pragma unroll
                    for (int d8 = 0; d8 < 16; ++d8) { const f32x4 k0 = *(const LAS f32x4*)(km + n * HD + d8 * 8), k1 = *(const LAS f32x4*)(km + n * HD + d8 * 8 + 4); const u32x4 w = qw[d8];
                        a += bf2f(w.x & 0xffff) * k0[0] + bf2f(w.x >> 16) * k0[1] + bf2f(w.y & 0xffff) * k0[2] + bf2f(w.y >> 16) * k0[3] + bf2f(w.z & 0xffff) * k1[0] + bf2f(w.z >> 16) * k1[1] + bf2f(w.w & 0xffff) * k1[2] + bf2f(w.w >> 16) * k1[3]; } }
                gt[n] = n < own ? a : -1e9f; }
            u64 m = 0xFull << (4 * own);
#pragma unroll
            for (int n = 0; n < 16; ++n) { int rank = 0;
#pragma unroll
                for (int np = 0; np < 16; ++np) rank += (gt[np] > gt[n] || (gt[np] == gt[n] && np < n)) ? 1 : 0;
                if (rank < 3 && gt[n] > -0.5e9f) m |= 0xFull << (4 * n); }
            ((u64*)(ws + WS_MMOBA))[(size_t)bh * S + t] = m;
        }
    }
    SEAM(3);
    if (IN(4)) {
        for (;;) {
            const int it = queue_pop(misc, ctl + CW_Q + 64 * 1);
            if (it >= 1024) break;
            if (it < 512) {
                const int qb = 15 - (it >> 5), bh = it & 31, b = bh >> 3, head = bh & 7, tq = qb * 256 + wave * 32 + (lane & 31);
                const bf16* qrow = (const bf16*)(ws + WS_MQ) + ((size_t)bh * S + tq) * HD;
                const u64 mk = ((const u64*)(ws + WS_MMOBA))[(size_t)bh * S + tq];
                unsigned char* orow = (unsigned char*)(ws + WS_OB) + ((size_t)b * S + tq) * 1024 + head * HD;
                attn_item<1, false>(lds, qrow, (const bf16*)(ws + WS_MK) + (size_t)bh * S * HD, (const bf16*)(ws + WS_MV) + (size_t)bh * S * HD, mk, tq, 1 << 30, 0, 4 * (qb + 1), orow, nullptr, nullptr, 0.f, 0.f, 0.f);
            } else { const int id = it - 512; cmp_item(lds, ws, id & 7, 63 - (id >> 3)); }
        }
    }
    SEAM(4);
    if (IN(5)) {
        for (;;) {
            const int it = queue_pop(misc, ctl + CW_Q + 64 * 2);
            if (it >= 512) break;
            const int bg = it & 7, qc = 63 - (it >> 3), b = bg >> 1, g = bg & 1, head = g * 4 + (wave >> 1), tq = qc * 64 + (wave & 1) * 32 + (lane & 31);
            const size_t trow = (size_t)b * S + tq;
            const bf16* qrow = (const bf16*)(ws + WS_QN) + (((size_t)b * 8 + head) * S + tq) * HD;
            const u64 mk = ((const u64*)(ws + WS_MSEL))[(size_t)bg * S + tq];
            const float* gn = (const float*)(ws + WS_GN) + trow * 24;
            attn_item<2, false>(lds, qrow, (const bf16*)(ws + WS_KSLC) + (size_t)bg * S * HD, (const bf16*)(ws + WS_VSLC) + (size_t)bg * S * HD, mk, tq, 1 << 30, 0, qc + 1,
                         (unsigned char*)(ws + WS_OA) + trow * 1024 + head * HD, (const bf16*)(ws + WS_OCMP) + trow * 1024 + head * HD, (const bf16*)(ws + WS_OWIN) + trow * 1024 + head * HD, gn[head], gn[8 + head], gn[16 + head]);
        }
    }
    SEAM(5);
    if (IN(6)) {
        SchedProj Sc{G, blk, (const char*)(ws + WS_OA), (const char*)(ws + WS_OB), (const char*)(ws + WS_WPN_T), (const char*)(ws + WS_WPM_T)}; EpiProj E{ws};
        gemm_phase<EpiProj, SchedProj, false, true>(lds, Gemm{512, 512, 512}, Sc, E);
#if defined(FK_TS) && defined(FK_EXP) && FK_EXP == 8
        xcd_barrier(bar); STAMP(14);
        gemm_phase<EpiProj, SchedProj, false, true>(lds, Gemm{512, 512, 512}, Sc, E, nullptr, nullptr, true);
        xcd_barrier(bar); STAMP(15);
#endif
    }
    SEAM(6);
    if (IN(7)) {
        SchedOut Sc{G, blk, (const char*)(ws + WS_MIX), (const char*)(ws + WS_WOUT_T)}; EpiOut E{x, (bf16*)(ws + WS_X1)};
        gemm_phase<EpiOut, SchedOut, false, true>(lds, Gemm{D / 2, D / 2, D / 2}, Sc, E);
    }
    SEAM(7);
    if (IN(8)) {
        LAS float* part = (LAS float*)lds;
        LAS float* rsv = (LAS float*)(lds + 65536);
        LAS int* lcnt = (LAS int*)(lds + 65536 + 8192);
        LAS int* lbase = lcnt + 32;
        LAS int* lsel = lcnt + 64;
        LAS int* lidx = lcnt + 64 + 2048;
        LAS float* lwt = (LAS float*)(lcnt + 64 + 4096);
        if (tid < NE) lcnt[tid] = 0;
        const int tok0 = blk * 64, fe = lane & 15, kq = lane >> 4;
        { f32x4 gg8[8]; u32x2 vr[8];
#pragma unroll
          for (int i = 0; i < 8; ++i) gg8[i] = ((const f32x4*)args.in[13])[lane + 64 * i];
          { const u32x2* xr = (const u32x2*)((const bf16*)(ws + WS_X1) + (size_t)(tok0 + 8 * wave) * D);
#pragma unroll
            for (int i = 0; i < 8; ++i) vr[i] = xr[lane + 64 * i]; }
          for (int r = 0; r < 8; ++r) { const int tok = tok0 + 8 * wave + r; float ss = 0.f; f32x4 v[8];
              int ln = lane; asm volatile("" : "+v"(ln));
#pragma unroll
              for (int i = 0; i < 8; ++i) { v[i][0] = bf2f(vr[i].x & 0xffff); v[i][1] = bf2f(vr[i].x >> 16); v[i][2] = bf2f(vr[i].y & 0xffff); v[i][3] = bf2f(vr[i].y >> 16); }
              if (r + 1 < 8) { const u32x2* xr = (const u32x2*)((const bf16*)(ws + WS_X1) + (size_t)(tok + 1) * D);
#pragma unroll
                  for (int i = 0; i < 8; ++i) vr[i] = xr[ln + 64 * i]; }
#pragma unroll
              for (int i = 0; i < 8; ++i) ss += v[i][0] * v[i][0] + v[i][1] * v[i][1] + v[i][2] * v[i][2] + v[i][3] * v[i][3];
              ss = wave_sum(ss); const float rs = rsqrtf(ss * (1.0f / D) + 1e-5f);
              unsigned* hr = (unsigned*)(ws + WS_H8 + (size_t)tok * D);
#pragma unroll
              for (int i = 0; i < 8; ++i) { const f32x4 o = v[i] * rs * gg8[i]; hr[ln + 64 * i] = pk4_fp8(o[0], o[1], o[2], o[3]); }
              if (lane == 0) rsv[8 * wave + r] = rs; } }
        bf16x8 bhi[8][2], blo[8][2];
#pragma unroll
        for (int j = 0; j < 8; ++j) { const int k0 = 256 * wave + 64 * (j >> 1) + 16 * kq + 8 * (j & 1);
            const f32x4 g0 = *(const f32x4*)(args.in[13] + k0), g1 = *(const f32x4*)(args.in[13] + k0 + 4);
#pragma unroll
            for (int eb = 0; eb < 2; ++eb) { float v[8], r[8];
#pragma unroll
                for (int i = 0; i < 8; ++i) v[i] = args.in[14][(size_t)(k0 + i) * NE + 16 * eb + fe] * (i < 4 ? g0[i & 3] : g1[i & 3]);
                u32x4 h, l; h.x = pk2(v[0], v[1]); h.y = pk2(v[2], v[3]); h.z = pk2(v[4], v[5]); h.w = pk2(v[6], v[7]);
                r[0] = v[0] - bf2f(h.x & 0xffff); r[1] = v[1] - bf2f(h.x >> 16); r[2] = v[2] - bf2f(h.y & 0xffff); r[3] = v[3] - bf2f(h.y >> 16);
                r[4] = v[4] - bf2f(h.z & 0xffff); r[5] = v[5] - bf2f(h.z >> 16); r[6] = v[6] - bf2f(h.w & 0xffff); r[7] = v[7] - bf2f(h.w >> 16);
                l.x = pk2(r[0], r[1]); l.y = pk2(r[2], r[3]); l.z = pk2(r[4], r[5]); l.w = pk2(r[6], r[7]);
                bhi[j][eb] = __builtin_bit_cast(bf16x8, h); blo[j][eb] = __builtin_bit_cast(bf16x8, l); } }
        { f32x4 lacc[4][2];
#pragma unroll
          for (int rb = 0; rb < 4; ++rb)
#pragma unroll
              for (int eb = 0; eb < 2; ++eb) lacc[rb][eb] = (f32x4){0.f, 0.f, 0.f, 0.f};
#pragma unroll
          for (int rbp = 0; rbp < 2; ++rbp) { bf16x8 af[2][8];
#pragma unroll
              for (int rr = 0; rr < 2; ++rr)
#pragma unroll
                  for (int j = 0; j < 8; ++j) af[rr][j] = *(const bf16x8*)((const bf16*)(ws + WS_X1) + (size_t)(tok0 + 16 * (2 * rbp + rr) + fe) * D + 256 * wave + 64 * (j >> 1) + 16 * kq + 8 * (j & 1));
#pragma unroll
              for (int rr = 0; rr < 2; ++rr)
#pragma unroll
                  for (int j = 0; j < 8; ++j)
#pragma unroll
                      for (int eb = 0; eb < 2; ++eb) { lacc[2 * rbp + rr][eb] = __builtin_amdgcn_mfma_f32_16x16x32_bf16(af[rr][j], bhi[j][eb], lacc[2 * rbp + rr][eb], 0, 0, 0);
                          lacc[2 * rbp + rr][eb] = __builtin_amdgcn_mfma_f32_16x16x32_bf16(af[rr][j], blo[j][eb], lacc[2 * rbp + rr][eb], 0, 0, 0); } }
#pragma unroll
          for (int rb = 0; rb < 4; ++rb)
#pragma unroll
              for (int eb = 0; eb < 2; ++eb)
#pragma unroll
                  for (int i = 0; i < 4; ++i) part[(wave * 64 + 16 * rb + 4 * kq + i) * 32 + 16 * eb + fe] = lacc[rb][eb][i]; }
        __syncthreads();
#pragma unroll 1
        for (int q4 = 0; q4 < 4; ++q4) { const int tl = 16 * q4 + (tid >> 5), e = lane & 31, tok = tok0 + tl; float lg = 0.f;
#pragma unroll
            for (int w8 = 0; w8 < 8; ++w8) lg += part[(w8 * 64 + tl) * 32 + e];
            lg = lg * rsv[tl] + args.in[15][e];
            int rank = 0; float mx = lg;
#pragma unroll
            for (int ep = 0; ep < 32; ++ep) { const float o = __shfl(lg, (lane & 32) + ep); rank += (o > lg || (o == lg && ep < e)) ? 1 : 0; mx = fmaxf(mx, o); }
            const bool sel = rank < 4; const float ex = sel ? __expf(lg - mx) : 0.f; float sum = ex;
#pragma unroll
            for (int o = 1; o < 32; o <<= 1) sum += __shfl_xor(sum, o);
            if (sel) { const int slot = (tl << 2) + rank;
                lsel[slot] = e; lidx[slot] = (int)__hip_atomic_fetch_add((LAS unsigned*)lcnt + e, 1u, __ATOMIC_RELAXED, __HIP_MEMORY_SCOPE_WORKGROUP);
                lwt[slot] = ex / sum; } (void)tok; }
        __syncthreads();
        if (tid < NE) lbase[tid] = (int)__hip_atomic_fetch_add(ctl + CW_CNT + 64 * tid, (unsigned)lcnt[tid], __ATOMIC_RELAXED, __HIP_MEMORY_SCOPE_AGENT);
        __syncthreads();
        if (tid < 256) { const int e = lsel[tid], r = e * T + lbase[e] + lidx[tid];
            ((int*)(ws + WS_ROWDST))[r] = (tok0 + (tid >> 2)) * 4 + (tid & 3); ((float*)(ws + WS_ROWW))[r] = lwt[tid]; }
    }
    SEAM(8);
    STAMP(10);
    if (IN(10)) {
        moe_offsets(misc, ctl + CW_CNT);
        SchedMoe Sc{G, blk, 16, (const LAS int*)(misc + 16), (const char*)(ws + WS_H8), (const char*)(ws + WS_WGU_T), (size_t)4096 * 2048, (size_t)256 * 2048}; EpiAct E{args.in[17], (unsigned char*)(ws + WS_ACT)};
        LAS unsigned short* gtab = (LAS unsigned short*)(lds + MISC_OFF + 1024);
        for (int ui0 = 0; ui0 < 28; ui0 += 4) {
            Unit uu[4]; bool ok[4]; int vv[4];
#pragma unroll
            for (int q = 0; q < 4; ++q) { ok[q] = Sc.next(ui0 + q, uu[q]); vv[q] = (ok[q] && tid < 256) ? ((const int*)(ws + WS_ROWDST))[uu[q].kind * T - (int)misc[16 + uu[q].kind] + uu[q].pm * 256 + tid] : 0; }
#pragma unroll
            for (int q = 0; q < 4; ++q) if (ok[q] && tid < 256) gtab[(ui0 + q) * 256 + tid] = (unsigned short)(vv[q] < 0 ? 0 : (vv[q] >> 2));
            if (!ok[3]) break; }
        __syncthreads();
        gemm_phase<EpiAct, SchedMoe, true, true>(lds, Gemm{D / 2, D / 2, D / 2}, Sc, E, (const char*)(ws + WS_H8), gtab);
#if defined(FK_TS) && defined(FK_EXP) && FK_EXP != 8
        xcd_barrier(bar); STAMP(14);
#if FK_EXP == 1
        gemm_phase<EpiAct, SchedMoe, true, true>(lds, Gemm{D / 2, D / 2, D / 2}, Sc, E, (const char*)(ws + WS_H8), gtab, true);
#elif FK_EXP == 3
        { struct SX { SchedMoe s; __device__ __forceinline__ bool next(int i, Unit& u) const { if (!s.next(i, u)) return false; u.a = s.A + (size_t)(u.pm & 63) * s.ts; return true; } } Sx{Sc};
          gemm_phase<EpiAct, SX, false, true>(lds, Gemm{D / 2, D / 2, D / 2}, Sx, E, nullptr, nullptr, true); }
#elif FK_EXP == 4
        gemm_phase<EpiAct, SchedMoe, true, true, 1>(lds, Gemm{D / 2, D / 2, D / 2}, Sc, E, (const char*)(ws + WS_H8), gtab, true);
#elif FK_EXP == 5
        gemm_phase<EpiAct, SchedMoe, true, true, 2>(lds, Gemm{D / 2, D / 2, D / 2}, Sc, E, (const char*)(ws + WS_H8), gtab, true);
#elif FK_EXP == 6
        gemm_phase<EpiAct, SchedMoe, true, true, 0, true>(lds, Gemm{D / 2, D / 2, D / 2}, Sc, E, (const char*)(ws + WS_H8), gtab, true);
#elif FK_EXP == 7
        { struct SX { SchedMoe s; __device__ __forceinline__ bool next(int i, Unit& u) const { if (!s.next(i, u)) return false; u.a = s.A + (size_t)(u.pm & 1) * s.ts; u.b = s.W + (size_t)(u.pn & 1) * s.ts; return true; } } Sx{Sc};
          gemm_phase<EpiAct, SX, false, true>(lds, Gemm{D / 2, D / 2, D / 2}, Sx, E, nullptr, nullptr, true); }
#elif FK_EXP == 2
        gemm_phase<EpiAct, SchedMoe, true, true>(lds, Gemm{D / 2, D / 2, D / 2}, Sc, E, (const char*)(ws + WS_H8), gtab, false);
#endif
        xcd_barrier(bar); STAMP(15);
#endif
    }
    SEAM(10);
    if (IN(11)) {
        moe_offsets(misc, ctl + CW_CNT);
        SchedMoe Sc{G, blk, 8, (const LAS int*)(misc + 16), (const char*)(ws + WS_ACT), (const char*)(ws + WS_WDN_T), (size_t)2048 * 2048, (size_t)256 * 2048}; EpiDown E{args.in[19], (const int*)(ws + WS_ROWDST), (const float*)(ws + WS_ROWW), (unsigned char*)(ws + WS_YS), (const LAS int*)(misc + 16)};
        gemm_phase<EpiDown, SchedMoe, false, true>(lds, Gemm{FF / 2, FF / 2, FF / 2}, Sc, E);
    }
    SEAM(11);
    if (IN(12)) {
        for (int tok = gw; tok < T; tok += NGW) {
            f32x4 v[8]; float ss = 0.f;
#pragma unroll
            for (int i = 0; i < 8; ++i) { const u32x2 xb = ((const u32x2*)((const bf16*)(ws + WS_X1) + (size_t)tok * D))[lane + 64 * i]; f32x4 a = {bf2f(xb.x & 0xffff), bf2f(xb.x >> 16), bf2f(xb.y & 0xffff), bf2f(xb.y >> 16)}, ysum = {0.f, 0.f, 0.f, 0.f};
#pragma unroll
                for (int k = 0; k < 4; ++k) { const int y = ((const int*)(ws + WS_YS + ((size_t)tok * 4 + k) * D))[lane + 64 * i];
                    const auto lo = __builtin_amdgcn_cvt_pk_f32_fp8(y, false), hi = __builtin_amdgcn_cvt_pk_f32_fp8(y, true);
                    ysum[0] += lo[0]; ysum[1] += lo[1]; ysum[2] += hi[0]; ysum[3] += hi[1]; }
                a = a + ysum * (1.0f / YS_SCALE);
                v[i] = a; ss += a[0] * a[0] + a[1] * a[1] + a[2] * a[2] + a[3] * a[3]; }
            ss = wave_sum(ss); const float rs = rsqrtf(ss * (1.0f / D) + 1e-5f);
#pragma unroll
            for (int i = 0; i < 8; ++i) { const f32x4 gg = ((const f32x4*)args.in[20])[lane + 64 * i]; ((f32x4*)(args.out + (size_t)tok * D))[lane + 64 * i] = v[i] * rs * gg; }
        }
    }
#ifdef FK_TS
    if (blk == 0 && tid == 0) {
        asm volatile("s_waitcnt vmcnt(0)" ::: "memory");
        const unsigned long long tend = __builtin_amdgcn_s_memrealtime();
        misc[64 + 2 * 13] = (unsigned)tend; misc[65 + 2 * 13] = (unsigned)(tend >> 32);
        const unsigned long long ta = ((unsigned long long)misc[65 + 2 * FK_TS_LO] << 32) | misc[64 + 2 * FK_TS_LO], tb = ((unsigned long long)misc[65 + 2 * FK_TS_HI] << 32) | misc[64 + 2 * FK_TS_HI];
#if FK_TS_LO == 99
        const unsigned long long span = (fk_pb - fk_pa) * FK_TS_F;
#else
        const unsigned long long span = (tb - ta) * FK_TS_F;
#endif
        if (span < 2000000ull) while (__builtin_amdgcn_s_memrealtime() - tend < span) __builtin_amdgcn_s_sleep(8);
    }
#endif
#undef IN
#undef SEAM
}

static void launch_phases(void* const* d_in, void* d_out, void* d_ws, hipStream_t stream, int lo, int hi, bool per_phase) {
    static int grid = 0;
    if (grid == 0) {
        int dev = 0, cus = 0;
        (void)hipGetDevice(&dev); (void)hipDeviceGetAttribute(&cus, hipDeviceAttributeMultiprocessorCount, dev);
        (void)hipFuncSetAttribute((const void*)fwd, hipFuncAttributeMaxDynamicSharedMemorySize, LDS_BYTES);
        grid = cus > 0 ? cus : 256;
    }
    Args a{};
    for (int i = 0; i < 21; ++i) a.in[i] = (const float*)d_in[i];
    a.out = (float*)d_out; a.ws = (unsigned char*)d_ws;
    if (per_phase) { for (int p = lo; p < hi; ++p) { a.ph_lo = p; a.ph_hi = p + 1; hipLaunchKernelGGL(fwd, dim3(grid), dim3(NTHREADS), LDS_BYTES, stream, a); } }
    else { a.ph_lo = lo; a.ph_hi = hi; hipLaunchKernelGGL(fwd, dim3(grid), dim3(NTHREADS), LDS_BYTES, stream, a); }
}
}
extern "C" void kernel_launch(void* const* d_in, const int* in_sizes, int n_in, void* d_out, int out_size, void* d_ws, size_t ws_size, hipStream_t stream) {
    using namespace fk;
    (void)hipMemsetAsync((char*)d_ws + WS_CTL, 0, CTL_BYTES, stream);
    launch_phases(d_in, d_out, d_ws, stream, 0, NPHASE, false);
}
```

```cpp
#include <hip/hip_runtime.h>
#include <stdint.h>
namespace fk {
#define LAS __attribute__((address_space(3)))
#define GAS __attribute__((address_space(1)))
typedef unsigned short bf16;
typedef unsigned long long u64;
typedef short bf16x8 __attribute__((ext_vector_type(8)));
typedef float f32x4 __attribute__((ext_vector_type(4)));
typedef float f32x16 __attribute__((ext_vector_type(16)));
typedef unsigned u32x4 __attribute__((ext_vector_type(4)));
typedef unsigned u32x2 __attribute__((ext_vector_type(2)));
typedef float f32x2_t __attribute__((ext_vector_type(2)));
typedef __bf16 bf16x2_t __attribute__((ext_vector_type(2)));

constexpr int D = 2048, NB = 4, S = 4096, T = NB * S, HD = 128, NE = 32, FF = 2048, INW = 9752;
constexpr int NTHREADS = 512, NWAVES = 8;

__device__ __forceinline__ unsigned pk2(float lo, float hi) { f32x2_t v = {lo, hi}; bf16x2_t b = __builtin_convertvector(v, bf16x2_t); return __builtin_bit_cast(unsigned, b); }
__device__ __forceinline__ float bf2f(unsigned short b) { return __builtin_bit_cast(float, (unsigned)b << 16); }
__device__ __forceinline__ float wave_sum(float v) {
#pragma unroll
    for (int o = 1; o < 64; o <<= 1) v += __shfl_xor(v, o);
    return v;
}
__device__ __forceinline__ float sigmoid_f(float x) { return __builtin_amdgcn_rcpf(1.0f + __expf(-x)); }

#define XB_TMO      128
#define XB_XCNT(j)  (256  + 64 * (j))
#define XB_XSUB(j)  (1280 + 64 * (j))
#define XB_XGEN(j)  (2304 + 64 * (j))
#define XB_TOP      3328
#define XB_TOPGEN   3392
#define XCD_BAR_WORDS 3456
#define XB_SPIN_CAP (1u << 18)
__device__ __forceinline__ unsigned xb_ld(unsigned* p)              { return __hip_atomic_load(p, __ATOMIC_RELAXED, __HIP_MEMORY_SCOPE_AGENT); }
__device__ __forceinline__ unsigned xb_add(unsigned* p, unsigned v) { return __hip_atomic_fetch_add(p, v, __ATOMIC_RELAXED, __HIP_MEMORY_SCOPE_AGENT); }
__device__ __forceinline__ unsigned xb_xcc_id() { return (unsigned)__builtin_amdgcn_s_getreg((3 << 11) | 20) & 0xFu; }
#define XB_SPIN(cond, bar) do { unsigned _sp = 0; while (cond) { __builtin_amdgcn_s_sleep(1); \
    if ((++_sp & 255u) == 0u) { if (xb_ld(&(bar)[XB_TMO])) break; if (_sp > XB_SPIN_CAP) { atomicAdd(&(bar)[XB_TMO], 1u); break; } } } } while (0)
struct XcdBarrier { unsigned* bar; unsigned x; volatile LAS unsigned* st; };
__device__ __forceinline__ XcdBarrier xcd_barrier_post(unsigned* bar, volatile LAS unsigned* st) {
    XcdBarrier b; b.bar = bar; b.x = xb_xcc_id(); b.st = st;
    if (threadIdx.x == 0) (void)xb_add(&bar[XB_XCNT(b.x)], 1u);
    return b;
}
__device__ __forceinline__ void xcd_barrier_complete(unsigned* bar, unsigned x, unsigned& nloc, unsigned& nx) {
    const unsigned G = gridDim.x * gridDim.y * gridDim.z;
    unsigned sum, cnt, mine, sp = 0u;
    for (;;) {
        sum = 0u; cnt = 0u; mine = 0u;
#pragma unroll
        for (unsigned j = 0; j < 16; ++j) { const unsigned c = xb_ld(&bar[XB_XCNT(j)]); sum += c; cnt += (c > 0u) ? 1u : 0u; mine = (j == x) ? c : mine; }
        if (sum == G) break;
        __builtin_amdgcn_s_sleep(1);
        if ((++sp & 255u) == 0u) { if (xb_ld(&bar[XB_TMO])) break; if (sp > XB_SPIN_CAP) { atomicAdd(&bar[XB_TMO], 1u); break; } }
    }
    nloc = mine > 0u ? mine : 1u; nx = cnt > 0u ? cnt : 1u;
}
__device__ __forceinline__ void xcd_barrier(const XcdBarrier& b) {
    asm volatile("s_waitcnt vmcnt(0)" ::: "memory");
    __syncthreads();
    if (threadIdx.x == 0) {
        unsigned* bar = b.bar;
        __builtin_amdgcn_s_waitcnt(0);
        unsigned nloc = b.st[0], nx = b.st[1];
        if (nloc == 0u) { xcd_barrier_complete(bar, b.x, nloc, nx); b.st[0] = nloc; b.st[1] = nx; }
        const unsigned old = xb_add(&bar[XB_XSUB(b.x)], 1u);
        const unsigned gen = old / nloc;
        if (old + 1u == (gen + 1u) * nloc) {
            __builtin_amdgcn_fence(__ATOMIC_RELEASE, "agent");
            asm volatile("s_waitcnt vmcnt(0)" ::: "memory");
            const unsigned og = xb_add(&bar[XB_TOP], 1u);
            const unsigned tg = og / nx;
            if (og + 1u == (tg + 1u) * nx) xb_add(&bar[XB_TOPGEN], 1u);
            else XB_SPIN(xb_ld(&bar[XB_TOPGEN]) == tg, bar);
            __builtin_amdgcn_fence(__ATOMIC_ACQUIRE, "agent");
            xb_add(&bar[XB_XGEN(b.x)], 1u);
            asm volatile("s_waitcnt vmcnt(0)" ::: "memory");
        } else {
            XB_SPIN(xb_ld(&bar[XB_XGEN(b.x)]) == gen, bar);
            __builtin_amdgcn_fence(__ATOMIC_ACQUIRE, "agent");
            asm volatile("s_waitcnt vmcnt(0)" ::: "memory");
        }
    }
    __syncthreads();
}

constexpr int BM = 256, BK = 64, HALF = 128, HTB = HALF * BK * 2, STAGE_BYTES = 8 * HTB, NXCD = 8, WGM = 8;
__host__ __device__ __forceinline__ int lds_byte(int r, int c) { const int st = (r >> 4) * 2 + (c >> 5), rr = r & 15, cc = c & 31, ob = rr * 64 + cc * 2; return st * 1024 + (ob ^ (((ob >> 9) & 1) << 5)); }
__host__ __device__ __forceinline__ void stage_rc(int b, int& R, int& C) { const int st = b / 1024, sb = b % 1024, swz = sb ^ (((sb >> 9) & 1) << 5); R = (st >> 1) * 16 + swz / 64; C = (st & 1) * 32 + (swz % 64) / 2; }
__host__ __device__ __forceinline__ int lds_byte8(int r, int q) { return ((r >> 4) * 2 + (q >> 2)) * 1024 + (((r & 15) * 64 + (q & 3) * 16) ^ (((r >> 3) & 1) << 4)); }
__host__ __device__ __forceinline__ void stage_rc8(int b, int& R, int& C) { const int st = b / 1024, sb = b % 1024, rr = sb / 64, swz = sb ^ (((rr >> 3) & 1) << 4); R = (st >> 1) * 16 + rr; C = ((st & 1) * 4 + (swz % 64) / 16) * 8; }
__host__ __device__ __forceinline__ int perm32(int rho) { const int n = rho >> 4, i = rho & 15; return 8 * (i >> 2) + 4 * n + (i & 3); }

struct Unit { const char* a; const char* b; int pm, pn, kind; };
struct Gemm { int K, lda, ldb; };
__device__ __forceinline__ void tile_map(int L, int nM, int nN, int& pm, int& pn) {
    const int nwg = nM * nN; int wgid = L;
    { const int q = nwg / NXCD, r = nwg % NXCD, xcd = wgid % NXCD, off = wgid / NXCD; wgid = (xcd < r ? xcd * (q + 1) : r * (q + 1) + (xcd - r) * q) + off; }
    const int nig = WGM * nN, gid = wgid / nig, fm = gid * WGM, gsz = (nM - fm) < WGM ? (nM - fm) : WGM;
    pm = fm + ((wgid % nig) % gsz); pn = (wgid % nig) / gsz;
}
typedef int i32x8 __attribute__((ext_vector_type(8)));
typedef int i32x4 __attribute__((ext_vector_type(4)));
template <class Epi, class Sched, bool GATHER = false, bool FP8 = false, int DBG = 0, bool DMAX = false>
__device__ __forceinline__ void gemm_phase(LAS unsigned char* lds, const Gemm g, const Sched& S, const Epi& E, const char* A0 = nullptr, const LAS unsigned short* gtab = nullptr, const bool skip_epi = false) {
    const int tid = threadIdx.x, wid = __builtin_amdgcn_readfirstlane(tid >> 6), lane = tid & 63, wr = wid >> 2, wc = wid & 3, fr = lane & 15, fq = lane >> 4;
    const int K = g.K, nt = K / BK;
    unsigned voffA[2], voffB[2]; int gR[2], gC[2];
#pragma unroll
    for (int i = 0; i < 2; ++i) { int R, C; if constexpr (FP8) stage_rc8(tid * 16 + i * 8192, R, C); else stage_rc(tid * 16 + i * 8192, R, C); const int Rb = Epi::PERM ? ((R & ~31) + perm32(R & 31)) : R; gR[i] = R; gC[i] = C * 2;
        voffA[i] = (unsigned)(R * g.lda + C) * 2u; voffB[i] = (unsigned)(Rb * g.ldb + C) * 2u; }
    unsigned gaC[2][2], gaN[2][2];
#define PG8_GA(ga, slot) do { _Pragma("unroll") for (int _h = 0; _h < 2; ++_h) _Pragma("unroll") for (int _i = 0; _i < 2; ++_i) \
        ga[_h][_i] = (unsigned)gtab[(slot) * 256 + _h * 128 + gR[_i]] * (unsigned)(g.lda * 2) + (unsigned)gC[_i]; } while (0)
#define PG8_STAGEA(bufoff, h, kofs, nx) do { if constexpr (GATHER) { const char* _gb = A0 + (kofs); asm volatile("" : "+s"(_gb)); _Pragma("unroll") for (int _i = 0; _i < 2; ++_i) \
        __builtin_amdgcn_global_load_lds((const unsigned*)(_gb + ((nx) ? gaN[h][_i] : gaC[h][_i])), (LAS unsigned*)(lds + (bufoff) + ldsw + _i * 8192), 16, 0, 0); } \
    else { PG8_STAGE(bufoff, ((nx) ? nA : cA) + (kofs) + (h) * hstepA, voffA); } } while (0)
    const size_t kstep = (size_t)(BK * 2);
    const size_t hstepA = (size_t)HALF * g.lda * 2, hstepB = (size_t)HALF * g.ldb * 2;
    const unsigned ldsw = (unsigned)wid * 1024u;
    const int aoff = lds_byte(wr * 64 + fr, fq * 8), boff = lds_byte(wc * 32 + fr, fq * 8);
    const int aoff80 = lds_byte8(wr * 64 + fr, 2 * fq), aoff81 = lds_byte8(wr * 64 + fr, 2 * fq + 1), boff80 = lds_byte8(wc * 32 + fr, 2 * fq), boff81 = lds_byte8(wc * 32 + fr, 2 * fq + 1);
#define PG8_SA(b, h) (((b) * 2 + (h)) * HTB)
#define PG8_SB(b, h) ((4 + (b) * 2 + (h)) * HTB)
#define PG8_STAGE(bufoff, gbase, voff) do { const char* _gb = (const char*)(gbase); asm volatile("" : "+s"(_gb)); _Pragma("unroll") for (int _i = 0; _i < 2; ++_i) \
        __builtin_amdgcn_global_load_lds((const unsigned*)(_gb + (voff)[_i]), (LAS unsigned*)(lds + (bufoff) + ldsw + _i * 8192), 16, 0, 0); } while (0)
#define PG8_FRAG8(dst, p0, p1) do { const i32x4 _lo = *(const LAS i32x4*)(p0), _hi = *(const LAS i32x4*)(p1); dst = __builtin_shufflevector(_lo, _hi, 0, 1, 2, 3, 4, 5, 6, 7); } while (0)
#define PG8_LDA(dst, b, h) do { if constexpr (DBG == 2) { } else if constexpr (FP8) { _Pragma("unroll") for (int m = 0; m < 4; ++m) PG8_FRAG8(dst##8[m], lds + PG8_SA(b, h) + aoff80 + m * 2048, lds + PG8_SA(b, h) + aoff81 + m * 2048); } \
    else { _Pragma("unroll") for (int m = 0; m < 4; ++m) _Pragma("unroll") for (int k = 0; k < 2; ++k) dst[m][k] = *(const LAS bf16x8*)(lds + PG8_SA(b, h) + aoff + m * 2048 + k * 1024); } } while (0)
#define PG8_LDB(dst, b, h) do { if constexpr (DBG == 2) { } else if constexpr (FP8) { _Pragma("unroll") for (int n = 0; n < 2; ++n) PG8_FRAG8(dst##8[n], lds + PG8_SB(b, h) + boff80 + n * 2048, lds + PG8_SB(b, h) + boff81 + n * 2048); } \
    else { _Pragma("unroll") for (int n = 0; n < 2; ++n) _Pragma("unroll") for (int k = 0; k < 2; ++k) dst[n][k] = *(const LAS bf16x8*)(lds + PG8_SB(b, h) + boff + n * 2048 + k * 1024); } } while (0)
#define PG8_MMA(ai, bj, At, Bt) do { __builtin_amdgcn_s_setprio(1); if constexpr (DBG == 1) { _Pragma("unroll") for (int m = 0; m < 4; ++m) asm volatile("" :: "v"(At##8[m])); _Pragma("unroll") for (int n = 0; n < 2; ++n) asm volatile("" :: "v"(Bt##8[n])); } else if constexpr (FP8) { _Pragma("unroll") for (int m = 0; m < 4; ++m) _Pragma("unroll") for (int n = 0; n < 2; ++n) \
        asm volatile("v_mfma_scale_f32_16x16x128_f8f6f4 %0, %1, %2, %0, %3, %3 op_sel_hi:[0,0,0]" : "+v"(acc[ai][bj][m][n]) : "v"(Bt##8[n]), "v"(At##8[m]), "v"(sc8)); } \
    else { _Pragma("unroll") for (int m = 0; m < 4; ++m) _Pragma("unroll") for (int n = 0; n < 2; ++n) _Pragma("unroll") for (int k = 0; k < 2; ++k) \
        acc[ai][bj][m][n] = __builtin_amdgcn_mfma_f32_16x16x32_bf16(Bt[n][k], At[m][k], acc[ai][bj][m][n], 0, 0, 0); } __builtin_amdgcn_s_setprio(0); } while (0)
#define PG8_MF8(ai, bj, At, Bt, m, n) asm volatile("v_mfma_scale_f32_16x16x128_f8f6f4 %0, %1, %2, %0, %3, %3 op_sel_hi:[0,0,0]" : "+v"(acc[ai][bj][m][n]) : "v"(Bt##8[n]), "v"(At##8[m]), "v"(sc8))
#define PG8_MMAX(ai, bj, At, Bt, X1, X2) do { __builtin_amdgcn_s_setprio(1); PG8_MF8(ai, bj, At, Bt, 0, 0); PG8_MF8(ai, bj, At, Bt, 0, 1); X1; PG8_MF8(ai, bj, At, Bt, 1, 0); PG8_MF8(ai, bj, At, Bt, 1, 1); \
        PG8_MF8(ai, bj, At, Bt, 2, 0); PG8_MF8(ai, bj, At, Bt, 2, 1); X2; PG8_MF8(ai, bj, At, Bt, 3, 0); PG8_MF8(ai, bj, At, Bt, 3, 1); __builtin_amdgcn_s_setprio(0); } while (0)
#define PG8_WAIT_V(n) asm volatile("s_waitcnt vmcnt(" #n ")" ::: "memory")
#define PG8_WAIT_L(n) asm volatile("s_waitcnt lgkmcnt(" #n ")" ::: "memory")
#define PG8_BAR __builtin_amdgcn_s_barrier()
#define PG8_SCHED __builtin_amdgcn_sched_barrier(0)
    Unit cur, nxt; int ui = 0;
    if (!S.next(0, cur)) return;
    f32x4 acc[2][2][4][2];
#pragma unroll
    for (int a = 0; a < 2; ++a)
#pragma unroll
        for (int b = 0; b < 2; ++b)
#pragma unroll
            for (int m = 0; m < 4; ++m)
#pragma unroll
                for (int n = 0; n < 2; ++n) acc[a][b][m][n] = (f32x4){0.f, 0.f, 0.f, 0.f};
    bf16x8 At[4][2], B0[2][2], B1[2][2];
    i32x8 At8[4], B08[2], B18[2];
    if constexpr (DBG == 2) {
#pragma unroll
        for (int m = 0; m < 4; ++m) { At8[m] = (i32x8){0, 0, 0, 0, 0, 0, 0, 0}; asm volatile("" : "+v"(At8[m])); }
#pragma unroll
        for (int n = 0; n < 2; ++n) { B08[n] = (i32x8){0, 0, 0, 0, 0, 0, 0, 0}; B18[n] = B08[n]; asm volatile("" : "+v"(B08[n]), "+v"(B18[n])); } }
    const int sc8 = 0x7f7f7f7f;
    const char* cA = cur.a; const char* cB = cur.b; const char* nA = cA;
    if constexpr (GATHER) { PG8_GA(gaC, 0); }
    {
        PG8_STAGE(PG8_SB(0, 0), cB, voffB); PG8_STAGE(PG8_SB(0, 1), cB + hstepB, voffB); PG8_STAGEA(PG8_SA(0, 0), 0, (size_t)0, false); PG8_STAGEA(PG8_SA(0, 1), 1, (size_t)0, false);
        if (wr == 1) PG8_BAR;
        PG8_WAIT_V(2); PG8_BAR;
        PG8_STAGE(PG8_SB(1, 0), cB + kstep, voffB); PG8_STAGEA(PG8_SA(1, 0), 0, kstep, false); PG8_STAGE(PG8_SB(1, 1), cB + hstepB + kstep, voffB);
        PG8_WAIT_V(6); PG8_BAR;
    }
    for (;;) {
        const bool has_next = S.next(ui + 1, nxt);
        nA = has_next ? nxt.a : cA; const char* nB = has_next ? nxt.b : cB;
        if constexpr (GATHER) { if (has_next) { PG8_GA(gaN, ui + 1); } else {
#pragma unroll
            for (int _h = 0; _h < 2; ++_h)
#pragma unroll
                for (int _i = 0; _i < 2; ++_i) gaN[_h][_i] = gaC[_h][_i]; } }
        for (int t = 0; t < nt; t += 2) {
            const bool last = (t == nt - 2);
            const size_t k1 = (size_t)(t + 1) * kstep, k2 = last ? (size_t)0 : (size_t)(t + 2) * kstep, k3 = k2 + kstep;
            const char* b2 = last ? nB : cB + (size_t)(t + 2) * kstep;
            const char* b3 = b2 + kstep;
            if constexpr (FP8 && DMAX) {
            PG8_LDB(B0, 0, 0); PG8_LDB(B1, 0, 1); PG8_SCHED; PG8_LDA(At, 0, 0); PG8_STAGEA(PG8_SA(1, 1), 1, k1, false);
            PG8_WAIT_V(8); PG8_WAIT_L(0); PG8_BAR; PG8_MMAX(0, 0, At, B0, (void)0, (void)0); PG8_MMAX(0, 1, At, B1, (void)0, (void)0); PG8_BAR; PG8_SCHED;
            PG8_LDA(At, 0, 1); PG8_STAGE(PG8_SB(0, 0), b2, voffB); PG8_STAGEA(PG8_SA(0, 0), 0, k2, last);
            PG8_WAIT_V(6); PG8_WAIT_L(0); PG8_BAR; PG8_MMAX(1, 0, At, B0, PG8_STAGE(PG8_SB(0, 1), b2 + hstepB, voffB), (void)0); PG8_MMAX(1, 1, At, B1, (void)0, (void)0); PG8_BAR; PG8_SCHED;
            PG8_LDB(B0, 1, 0); PG8_LDB(B1, 1, 1); PG8_SCHED; PG8_LDA(At, 1, 0); PG8_STAGEA(PG8_SA(0, 1), 1, k2, last);
            PG8_WAIT_V(8); PG8_WAIT_L(0); PG8_BAR; PG8_MMAX(0, 0, At, B0, (void)0, (void)0); PG8_MMAX(0, 1, At, B1, (void)0, (void)0); PG8_BAR; PG8_SCHED;
            PG8_LDA(At, 1, 1); PG8_STAGE(PG8_SB(1, 0), b3, voffB); PG8_STAGEA(PG8_SA(1, 0), 0, k3, last);
            PG8_WAIT_V(6); PG8_WAIT_L(0); PG8_BAR; PG8_MMAX(1, 0, At, B0, PG8_STAGE(PG8_SB(1, 1), b3 + hstepB, voffB), (void)0); PG8_MMAX(1, 1, At, B1, (void)0, (void)0); PG8_BAR; PG8_SCHED;
            continue; }
            PG8_LDB(B0, 0, 0); PG8_LDB(B1, 0, 1); PG8_SCHED; PG8_LDA(At, 0, 0); PG8_STAGEA(PG8_SA(1, 1), 1, k1, false);
            PG8_WAIT_V(8); PG8_WAIT_L(0); PG8_BAR; PG8_MMA(0, 0, At, B0); PG8_MMA(0, 1, At, B1); PG8_BAR; PG8_SCHED;
            PG8_LDA(At, 0, 1); PG8_STAGE(PG8_SB(0, 0), b2, voffB); PG8_STAGE(PG8_SB(0, 1), b2 + hstepB, voffB); PG8_STAGEA(PG8_SA(0, 0), 0, k2, last);
            PG8_WAIT_V(8); PG8_WAIT_L(0); PG8_BAR; PG8_MMA(1, 0, At, B0); PG8_MMA(1, 1, At, B1); PG8_BAR; PG8_SCHED;
            PG8_LDB(B0, 1, 0); PG8_LDB(B1, 1, 1); PG8_SCHED; PG8_LDA(At, 1, 0); PG8_STAGEA(PG8_SA(0, 1), 1, k2, last);
            PG8_WAIT_V(8); PG8_WAIT_L(0); PG8_BAR; PG8_MMA(0, 0, At, B0); PG8_MMA(0, 1, At, B1); PG8_BAR; PG8_SCHED;
            PG8_LDA(At, 1, 1); PG8_STAGE(PG8_SB(1, 0), b3, voffB); PG8_STAGE(PG8_SB(1, 1), b3 + hstepB, voffB); PG8_STAGEA(PG8_SA(1, 0), 0, k3, last);
            PG8_WAIT_V(8); PG8_WAIT_L(0); PG8_BAR; PG8_MMA(1, 0, At, B0); PG8_MMA(1, 1, At, B1); PG8_BAR; PG8_SCHED;
        }
        if (wr == 0) PG8_BAR;
        if constexpr (FP8) asm volatile("s_nop 15\n\ts_nop 15" ::: "memory");
        { int fr_ = fr, fq_ = fq; asm volatile("" : "+v"(fr_), "+v"(fq_));
          if (!skip_epi) E(acc, cur, wr, wc, fr_, fq_); }
        if (!has_next) break;
#pragma unroll
        for (int a = 0; a < 2; ++a)
#pragma unroll
            for (int b = 0; b < 2; ++b)
#pragma unroll
                for (int m = 0; m < 4; ++m)
#pragma unroll
                    for (int n = 0; n < 2; ++n) acc[a][b][m][n] = (f32x4){0.f, 0.f, 0.f, 0.f};
        cur = nxt; cA = nA; cB = nB; ++ui;
        if constexpr (GATHER) {
#pragma unroll
            for (int _h = 0; _h < 2; ++_h)
#pragma unroll
                for (int _i = 0; _i < 2; ++_i) gaC[_h][_i] = gaN[_h][_i]; }
        if (wr == 1) PG8_BAR;
    }
    PG8_WAIT_V(0);
    PG8_BAR;
#undef PG8_SA
#undef PG8_SB
#undef PG8_STAGE
#undef PG8_STAGEA
#undef PG8_GA
#undef PG8_LDA
#undef PG8_FRAG8
#undef PG8_LDB
#undef PG8_MMA
#undef PG8_WAIT_V
#undef PG8_WAIT_L
#undef PG8_BAR
#undef PG8_SCHED
}

constexpr size_t al256(size_t x) { return (x + 255) & ~(size_t)255; }
constexpr int PMAX = T * 4 + NE * 256;
constexpr size_t WS_CTL = 0, CTL_BYTES = 1u << 20;
constexpr size_t WS_WIN_T  = CTL_BYTES;
constexpr size_t WS_WK1_T  = WS_WIN_T + al256((size_t)9984 * 2048 * 2);
constexpr size_t WS_WV1_T  = WS_WK1_T + al256((size_t)256 * 4096 * 2);
constexpr size_t WS_WPN_T  = WS_WV1_T + al256((size_t)256 * 4096 * 2);
constexpr size_t WS_WPM_T  = WS_WPN_T + al256((size_t)2048 * 1024 * 2);
constexpr size_t WS_WOUT_T = WS_WPM_T + al256((size_t)2048 * 1024 * 2);
constexpr size_t WS_WGU_T  = WS_WOUT_T + al256((size_t)2048 * 2048 * 2);
constexpr size_t WS_WDN_T  = WS_WGU_T + al256((size_t)NE * 4096 * 2048 * 2);
constexpr size_t WS_H      = WS_WDN_T + al256((size_t)NE * 2048 * 2048 * 2);
constexpr size_t WS_X1     = WS_H + al256((size_t)T * D * 2);
constexpr size_t WS_SELE   = WS_X1 + al256((size_t)T * D * 4);
constexpr size_t WS_SELW   = WS_SELE + al256((size_t)T * 4 * 4);
constexpr size_t WS_SELP   = WS_SELW + al256((size_t)T * 4 * 4);
constexpr size_t WS_ROWDST = WS_SELP + al256((size_t)T * 4 * 4);
constexpr size_t WS_ROWW   = WS_ROWDST + al256((size_t)NE * T * 4);
constexpr size_t WS_H8     = WS_ROWW + al256((size_t)NE * T * 4);
constexpr size_t WS_WGM8   = WS_H8 + al256((size_t)T * D);
constexpr size_t WS_U0     = WS_WGM8 + al256((size_t)4096 * 2048);
constexpr size_t WS_QN     = WS_U0;
constexpr size_t HB2 = al256((size_t)T * 2 * HD * 2 + 65536);
constexpr size_t HB8 = al256((size_t)T * 8 * HD * 2);
constexpr size_t WS_KCMP   = WS_QN + HB8;
constexpr size_t WS_VCMP   = WS_KCMP + HB2;
constexpr size_t WS_KSLC   = WS_VCMP + HB2;
constexpr size_t WS_KWIN   = WS_KSLC + HB2;
constexpr size_t WS_VSLC   = WS_KWIN + HB2;
constexpr size_t WS_VWIN   = WS_VSLC + HB2;
constexpr size_t WS_MQ     = WS_VWIN + HB2;
constexpr size_t WS_MK     = WS_MQ + HB8;
constexpr size_t WS_MV     = WS_MK + HB8;
constexpr size_t WS_GN     = WS_MV + HB8;
constexpr size_t WS_GM     = WS_GN + al256((size_t)T * 24 * 4);
constexpr size_t WS_CS     = WS_GM + al256((size_t)T * 4096 * 2);
constexpr size_t WS_HIDP   = WS_CS + al256((size_t)T * 32 * 4);
constexpr size_t WS_PEB    = WS_HIDP + al256((size_t)2 * 4 * 2048 * 256 * 4);
constexpr size_t WS_KC     = WS_PEB + al256(2 * 256 * 4);
constexpr size_t WS_VC     = WS_KC + al256((size_t)8 * 4 * 8192 * 2);
constexpr size_t WS_KMEAN  = WS_VC + al256((size_t)8 * 4 * 8192 * 2);
constexpr size_t WS_MSEL   = WS_KMEAN + al256((size_t)NB * 8 * 16 * HD * 4);
constexpr size_t WS_MMOBA  = WS_MSEL + al256((size_t)NB * 2 * S * 8);
constexpr size_t WS_OCMP   = WS_MMOBA + al256((size_t)NB * 8 * S * 8);
constexpr size_t WS_OWIN   = WS_OCMP + al256((size_t)T * 1024 * 4);
constexpr size_t WS_OA     = WS_OWIN + al256((size_t)T * 1024 * 4);
constexpr size_t WS_OB     = WS_OA + al256((size_t)T * 1024 * 2);
constexpr size_t WS_MIXP   = WS_OB + al256((size_t)T * 1024 * 2);
constexpr size_t WS_MIX    = WS_MIXP + al256((size_t)T * D * 4);
constexpr size_t WS_ATT_END = WS_MIX + al256((size_t)T * D * 2);
constexpr size_t WS_XPAD   = WS_U0;
constexpr size_t WS_ACT    = WS_XPAD + al256((size_t)PMAX * D * 2);
constexpr size_t WS_YS     = WS_ACT + al256((size_t)PMAX * FF * 2);
constexpr size_t WS_MOE_END = WS_YS + al256((size_t)T * 4 * D * 2);
constexpr size_t WS_END    = WS_ATT_END > WS_MOE_END ? WS_ATT_END : WS_MOE_END;
constexpr int CW_BAR = 4096;
constexpr int CW_CNT = 16384;
constexpr int CW_Q   = 16384 + 64 * 32;
constexpr int RING_BYTES = 131072, MISC_OFF = 131072, LDS_BYTES = 147456;

constexpr float A8_SCALE = 64.0f;
constexpr float YS_SCALE = 32.0f;
constexpr float W8_SCALE = 64.0f;
struct Args { const float* in[21]; float* out; unsigned char* ws; int ph_lo, ph_hi; };

template <class RowMap>
__device__ __forceinline__ void transpose_item(const float* __restrict__ W, int K, int N, bf16* WT, const RowMap& rm, LAS float* scr, int item, int lane, int nblk_use = 0) {
    const int nblk = nblk_use ? nblk_use : (N + 31) / 32, kb = item / nblk, nb = item % nblk, k0 = 64 * kb, n0 = 32 * nb;
    const bool cok = (n0 + (lane & 31)) < N;
#pragma unroll 8
    for (int i = 0; i < 32; ++i) { const int kk = 2 * i + (lane >> 5); scr[kk * 33 + (lane & 31)] = cok ? W[(size_t)(k0 + kk) * N + n0 + (lane & 31)] : 0.f; }
    asm volatile("s_waitcnt lgkmcnt(0)" ::: "memory");
    const int c = lane & 7;
#pragma unroll
    for (int j = 0; j < 4; ++j) { const int n = (lane >> 3) + 8 * j; const LAS float* s = scr + (8 * c) * 33 + n;
        u32x4 o; o.x = pk2(s[0 * 33], s[1 * 33]); o.y = pk2(s[2 * 33], s[3 * 33]); o.z = pk2(s[4 * 33], s[5 * 33]); o.w = pk2(s[6 * 33], s[7 * 33]);
        const long dr = (n0 + n) < N ? rm(n0 + n) : -1;
        if (dr >= 0) *(u32x4*)(WT + (size_t)dr * K + k0 + 8 * c) = o; }
    asm volatile("s_waitcnt lgkmcnt(0)" ::: "memory");
}
__device__ __forceinline__ unsigned pk4_fp8(float a, float b, float c, float d) { int p = __builtin_amdgcn_cvt_pk_fp8_f32(a, b, 0, false); p = __builtin_amdgcn_cvt_pk_fp8_f32(c, d, p, true); return (unsigned)p; }
struct ConvItem { const float* src; unsigned char* dst; int N, n0, gu; long roff; };
__device__ __forceinline__ ConvItem conv_item(int it, const float* wgu, const float* wdn, unsigned char* wgu8, unsigned char* wdn8, int lane) {
    constexpr int I_GU = 16 * 128, I_DN = 16 * 64; ConvItem c; int e, r, nblk;
    if (it < NE * I_GU) { e = it / I_GU; r = it % I_GU; nblk = 128; c.N = 2 * FF; c.gu = 1; c.roff = (long)e * 4096; c.src = wgu + (size_t)e * D * 2 * FF; c.dst = wgu8; }
    else { it -= NE * I_GU; e = it / I_DN; r = it % I_DN; nblk = 64; c.N = D; c.gu = 0; c.roff = (long)e * 2048; c.src = wdn + (size_t)e * FF * D; c.dst = wdn8; }
    const int kb = r / nblk, nb = r % nblk; c.n0 = 32 * nb;
    c.src += (size_t)(128 * kb + (lane >> 3)) * c.N + c.n0 + 4 * (lane & 7); c.dst += 128 * kb + 16 * (lane & 7);
    return c;
}
#define CONV_LOAD(v, c) do { _Pragma("unroll") for (int _i = 0; _i < 16; ++_i) v[_i] = __builtin_nontemporal_load((const f32x4*)((c).src + (size_t)(8 * _i) * (c).N)); } while (0)
#define CONV_PROC(v, c) do { const int _lr = lane >> 3, _lg = lane & 7; \
    _Pragma("unroll") for (int _i = 0; _i < 16; ++_i) { const int _k = 8 * _i + _lr; *(LAS f32x4*)(scr + _k * 32 + 4 * (_lg ^ (((_k >> 4) ^ _k) & 7))) = v[_i] * W8_SCALE; } \
    asm volatile("s_waitcnt lgkmcnt(0)" ::: "memory"); \
    _Pragma("unroll") for (int _jj = 0; _jj < 4; ++_jj) { const int _n = _lr + 8 * _jj; float _f[16]; \
        _Pragma("unroll") for (int _j = 0; _j < 16; ++_j) { const int _k = 16 * _lg + _j; _f[_j] = scr[_k * 32 + 4 * ((_n >> 2) ^ (((_k >> 4) ^ _k) & 7)) + (_n & 3)]; } \
        u32x4 _o; _o.x = pk4_fp8(_f[0], _f[1], _f[2], _f[3]); _o.y = pk4_fp8(_f[4], _f[5], _f[6], _f[7]); _o.z = pk4_fp8(_f[8], _f[9], _f[10], _f[11]); _o.w = pk4_fp8(_f[12], _f[13], _f[14], _f[15]); \
        const int _nn = (c).n0 + _n; const long _dr = (c).gu ? ((c).roff + ((_nn >= FF ? _nn - FF : _nn) >> 7) * 256 + (_nn >= FF ? 128 : 0) + (_nn & 127)) : ((c).roff + _nn); \
        *(u32x4*)((c).dst + (size_t)_dr * 2048) = _o; } \
    asm volatile("s_waitcnt lgkmcnt(0)" ::: "memory"); } while (0)
__device__ __forceinline__ ConvItem conv_item_gm(int it, const float* win, unsigned char* wgm8, int lane) {
    ConvItem c; const int kb = it >> 7, nb = it & 127; c.N = INW; c.gu = 0; c.roff = 0; c.n0 = 32 * nb;
    c.src = win + 5656 + (size_t)(128 * kb + (lane >> 3)) * INW + c.n0 + 4 * (lane & 7); c.dst = wgm8 + 128 * kb + 16 * (lane & 7); return c;
}
template <bool PIPE>
__device__ __forceinline__ int moe_convert(const float* wgu, const float* wdn, unsigned char* wgu8, unsigned char* wdn8, LAS float* scr, int first, int stride, int lane, int maxn) {
    constexpr int NTOT = NE * (16 * 128 + 16 * 64);
    int it = first; if (it >= NTOT || maxn <= 0) return it;
    const long lim = (long)first + (long)maxn * stride; const int end = lim < NTOT ? (int)lim : NTOT;
    if constexpr (!PIPE) { f32x4 va[16];
        for (; it < end; it += stride) { asm volatile("" : "+v"(lane)); const ConvItem ca = conv_item(it, wgu, wdn, wgu8, wdn8, lane); CONV_LOAD(va, ca); CONV_PROC(va, ca); }
        return it; }
    f32x4 va[16], vb[16];
    ConvItem ca = conv_item(it, wgu, wdn, wgu8, wdn8, lane), cb = ca; CONV_LOAD(va, ca);
    for (;;) {
        const int itb = it + stride; if (itb < end) { cb = conv_item(itb, wgu, wdn, wgu8, wdn8, lane); CONV_LOAD(vb, cb); }
        CONV_PROC(va, ca);
        if (itb >= end) return itb;
        const int ita = itb + stride; if (ita < end) { ca = conv_item(ita, wgu, wdn, wgu8, wdn8, lane); CONV_LOAD(va, ca); }
        CONV_PROC(vb, cb);
        if (ita >= end) return ita;
        it = ita;
    }
}
struct RmIdent { long off; __device__ long operator()(int n) const { return off + n; } };
struct RmWin { __device__ long operator()(int n) const {
    if (n < 1024) return n;
    if (n < 2560) { const int c = n - 1024, which = c >> 8, r = c & 255;
        return which == 0 ? 1024 + r : which == 1 ? 1280 + r : which == 2 ? 1536 + r : which == 3 ? 8448 + r : which == 4 ? 1792 + r : 8448 + 256 + r; }
    if (n < 2584) return 8192 + (n - 2560);
    if (n < 5656) { const int c = n - 2584, which = c >> 10, r = c & 1023; return which == 0 ? 2048 + r : which == 1 ? 3072 + r : 8448 + 512 + r; }
    return 4096 + (n - 5656); } };
__device__ __forceinline__ void conv_win_item(int it, const float* win, unsigned char* w8, LAS float* scr, int lane) {
    const int kb = it / 305, nb = it % 305, k0 = 128 * kb, n0 = 32 * nb, lr = lane >> 3, lg = lane & 7;
    const bool cok = n0 + 4 * lg < INW;
    f32x4 v[16];
#pragma unroll
    for (int i = 0; i < 16; ++i) v[i] = cok ? __builtin_nontemporal_load((const f32x4*)(win + (size_t)(k0 + lr + 8 * i) * INW + n0 + 4 * lg)) : (f32x4){0.f, 0.f, 0.f, 0.f};
#pragma unroll
    for (int i = 0; i < 16; ++i) { const int k = 8 * i + lr; *(LAS f32x4*)(scr + k * 32 + 4 * (lg ^ (((k >> 4) ^ k) & 7))) = v[i] * W8_SCALE; }
    asm volatile("s_waitcnt lgkmcnt(0)" ::: "memory");
#pragma unroll
    for (int jj = 0; jj < 4; ++jj) { const int n = lr + 8 * jj; float f[16];
#pragma unroll
        for (int j = 0; j < 16; ++j) { const int k = 16 * lg + j; f[j] = scr[k * 32 + 4 * ((n >> 2) ^ (((k >> 4) ^ k) & 7)) + (n & 3)]; }
        u32x4 o; o.x = pk4_fp8(f[0], f[1], f[2], f[3]); o.y = pk4_fp8(f[4], f[5], f[6], f[7]); o.z = pk4_fp8(f[8], f[9], f[10], f[11]); o.w = pk4_fp8(f[12], f[13], f[14], f[15]);
        if (n0 + n < INW) *(u32x4*)(w8 + (size_t)RmWin{}(n0 + n) * 2048 + k0 + 16 * lg) = o; }
    asm volatile("s_waitcnt lgkmcnt(0)" ::: "memory");
}
__device__ __forceinline__ void conv_plain_item(int it, const float* W, int K, int N, unsigned char* w8, LAS float* scr, int lane) {
    const int nblk = N / 32, kb = it / nblk, nb = it % nblk, k0 = 128 * kb, n0 = 32 * nb, lr = lane >> 3, lg = lane & 7;
    f32x4 v[16];
#pragma unroll
    for (int i = 0; i < 16; ++i) v[i] = __builtin_nontemporal_load((const f32x4*)(W + (size_t)(k0 + lr + 8 * i) * N + n0 + 4 * lg));
#pragma unroll
    for (int i = 0; i < 16; ++i) { const int k = 8 * i + lr; *(LAS f32x4*)(scr + k * 32 + 4 * (lg ^ (((k >> 4) ^ k) & 7))) = v[i] * W8_SCALE; }
    asm volatile("s_waitcnt lgkmcnt(0)" ::: "memory");
#pragma unroll
    for (int jj = 0; jj < 4; ++jj) { const int n = lr + 8 * jj; float f[16];
#pragma unroll
        for (int j = 0; j < 16; ++j) { const int k = 16 * lg + j; f[j] = scr[k * 32 + 4 * ((n >> 2) ^ (((k >> 4) ^ k) & 7)) + (n & 3)]; }
        u32x4 o; o.x = pk4_fp8(f[0], f[1], f[2], f[3]); o.y = pk4_fp8(f[4], f[5], f[6], f[7]); o.z = pk4_fp8(f[8], f[9], f[10], f[11]); o.w = pk4_fp8(f[12], f[13], f[14], f[15]);
        *(u32x4*)(w8 + (size_t)(n0 + n) * K + k0 + 16 * lg) = o; }
    asm volatile("s_waitcnt lgkmcnt(0)" ::: "memory");
}
struct RmGu { long off; __device__ long operator()(int n) const { const int lin = n >= FF, j = lin ? n - FF : n; return off + (j >> 7) * 256 + lin * 128 + (j & 127); } };

struct EpiIn {
    static constexpr bool PERM = true;
    unsigned char* ws; const float* cs;
    __device__ __forceinline__ void operator()(const f32x4 (&acc)[2][2][4][2], const Unit& u, int wr, int wc, int fr, int fq) const {
        const int lane = threadIdx.x & 63;
        if (u.kind != 1) {
            const int pn = u.pn, tok0 = u.pm * 256; constexpr float usc = 1.0f / W8_SCALE;
            const bool is_rope = (pn < 4) || pn == 6 || pn == 7 || (pn >= 8 && pn < 16);
#pragma unroll
            for (int ai = 0; ai < 2; ++ai)
#pragma unroll
              for (int mh = 0; mh < 2; ++mh) { f32x4 csv[2][4];
                if (is_rope && wc == 0) {
#pragma unroll
                    for (int mm = 0; mm < 2; ++mm) { const float* cst = cs + (size_t)(tok0 + ai * 128 + wr * 64 + (2 * mh + mm) * 16 + fr) * 32 + 8 * (fq & 1);
                        csv[mm][0] = *(const f32x4*)cst; csv[mm][1] = *(const f32x4*)(cst + 4); csv[mm][2] = *(const f32x4*)(cst + 16); csv[mm][3] = *(const f32x4*)(cst + 20); } }
#pragma unroll
                for (int m = 2 * mh; m < 2 * mh + 2; ++m) {
                    const int t = tok0 + ai * 128 + wr * 64 + m * 16 + fr, b = t >> 12, s = t & (S - 1);
#pragma unroll
                    for (int bj = 0; bj < 2; ++bj) {
                        f32x4 v0 = acc[ai][bj][m][0] * usc, v1 = acc[ai][bj][m][1] * usc;
                        if (pn < 16) {
                            if (is_rope && wc == 0) {
                                f32x4 p0, p1;
#pragma unroll
                                for (int i = 0; i < 4; ++i) { p0[i] = __shfl_xor(v0[i], 32); p1[i] = __shfl_xor(v1[i], 32); }
                                const f32x4 c0 = csv[m & 1][0], c1 = csv[m & 1][1], s0 = csv[m & 1][2], s1 = csv[m & 1][3];
                                if (fq < 2) { v0 = v0 * c0 - p0 * s0; v1 = v1 * c1 - p1 * s1; }
                                else        { v0 = v0 * c0 + p0 * s0; v1 = v1 * c1 + p1 * s1; }
                            }
                            u32x4 w; w.x = pk2(v0[0], v0[1]); w.y = pk2(v0[2], v0[3]); w.z = pk2(v1[0], v1[1]); w.w = pk2(v1[2], v1[3]);
                            const int piece = 4 * wc + fq;
                            size_t off;
                            bf16* dst;
                            if (pn < 4) { dst = (bf16*)(ws + WS_QN); off = (((size_t)b * 8 + 2 * pn + bj) * S + s) * HD + piece * 8; }
                            else if (pn == 4) { dst = (bf16*)(ws + WS_KCMP); off = (((size_t)b * 2 + bj) * S + s) * HD + piece * 8; }
                            else if (pn == 5) { dst = (bf16*)(ws + WS_VCMP); off = (((size_t)b * 2 + bj) * S + s) * HD + piece * 8; }
                            else if (pn < 8) { dst = (bf16*)(ws + (pn == 6 ? WS_KSLC : WS_KWIN)); off = (((size_t)b * 2 + bj) * S + s) * HD + ((piece ^ (s & 15)) * 8); }
                            else if (pn < 12) { dst = (bf16*)(ws + WS_MQ); off = (((size_t)b * 8 + 2 * (pn - 8) + bj) * S + s) * HD + piece * 8; }
                            else { dst = (bf16*)(ws + WS_MK); off = (((size_t)b * 8 + 2 * (pn - 12) + bj) * S + s) * HD + ((piece ^ (s & 15)) * 8); }
                            *(u32x4*)(dst + off) = w;
                        } else if (pn < 32) {
                            unsigned q0[4], q1[4];
#pragma unroll
                            for (int i = 0; i < 4; ++i) { q0[i] = (unsigned)(255.0f * sigmoid_f(v0[i]) + 0.5f); q1[i] = (unsigned)(255.0f * sigmoid_f(v1[i]) + 0.5f); }
                            u32x2 w; w.x = q0[0] | (q0[1] << 8) | (q0[2] << 16) | (q0[3] << 24); w.y = q1[0] | (q1[1] << 8) | (q1[2] << 16) | (q1[3] << 24);
                            *(u32x2*)(ws + WS_GM + (size_t)t * 4096 + (pn - 16) * 256 + bj * 128 + wc * 32 + fq * 8) = w;
                        } else {
                            if (bj == 0 && wc == 0 && fq < 3) {
#pragma unroll
                                for (int i = 0; i < 4; ++i) { v0[i] = sigmoid_f(v0[i]); v1[i] = sigmoid_f(v1[i]); }
                                float* gp = (float*)(ws + WS_GN) + (size_t)t * 24 + fq * 8;
                                *(f32x4*)gp = v0; *(f32x4*)(gp + 4) = v1;
                            }
                        }
                    }
                } }
        } else {
            const int j = u.pm, tok0 = u.pn * 256;
#pragma unroll
            for (int ai = 0; ai < 2; ++ai) {
                bf16* dst; int nh, head;
                if (j == 0) { dst = (bf16*)(ws + WS_VSLC); nh = 2; head = ai; } else if (j == 1) { dst = (bf16*)(ws + WS_VWIN); nh = 2; head = ai; } else { dst = (bf16*)(ws + WS_MV); nh = 8; head = 2 * (j - 2) + ai; }
#pragma unroll
                for (int m = 0; m < 4; ++m) {
                    const int d = wr * 64 + m * 16 + fr;
#pragma unroll
                    for (int bj = 0; bj < 2; ++bj) {
                        const int t = tok0 + bj * 128 + wc * 32 + fq * 8, b = t >> 12, s = t & (S - 1);
                        const f32x4 v0 = acc[ai][bj][m][0] * (1.0f / W8_SCALE), v1 = acc[ai][bj][m][1] * (1.0f / W8_SCALE);
                        bf16* tp = dst + ((size_t)b * nh + head) * S * HD + (size_t)(s >> 6) * 8192 + (((s & 63) >> 2) * 128 + d) * 4;
                        u32x2 q0, q1; q0.x = pk2(v0[0], v0[1]); q0.y = pk2(v0[2], v0[3]); q1.x = pk2(v1[0], v1[1]); q1.y = pk2(v1[2], v1[3]);
                        *(u32x2*)tp = q0; *(u32x2*)(tp + 512) = q1;
                    }
                }
            }
        }
    }
};
struct SchedGm {
    int G, c; const char* Hp; const char* Wp;
    __device__ __forceinline__ bool next(int i, Unit& u) const { const int L = i * G + c; if (L >= 64 * 16) return false; int pj; tile_map(L, 64, 16, u.pm, pj); constexpr size_t ts = (size_t)256 * 2048;
        u.pn = 16 + pj; u.kind = 2; u.a = Hp + u.pm * ts; u.b = Wp + pj * ts; return true; }
};
struct SchedIn {
    int G, c; const char* Hp; const char* Wp; int lo, hi;
    __device__ __forceinline__ bool next(int i, Unit& u) const {
        if (lo + i >= hi) return false;
        int L = (lo + i) * G + c; constexpr size_t ts = (size_t)256 * 2048;
        if (L < 64 * 33) { tile_map(L, 64, 33, u.pm, u.pn); u.a = Hp + u.pm * ts; u.b = Wp + u.pn * ts; u.kind = 0; return true; }
        L -= 64 * 33;
        if (L < 6 * 64) { tile_map(L, 6, 64, u.pm, u.pn); u.a = Wp + (33 + u.pm) * ts; u.b = Hp + u.pn * ts; u.kind = 1; return true; }
        return false;
    }
};

#define ATT_C 0.12751743074602194f
#define ATT_MFMA(a, b, c) __builtin_amdgcn_mfma_f32_32x32x16_bf16((a), (b), (c), 0, 0, 0)
#define ATT_DMA(j, buf) do { const char* _kp = (const char*)kt + (size_t)(j) * 16384 + so; const char* _vp = (const char*)vt + (size_t)(j) * 16384 + so; \
    __builtin_amdgcn_global_load_lds((const unsigned*)_kp, (LAS unsigned*)(lds + (buf) * 16384 + wbase), 16, 0, 0); \
    __builtin_amdgcn_global_load_lds((const unsigned*)(_kp + 8192), (LAS unsigned*)(lds + (buf) * 16384 + 8192 + wbase), 16, 0, 0); \
    __builtin_amdgcn_global_load_lds((const unsigned*)_vp, (LAS unsigned*)(lds + 32768 + (buf) * 16384 + wbase), 16, 0, 0); \
    __builtin_amdgcn_global_load_lds((const unsigned*)(_vp + 8192), (LAS unsigned*)(lds + 32768 + (buf) * 16384 + 8192 + wbase), 16, 0, 0); } while (0)
#define ATT_SYNC() do { asm volatile("s_waitcnt vmcnt(0)" ::: "memory"); __syncthreads(); } while (0)
#define ATT_QK(buf) do { _Pragma("unroll") for (int _kh = 0; _kh < 2; ++_kh) { _Pragma("unroll") for (int _r = 0; _r < 16; ++_r) sacc[_kh][_r] = 0.f; \
    _Pragma("unroll") for (int _s = 0; _s < 8; ++_s) { const bf16x8 _a = *(const LAS bf16x8*)(lds + (buf) * 16384 + _kh * 8192 + kbase_l + (((2 * _s) ^ kx) << 4)); \
        sacc[_kh] = ATT_MFMA(_a, qf[_s], sacc[_kh]); } } } while (0)
#define ATT_MASK(lo_rel, hi_rel, bit) do { const bool _none = !(bit) || (hi_rel) < 0 || (lo_rel) > 63; const bool _full = (bit) && (lo_rel) <= 0 && (hi_rel) >= 63; \
    if (__all(_none || _full)) { const float _bias = _none ? -INFINITY : 0.f; \
        _Pragma("unroll") for (int _kh = 0; _kh < 2; ++_kh) _Pragma("unroll") for (int _r = 0; _r < 16; ++_r) sacc[_kh][_r] = __builtin_fmaf(sacc[_kh][_r], ATT_C, _bias); } \
    else { _Pragma("unroll") for (int _kh = 0; _kh < 2; ++_kh) _Pragma("unroll") for (int _r = 0; _r < 16; ++_r) { const int _k = 32 * _kh + (_r & 3) + 8 * (_r >> 2) + 4 * h; \
        const bool _ok = (bit) && _k >= (lo_rel) && _k <= (hi_rel); sacc[_kh][_r] = _ok ? sacc[_kh][_r] * ATT_C : -INFINITY; } } } while (0)
#define ATT_TILEMAX(mt) do { float _m = sacc[0][0]; _Pragma("unroll") for (int _r = 1; _r < 16; ++_r) _m = fmaxf(_m, sacc[0][_r]); \
    _Pragma("unroll") for (int _r = 0; _r < 16; ++_r) _m = fmaxf(_m, sacc[1][_r]); mt = fmaxf(_m, __shfl_xor(_m, 32)); } while (0)
#define ATT_PV(buf) do { _Pragma("unroll") for (int _kh = 0; _kh < 2; ++_kh) _Pragma("unroll") for (int _s = 0; _s < 2; ++_s) { \
    u32x4 _p; _p.x = pk2(sacc[_kh][8 * _s + 0], sacc[_kh][8 * _s + 1]); _p.y = pk2(sacc[_kh][8 * _s + 2], sacc[_kh][8 * _s + 3]); \
    _p.z = pk2(sacc[_kh][8 * _s + 4], sacc[_kh][8 * _s + 5]); _p.w = pk2(sacc[_kh][8 * _s + 6], sacc[_kh][8 * _s + 7]); const bf16x8 _pf = __builtin_bit_cast(bf16x8, _p); \
    _Pragma("unroll") for (int _db = 0; _db < 4; ++_db) { const LAS unsigned char* _vp = lds + 32768 + (buf) * 16384 + vbase_l + (8 * _kh + 4 * _s) * 1024 + _db * 256; \
        const u32x2 _v0 = *(const LAS u32x2*)_vp, _v1 = *(const LAS u32x2*)(_vp + 2048); u32x4 _v; _v.x = _v0.x; _v.y = _v0.y; _v.z = _v1.x; _v.w = _v1.y; \
        oacc[_db] = ATT_MFMA(__builtin_bit_cast(bf16x8, _v), _pf, oacc[_db]); } } } while (0)

#define ATT_DMA_KV(j, kb, vb) do { const char* _kp = (const char*)kt + (size_t)(j) * 16384 + so; const char* _vp = (const char*)vt + (size_t)(j) * 16384 + so; \
    __builtin_amdgcn_global_load_lds((const unsigned*)_kp, (LAS unsigned*)(lds + (kb) * 16384 + wbase), 16, 0, 0); \
    __builtin_amdgcn_global_load_lds((const unsigned*)(_kp + 8192), (LAS unsigned*)(lds + (kb) * 16384 + 8192 + wbase), 16, 0, 0); \
    __builtin_amdgcn_global_load_lds((const unsigned*)_vp, (LAS unsigned*)(lds + 32768 + (vb) * 16384 + wbase), 16, 0, 0); \
    __builtin_amdgcn_global_load_lds((const unsigned*)(_vp + 8192), (LAS unsigned*)(lds + 32768 + (vb) * 16384 + 8192 + wbase), 16, 0, 0); } while (0)
#define ATT_DMA_KV3(j, st) do { const char* _kp = (const char*)kt + (size_t)(j) * 16384 + so; const char* _vp = (const char*)vt + (size_t)(j) * 16384 + so; \
    __builtin_amdgcn_global_load_lds((const unsigned*)_kp, (LAS unsigned*)(lds + (st) * 16384 + wbase), 16, 0, 0); \
    __builtin_amdgcn_global_load_lds((const unsigned*)(_kp + 8192), (LAS unsigned*)(lds + (st) * 16384 + 8192 + wbase), 16, 0, 0); \
    __builtin_amdgcn_global_load_lds((const unsigned*)_vp, (LAS unsigned*)(lds + 49152 + (st) * 16384 + wbase), 16, 0, 0); \
    __builtin_amdgcn_global_load_lds((const unsigned*)(_vp + 8192), (LAS unsigned*)(lds + 49152 + (st) * 16384 + 8192 + wbase), 16, 0, 0); } while (0)
#define ATT_QK3(buf) ATT_QK(buf)
#define ATT_PVP3(vb) do { _Pragma("unroll") for (int _ks = 0; _ks < 4; ++_ks) _Pragma("unroll") for (int _db = 0; _db < 4; ++_db) { const LAS unsigned char* _vp = lds + 49152 + (vb) * 16384 + vbase_l + (4 * _ks) * 1024 + _db * 256; \
        const u32x2 _v0 = *(const LAS u32x2*)_vp, _v1 = *(const LAS u32x2*)(_vp + 2048); u32x4 _v; _v.x = _v0.x; _v.y = _v0.y; _v.z = _v1.x; _v.w = _v1.y; \
        oacc[_db] = ATT_MFMA(__builtin_bit_cast(bf16x8, _v), pf[_ks], oacc[_db]); } } while (0)
#define ATT_PACKP() do { _Pragma("unroll") for (int _kh = 0; _kh < 2; ++_kh) _Pragma("unroll") for (int _s = 0; _s < 2; ++_s) { u32x4 _p; _p.x = pk2(sacc[_kh][8 * _s + 0], sacc[_kh][8 * _s + 1]); _p.y = pk2(sacc[_kh][8 * _s + 2], sacc[_kh][8 * _s + 3]); \
    _p.z = pk2(sacc[_kh][8 * _s + 4], sacc[_kh][8 * _s + 5]); _p.w = pk2(sacc[_kh][8 * _s + 6], sacc[_kh][8 * _s + 7]); pf[2 * _kh + _s] = __builtin_bit_cast(bf16x8, _p); } } while (0)
#define ATT_PVP(vb) do { _Pragma("unroll") for (int _ks = 0; _ks < 4; ++_ks) _Pragma("unroll") for (int _db = 0; _db < 4; ++_db) { const LAS unsigned char* _vp = lds + 32768 + (vb) * 16384 + vbase_l + (4 * _ks) * 1024 + _db * 256; \
        const u32x2 _v0 = *(const LAS u32x2*)_vp, _v1 = *(const LAS u32x2*)(_vp + 2048); u32x4 _v; _v.x = _v0.x; _v.y = _v0.y; _v.z = _v1.x; _v.w = _v1.y; \
        oacc[_db] = ATT_MFMA(__builtin_bit_cast(bf16x8, _v), pf[_ks], oacc[_db]); } } while (0)
template <int MODE, bool SKEW>
__device__ __forceinline__ void attn_item(LAS unsigned char* lds, const bf16* qrow, const bf16* kt, const bf16* vt, u64 mask, int tq, int W, int tile_lo, int tile_hi,
                                          void* o0, const bf16* o1, const bf16* o2, float g0, float g1, float g2) {
    int tid = threadIdx.x; asm volatile("" : "+v"(tid));
    const int lane = tid & 63, r32 = lane & 31, h = lane >> 5;
    const unsigned so = (unsigned)tid * 16u;
    const unsigned kbase_l = (unsigned)r32 * 256u, kx = (unsigned)(h ^ (lane & 15)), vbase_l = (unsigned)(h * 1024 + r32 * 8);
    bf16x8 qf[8];
#pragma unroll
    for (int s = 0; s < 8; ++s) qf[s] = *(const bf16x8*)(qrow + 16 * s + 8 * h);
    f32x16 oacc[4], sacc[2]; bf16x8 pf[4];
#pragma unroll
    for (int d = 0; d < 4; ++d)
#pragma unroll
        for (int r = 0; r < 16; ++r) oacc[d][r] = 0.f;
    float m_run = 0.f, l_run = 0.f;
    const int khi = tq, klo = (tq - W + 1) > 0 ? (tq - W + 1) : 0;
    const int wv_ = __builtin_amdgcn_readfirstlane(tid >> 6);
    const unsigned wbase = (unsigned)wv_ * 1024u;
    if (SKEW) { ATT_DMA_KV3(tile_lo, 0); if (tile_lo + 1 < tile_hi) { ATT_DMA_KV3(tile_lo + 1, 1); asm volatile("s_waitcnt vmcnt(4)" ::: "memory"); } else asm volatile("s_waitcnt vmcnt(0)" ::: "memory"); __builtin_amdgcn_s_barrier(); asm volatile("" ::: "memory"); }
    else { ATT_DMA_KV(tile_lo, 0, 0); ATT_SYNC(); }
    int kb = 0, vb = 0;
    for (int j = tile_lo; j < tile_hi; ++j) {
        const int kbn = SKEW ? (kb == 2 ? 0 : kb + 1) : (kb ^ 1), vbn = kbn;
        if (SKEW) { if (j + 2 < tile_hi) ATT_DMA_KV3(j + 2, (kbn == 2 ? 0 : kbn + 1)); }
        else { if (j + 1 < tile_hi) ATT_DMA_KV(j + 1, kbn, vbn); }
        const bool bit = (mask >> j) & 1ull;
        const int lo_rel = klo - 64 * j, hi_rel = khi - 64 * j;
        const bool none = !bit || hi_rel < 0 || lo_rel > 63;
        if (!__all(none)) {
            if (SKEW) { ATT_QK3(kb); } else { ATT_QK(kb); }
            float ls = 0.f;
            if (((j - tile_lo) & 3) == 0) {
                ATT_MASK(lo_rel, hi_rel, bit);
                float mt; ATT_TILEMAX(mt); const bool upd = mt > m_run + 8.0f;
                if (__any(upd)) {
                    const float m_new = upd ? mt : m_run, alpha = __builtin_amdgcn_exp2f(m_run - m_new);
                    l_run *= alpha; m_run = m_new;
#pragma unroll
                    for (int d = 0; d < 4; ++d)
#pragma unroll
                        for (int r = 0; r < 16; ++r) oacc[d][r] *= alpha;
                }
#pragma unroll
                for (int kh = 0; kh < 2; ++kh)
#pragma unroll
                    for (int r = 0; r < 16; ++r) { const float p = __builtin_amdgcn_exp2f(sacc[kh][r] - m_run); sacc[kh][r] = p; ls += p; }
            } else {
                const bool full_ = bit && lo_rel <= 0 && hi_rel >= 63;
                if (__all(none || full_)) { const float bm = none ? -INFINITY : -m_run;
#pragma unroll
                    for (int kh = 0; kh < 2; ++kh)
#pragma unroll
                        for (int r = 0; r < 16; ++r) { const float p = __builtin_amdgcn_exp2f(__builtin_fmaf(sacc[kh][r], ATT_C, bm)); sacc[kh][r] = p; ls += p; } }
                else {
#pragma unroll
                    for (int kh = 0; kh < 2; ++kh)
#pragma unroll
                        for (int r = 0; r < 16; ++r) { const int k_ = 32 * kh + (r & 3) + 8 * (r >> 2) + 4 * h; const bool ok_ = bit && k_ >= lo_rel && k_ <= hi_rel;
                            const float p = ok_ ? __builtin_amdgcn_exp2f(__builtin_fmaf(sacc[kh][r], ATT_C, -m_run)) : 0.f; sacc[kh][r] = p; ls += p; } }
            }
            l_run += ls;
            ATT_PACKP();
            if (SKEW) { ATT_PVP3(vb); } else { ATT_PVP(vb); }
        }
        if (SKEW) { if (j + 2 < tile_hi) asm volatile("s_waitcnt vmcnt(4) lgkmcnt(0)" ::: "memory"); else asm volatile("s_waitcnt vmcnt(0) lgkmcnt(0)" ::: "memory"); __builtin_amdgcn_s_barrier(); asm volatile("" ::: "memory"); }
        else ATT_SYNC();
        kb = kbn; vb = vbn;
    }
    const float l_tot = l_run + __shfl_xor(l_run, 32);
    const float inv = l_tot > 0.f ? 1.0f / l_tot : 0.f;
#pragma unroll
    for (int db = 0; db < 4; ++db)
#pragma unroll
        for (int i4 = 0; i4 < 4; ++i4) {
            const int d = 32 * db + 8 * i4 + 4 * h;
            f32x4 v = {oacc[db][4 * i4] * inv, oacc[db][4 * i4 + 1] * inv, oacc[db][4 * i4 + 2] * inv, oacc[db][4 * i4 + 3] * inv};
            if (MODE == 0) { u32x2 w; w.x = pk2(v[0], v[1]); w.y = pk2(v[2], v[3]); *(u32x2*)((bf16*)o0 + d) = w; }
            else {
                if (MODE == 2) { const u32x2 aw = *(const u32x2*)((const bf16*)o1 + d), cw = *(const u32x2*)((const bf16*)o2 + d);
                    const f32x4 a = {bf2f(aw.x & 0xffff), bf2f(aw.x >> 16), bf2f(aw.y & 0xffff), bf2f(aw.y >> 16)}, c = {bf2f(cw.x & 0xffff), bf2f(cw.x >> 16), bf2f(cw.y & 0xffff), bf2f(cw.y >> 16)}; v = a * g0 + v * g1 + c * g2; }
                v = v * A8_SCALE; *(unsigned*)((unsigned char*)o0 + d) = pk4_fp8(v[0], v[1], v[2], v[3]);
            }
        }
}

__device__ __forceinline__ void cmp_item(LAS unsigned char* lds, unsigned char* ws, int bg, int qc) {
    int tid = threadIdx.x; asm volatile("" : "+v"(tid));
    const int lane = tid & 63, wv = tid >> 6, r32 = lane & 31, h = lane >> 5;
    const int b = bg >> 1, g = bg & 1, head = r32 >> 3, qi = 8 * wv + (r32 & 7), tq = qc * 64 + qi;
    const unsigned so = (unsigned)tid * 16u;
    const unsigned kbase_l = (unsigned)r32 * 256u, kx = (unsigned)(h ^ (lane & 15)), vbase_l = (unsigned)(h * 1024 + r32 * 8);
    const bf16* qrow = (const bf16*)(ws + WS_QN) + (((size_t)b * 8 + g * 4 + head) * S + tq) * HD;
    const bf16* kt = (const bf16*)(ws + WS_KC) + (size_t)bg * 4 * 8192;
    const bf16* vt = (const bf16*)(ws + WS_VC) + (size_t)bg * 4 * 8192;
    LAS float* impA = (LAS float*)(lds + 65536);
    LAS float* impB = (LAS float*)(lds + 65536 + 16384);
    f32x16 oacc[4], sacc[2];
#define CMP_LOADQ() bf16x8 qf[8]; { const bf16* _qp = qrow; asm volatile("" : "+v"(_qp)); _Pragma("unroll") for (int _s = 0; _s < 8; ++_s) qf[_s] = *(const bf16x8*)(_qp + 16 * _s + 8 * h); }
#pragma unroll
    for (int d = 0; d < 4; ++d)
#pragma unroll
        for (int r = 0; r < 16; ++r) oacc[d][r] = 0.f;
    const int khi = (tq - 31) >> 4;
    const int nmax = (qc * 64 + 63 - 31) >> 4;
    const int ntile = nmax < 0 ? 0 : (nmax >> 6) + 1;
    for (int i = tid; i < 8192; i += NTHREADS) impA[i] = 0.f;
    float m_run = -1e30f, l_run = 0.f;
    const unsigned wbase = (unsigned)__builtin_amdgcn_readfirstlane(tid >> 6) * 1024u;
    if (ntile > 0) {
        ATT_DMA(0, 0);
        { CMP_LOADQ();
        ATT_SYNC();
        for (int j = 0; j < ntile; ++j) {
            const int cur = j & 1;
            if (j + 1 < ntile) ATT_DMA(j + 1, cur ^ 1);
            const int hi_rel = khi - 64 * j;
            ATT_QK(cur);
            ATT_MASK(0, hi_rel, true);
            float mt; ATT_TILEMAX(mt);
            const float m_new = fmaxf(m_run, mt);
            float ls = 0.f;
#pragma unroll
            for (int kh = 0; kh < 2; ++kh)
#pragma unroll
                for (int r = 0; r < 16; ++r) ls += __builtin_amdgcn_exp2f(sacc[kh][r] - m_new);
            l_run = l_run * __builtin_amdgcn_exp2f(m_run - m_new) + ls; m_run = m_new;
            ATT_SYNC();
        } }
        const float l_tot = l_run + __shfl_xor(l_run, 32);
        const float inv = l_tot > 0.f ? 1.0f / l_tot : 0.f;
        ATT_DMA(0, 0);
        { CMP_LOADQ();
        ATT_SYNC();
        for (int j = 0; j < ntile; ++j) {
            const int cur = j & 1;
            if (j + 1 < ntile) ATT_DMA(j + 1, cur ^ 1);
            const int hi_rel = khi - 64 * j;
            ATT_QK(cur);
            ATT_MASK(0, hi_rel, true);
#pragma unroll
            for (int kh = 0; kh < 2; ++kh)
#pragma unroll
                for (int r = 0; r < 16; ++r) sacc[kh][r] = __builtin_amdgcn_exp2f(sacc[kh][r] - m_run) * inv;
#pragma unroll
            for (int kh = 0; kh < 2; ++kh)
#pragma unroll
                for (int i4 = 0; i4 < 4; ++i4) {
                    float a = sacc[kh][4 * i4] + sacc[kh][4 * i4 + 1] + sacc[kh][4 * i4 + 2] + 0.5f * sacc[kh][4 * i4 + 3], bb = 0.5f * sacc[kh][4 * i4 + 3];
                    a += __shfl_xor(a, 8); a += __shfl_xor(a, 16); bb += __shfl_xor(bb, 8); bb += __shfl_xor(bb, 16);
                    if (head == 0) { const int jj = 16 * j + 8 * kh + 2 * i4 + h; impA[qi * 64 + jj] = a; impB[qi * 64 + jj] = bb; }
                }
            ATT_SYNC();
        } }
#pragma unroll
        for (int d = 0; d < 4; ++d)
#pragma unroll
            for (int r = 0; r < 16; ++r) oacc[d][r] = 0.f;
        ATT_DMA(0, 0);
        ATT_SYNC();
        for (int j = 0; j < ntile; ++j) {
            const int cur = j & 1;
            if (j + 1 < ntile) ATT_DMA(j + 1, cur ^ 1);
            const int hi_rel = khi - 64 * j;
            { CMP_LOADQ(); ATT_QK(cur); }
            ATT_MASK(0, hi_rel, true);
#pragma unroll
            for (int kh = 0; kh < 2; ++kh)
#pragma unroll
                for (int r = 0; r < 16; ++r) sacc[kh][r] = __builtin_amdgcn_exp2f(sacc[kh][r] - m_run) * inv;
            ATT_PV(cur);
            ATT_SYNC();
        }
    }
    {
        bf16* orow = (bf16*)(ws + WS_OCMP) + ((size_t)b * S + tq) * 1024 + (g * 4 + head) * HD;
#pragma unroll
        for (int db = 0; db < 4; ++db)
#pragma unroll
            for (int i4 = 0; i4 < 4; ++i4) { const int d = 32 * db + 8 * i4 + 4 * h;
                f32x4 v = {oacc[db][4 * i4], oacc[db][4 * i4 + 1], oacc[db][4 * i4 + 2], oacc[db][4 * i4 + 3]}; u32x2 w; w.x = pk2(v[0], v[1]); w.y = pk2(v[2], v[3]); *(u32x2*)(orow + d) = w; }
    }
    __syncthreads();
    {
        const int q = tid >> 3, jg = tid & 7, cur = qc;
        float sc[8];
#pragma unroll
        for (int i = 0; i < 8; ++i) { const int jj = 8 * jg + i; const float v = impA[q * 64 + jj] + (jj > 0 ? impB[q * 64 + jj - 1] : 0.f);
            const bool valid = jj <= cur, forced = (jj == 0) || (jj == cur) || (jj == cur - 1); sc[i] = forced ? 1e9f : (valid ? v : -1e9f); }
        __syncthreads();
#pragma unroll
        for (int i = 0; i < 8; ++i) impA[q * 64 + 8 * jg + i] = sc[i];
        __syncthreads();
        int rank[8];
#pragma unroll
        for (int i = 0; i < 8; ++i) rank[i] = 0;
#pragma unroll 2
        for (int jp = 0; jp < 64; ++jp) { const float v = impA[q * 64 + jp];
#pragma unroll
            for (int i = 0; i < 8; ++i) rank[i] += (v > sc[i] || (v == sc[i] && jp < 8 * jg + i)) ? 1 : 0; }
        unsigned bits = 0;
#pragma unroll
        for (int i = 0; i < 8; ++i) bits |= (rank[i] < 16 && sc[i] > -0.5e9f) ? (1u << i) : 0u;
        unsigned lo = jg < 4 ? (bits << (8 * jg)) : 0u, hi2 = jg >= 4 ? (bits << (8 * (jg - 4))) : 0u;
        lo |= __shfl_xor(lo, 1); lo |= __shfl_xor(lo, 2); lo |= __shfl_xor(lo, 4); hi2 |= __shfl_xor(hi2, 1); hi2 |= __shfl_xor(hi2, 2); hi2 |= __shfl_xor(hi2, 4);
        if (jg == 0) ((u64*)(ws + WS_MSEL))[(size_t)bg * S + qc * 64 + q] = ((u64)hi2 << 32) | lo;
    }
    __syncthreads();
}

struct SchedOne { Unit u; bool has; __device__ __forceinline__ bool next(int i, Unit& o) const { if (i == 0 && has) { o = u; return true; } return false; } };
struct EpiHid {
    static constexpr bool PERM = false; float* dst;
    __device__ __forceinline__ void operator()(const f32x4 (&acc)[2][2][4][2], const Unit& u, int wr, int wc, int fr, int fq) const {
#pragma unroll
        for (int ai = 0; ai < 2; ++ai)
#pragma unroll
            for (int m = 0; m < 4; ++m) { float* rp = dst + (size_t)(ai * 128 + wr * 64 + m * 16 + fr) * 256 + wc * 32 + 4 * fq;
#pragma unroll
                for (int bj = 0; bj < 2; ++bj)
#pragma unroll
                    for (int n = 0; n < 2; ++n) *(f32x4*)(rp + bj * 128 + n * 16) = acc[ai][bj][m][n]; }
    }
};
struct EpiProj {
    static constexpr bool PERM = true; unsigned char* ws;
    __device__ __forceinline__ void operator()(const f32x4 (&acc)[2][2][4][2], const Unit& u, int wr, int wc, int fr, int fq) const {
#pragma unroll
        for (int ai = 0; ai < 2; ++ai) { u32x2 gw[4][2]; u32x4 pw[4][2];
#pragma unroll
            for (int m = 0; m < 4; ++m) { const int t = u.pm * 256 + ai * 128 + wr * 64 + m * 16 + fr;
#pragma unroll
                for (int bj = 0; bj < 2; ++bj) { const int c = u.pn * 256 + bj * 128 + wc * 32 + fq * 8;
                    gw[m][bj] = *(const u32x2*)(ws + WS_GM + (size_t)t * 4096 + u.kind * 2048 + c);
                    if (u.kind != 0) pw[m][bj] = *(const u32x4*)((const bf16*)(ws + WS_MIXP) + (size_t)t * D + c); } }
#pragma unroll
            for (int m = 0; m < 4; ++m) { const int t = u.pm * 256 + ai * 128 + wr * 64 + m * 16 + fr;
#pragma unroll
                for (int bj = 0; bj < 2; ++bj) { const int c = u.pn * 256 + bj * 128 + wc * 32 + fq * 8; const u32x2 g = gw[m][bj];
                    f32x4 g0 = {(float)(g.x & 0xff), (float)((g.x >> 8) & 0xff), (float)((g.x >> 16) & 0xff), (float)(g.x >> 24)}, g1 = {(float)(g.y & 0xff), (float)((g.y >> 8) & 0xff), (float)((g.y >> 16) & 0xff), (float)(g.y >> 24)};
                    constexpr float us = 1.0f / (W8_SCALE * A8_SCALE * 255.0f);
                    f32x4 v0 = acc[ai][bj][m][0] * us * g0, v1 = acc[ai][bj][m][1] * us * g1;
                    bf16* mp = (bf16*)(ws + WS_MIXP) + (size_t)t * D + c;
                    if (u.kind == 0) { u32x4 w; w.x = pk2(v0[0], v0[1]); w.y = pk2(v0[2], v0[3]); w.z = pk2(v1[0], v1[1]); w.w = pk2(v1[2], v1[3]); *(u32x4*)mp = w; }
                    else { const u32x4 q = pw[m][bj]; v0 += (f32x4){bf2f(q.x & 0xffff), bf2f(q.x >> 16), bf2f(q.y & 0xffff), bf2f(q.y >> 16)}; v1 += (f32x4){bf2f(q.z & 0xffff), bf2f(q.z >> 16), bf2f(q.w & 0xffff), bf2f(q.w >> 16)};
                        v0 = v0 * A8_SCALE; v1 = v1 * A8_SCALE; u32x2 w; w.x = pk4_fp8(v0[0], v0[1], v0[2], v0[3]); w.y = pk4_fp8(v1[0], v1[1], v1[2], v1[3]);
                        *(u32x2*)(ws + WS_MIX + (size_t)t * D + c) = w; } } } }
    }
};
struct SchedProj { int G, c; const char* oa; const char* ob; const char* wn; const char* wm;
    __device__ __forceinline__ bool next(int i, Unit& u) const { const int p = (i >> 1) * G + c; if (p >= 512) return false; tile_map(p, 64, 8, u.pm, u.pn); u.kind = i & 1;
        constexpr size_t ts = (size_t)256 * 1024; u.a = (u.kind ? ob : oa) + u.pm * ts; u.b = (u.kind ? wm : wn) + u.pn * ts; return true; } };
struct EpiOut {
    static constexpr bool PERM = true; const float* x; bf16* x1;
    __device__ __forceinline__ void operator()(const f32x4 (&acc)[2][2][4][2], const Unit& u, int wr, int wc, int fr, int fq) const {
#pragma unroll
        for (int ai = 0; ai < 2; ++ai) { f32x4 xv[4][2][2];
#pragma unroll
            for (int m = 0; m < 4; ++m) { const size_t ro = (size_t)(u.pm * 256 + ai * 128 + wr * 64 + m * 16 + fr) * D + u.pn * 256 + wc * 32 + 8 * fq;
#pragma unroll
                for (int bj = 0; bj < 2; ++bj) { xv[m][bj][0] = __builtin_nontemporal_load((const f32x4*)(x + ro + bj * 128)); xv[m][bj][1] = __builtin_nontemporal_load((const f32x4*)(x + ro + bj * 128 + 4)); } }
#pragma unroll
            for (int m = 0; m < 4; ++m) { const size_t ro = (size_t)(u.pm * 256 + ai * 128 + wr * 64 + m * 16 + fr) * D + u.pn * 256 + wc * 32 + 8 * fq;
#pragma unroll
                for (int bj = 0; bj < 2; ++bj) { constexpr float us = 1.0f / (W8_SCALE * A8_SCALE);
                    const f32x4 v0 = xv[m][bj][0] + acc[ai][bj][m][0] * us, v1 = xv[m][bj][1] + acc[ai][bj][m][1] * us;
                    u32x4 w; w.x = pk2(v0[0], v0[1]); w.y = pk2(v0[2], v0[3]); w.z = pk2(v1[0], v1[1]); w.w = pk2(v1[2], v1[3]);
                    *(u32x4*)(x1 + ro + bj * 128) = w; } } }
    }
};
struct SchedOut { int G, c; const char* a; const char* b;
    __device__ __forceinline__ bool next(int i, Unit& u) const { const int L = i * G + c; if (L >= 512) return false; tile_map(L, 64, 8, u.pm, u.pn); constexpr size_t ts = (size_t)256 * 2048;
        u.a = a + u.pm * ts; u.b = b + u.pn * ts; u.kind = 0; return true; } };
struct SchedMoe { int G, c, nN; const LAS int* offs; const char* A; const char* W; size_t wstride, ts;
    __device__ __forceinline__ bool next(int i, Unit& u) const { const int ntile = __builtin_amdgcn_readfirstlane(offs[NE]) >> 8, L = i * G + c; if (L >= ntile * nN) return false; tile_map(L, ntile, nN, u.pm, u.pn);
        int e = 0;
        for (int k = 1; k < NE; ++k) e = (__builtin_amdgcn_readfirstlane(offs[k]) <= u.pm * 256) ? k : e;
        u.kind = e; u.a = A + u.pm * ts; u.b = W + e * wstride + u.pn * ts; return true; } };
typedef _Float16 h2_t __attribute__((ext_vector_type(2)));
typedef short s2_t __attribute__((ext_vector_type(2)));
struct EpiAct {
    static constexpr bool PERM = true; const float* bgu; unsigned char* act;
    __device__ __forceinline__ void operator()(const f32x4 (&acc)[2][2][4][2], const Unit& u, int wr, int wc, int fr, int fq) const {
        const int c = u.pn * 128 + wc * 32 + fq * 8; const float* bp = bgu + (size_t)u.kind * 2 * FF + c;
        const f32x4 bg0 = *(const f32x4*)bp, bg1 = *(const f32x4*)(bp + 4), bl0 = *(const f32x4*)(bp + FF), bl1 = *(const f32x4*)(bp + FF + 4);
        h2_t bg[4], bl[4];
        bg[0] = (h2_t){(_Float16)bg0[0], (_Float16)bg0[1]}; bg[1] = (h2_t){(_Float16)bg0[2], (_Float16)bg0[3]}; bg[2] = (h2_t){(_Float16)bg1[0], (_Float16)bg1[1]}; bg[3] = (h2_t){(_Float16)bg1[2], (_Float16)bg1[3]};
        bl[0] = (h2_t){(_Float16)bl0[0], (_Float16)bl0[1]}; bl[1] = (h2_t){(_Float16)bl0[2], (_Float16)bl0[3]}; bl[2] = (h2_t){(_Float16)bl1[0], (_Float16)bl1[1]}; bl[3] = (h2_t){(_Float16)bl1[2], (_Float16)bl1[3]};
        const h2_t us = {(_Float16)(1.0f / W8_SCALE), (_Float16)(1.0f / W8_SCALE)}, seven = {(_Float16)7.0f, (_Float16)7.0f}, one = {(_Float16)1.0f, (_Float16)1.0f}, na = {(_Float16)(-1.702f * 1.4426950408889634f), (_Float16)(-1.702f * 1.4426950408889634f)};
#pragma unroll
        for (int ai = 0; ai < 2; ++ai)
#pragma unroll
            for (int m = 0; m < 4; ++m) { const size_t row = (size_t)u.pm * 256 + ai * 128 + wr * 64 + m * 16 + fr; h2_t a2[4];
#pragma unroll
                for (int p = 0; p < 4; ++p) { const f32x4 gv = acc[ai][0][m][p >> 1], lv = acc[ai][1][m][p >> 1];
                    h2_t g = __builtin_bit_cast(h2_t, __builtin_amdgcn_cvt_pkrtz(gv[2 * (p & 1)], gv[2 * (p & 1) + 1])), l = __builtin_bit_cast(h2_t, __builtin_amdgcn_cvt_pkrtz(lv[2 * (p & 1)], lv[2 * (p & 1) + 1]));
                    g = __builtin_elementwise_min(g * us + bg[p], seven); l = __builtin_elementwise_max(__builtin_elementwise_min(l * us + bl[p], seven), -seven);
                    const h2_t den = __builtin_elementwise_exp2(g * na) + one;
                    const h2_t sg = {(_Float16)__builtin_amdgcn_rcph(den[0]), (_Float16)__builtin_amdgcn_rcph(den[1])};
                    a2[p] = g * sg * (l + one); }
                s2_t w0 = {0, 0}, w1 = {0, 0};
                w0 = __builtin_amdgcn_cvt_scalef32_pk_fp8_f16(w0, a2[0], 1.0f, false); w0 = __builtin_amdgcn_cvt_scalef32_pk_fp8_f16(w0, a2[1], 1.0f, true);
                w1 = __builtin_amdgcn_cvt_scalef32_pk_fp8_f16(w1, a2[2], 1.0f, false); w1 = __builtin_amdgcn_cvt_scalef32_pk_fp8_f16(w1, a2[3], 1.0f, true);
                u32x2 w; w.x = __builtin_bit_cast(unsigned, w0); w.y = __builtin_bit_cast(unsigned, w1);
                *(u32x2*)(act + row * FF + c) = w; }
    }
};
struct EpiDown {
    static constexpr bool PERM = true; const float* bdn; const int* rowdst; const float* roww; unsigned char* ys; const LAS int* offs;
    __device__ __forceinline__ void operator()(const f32x4 (&acc)[2][2][4][2], const Unit& u, int wr, int wc, int fr, int fq) const {
        int dsts[2][4]; float ws_[2][4]; f32x4 bb[2][2];
#pragma unroll
        for (int ai = 0; ai < 2; ++ai)
#pragma unroll
            for (int m = 0; m < 4; ++m) { const int row = u.kind * T - offs[u.kind] + u.pm * 256 + ai * 128 + wr * 64 + m * 16 + fr; dsts[ai][m] = rowdst[row]; ws_[ai][m] = roww[row]; }
#pragma unroll
        for (int bj = 0; bj < 2; ++bj) { const float* bp = bdn + (size_t)u.kind * D + u.pn * 256 + bj * 128 + wc * 32 + fq * 8; bb[bj][0] = *(const f32x4*)bp; bb[bj][1] = *(const f32x4*)(bp + 4); }
#pragma unroll
        for (int ai = 0; ai < 2; ++ai)
#pragma unroll
            for (int m = 0; m < 4; ++m) { const int dst = dsts[ai][m]; const float w = ws_[ai][m] * YS_SCALE;
                if (dst >= 0) {
#pragma unroll
                    for (int bj = 0; bj < 2; ++bj) { const int c = u.pn * 256 + bj * 128 + wc * 32 + fq * 8;
                        constexpr float us = 1.0f / W8_SCALE;
                        const f32x4 v0 = (acc[ai][bj][m][0] * us + bb[bj][0]) * w, v1 = (acc[ai][bj][m][1] * us + bb[bj][1]) * w;
                        u32x2 o; o.x = pk4_fp8(v0[0], v0[1], v0[2], v0[3]); o.y = pk4_fp8(v1[0], v1[1], v1[2], v1[3]);
                        *(u32x2*)(ys + (size_t)dst * D + c) = o; } } }
    }
};
__device__ __forceinline__ float gelu_tanh_f(float x) { const float u = 0.7978845608028654f * (x + 0.044715f * x * x * x); const float e = __expf(2.0f * u); return 0.5f * x * (1.0f + (1.0f - 2.0f / (e + 1.0f))); }

__device__ __forceinline__ int queue_pop(volatile LAS unsigned* misc, unsigned* head) {
    __syncthreads();
    if (threadIdx.x == 0) misc[4] = __hip_atomic_fetch_add(head, 1u, __ATOMIC_RELAXED, __HIP_MEMORY_SCOPE_AGENT);
    __syncthreads();
    return (int)misc[4];
}
__device__ __forceinline__ void moe_offsets(volatile LAS unsigned* misc, const unsigned* counts) {
    __syncthreads();
    if (threadIdx.x < NE) misc[96 + threadIdx.x] = ((unsigned)__hip_atomic_load(counts + 64 * threadIdx.x, __ATOMIC_RELAXED, __HIP_MEMORY_SCOPE_AGENT) + 255u) / 256u * 256u;
    __syncthreads();
    if (threadIdx.x == 0) { unsigned o = 0; for (int e = 0; e < NE; ++e) { misc[16 + e] = o; o += misc[96 + e]; } misc[16 + NE] = o; }
    __syncthreads();
}

constexpr int NPHASE = 13;
__global__ void __launch_bounds__(NTHREADS, 2) fwd(Args args) {
    extern __shared__ __attribute__((aligned(16))) unsigned char lds_raw[];
    LAS unsigned char* lds = (LAS unsigned char*)lds_raw;
    volatile LAS unsigned* misc = (volatile LAS unsigned*)(lds + MISC_OFF);
    const int tid = threadIdx.x, lane = tid & 63, wave = __builtin_amdgcn_readfirstlane(tid >> 6);
    const int G = gridDim.x, blk = blockIdx.x, gw = blk * NWAVES + wave, NGW = G * NWAVES;
    unsigned char* ws = args.ws;
    unsigned* ctl = (unsigned*)(ws + WS_CTL);
    const float* x = args.in[0]; const int* positions = (const int*)args.in[1];
    for (int u = tid; u < 64; u += NTHREADS) misc[u] = 0u;
    __syncthreads();
    const int lo = args.ph_lo, hi = args.ph_hi;
    int cv_it = gw; constexpr int CV_P1 = 1 << 20;
    XcdBarrier bar; bar.bar = ctl + CW_BAR; bar.x = 0; bar.st = nullptr;
    if (hi - lo > 1) bar = xcd_barrier_post(ctl + CW_BAR, misc);
#ifndef FK_PHASE_MASK
#define FK_PHASE_MASK 0xFFFF
#endif
#define IN(k) (((FK_PHASE_MASK >> (k)) & 1) && lo <= (k) && (k) < hi)
#ifdef FK_TS
#define STAMP(k) do { if (blk == 0 && tid == 0) { const unsigned long long _t = __builtin_amdgcn_s_memrealtime(); misc[64 + 2 * (k)] = (unsigned)_t; misc[65 + 2 * (k)] = (unsigned)(_t >> 32); } } while (0)
#else
#define STAMP(k) do { } while (0)
#endif
#define SEAM(k) do { if (IN(k) && IN((k) + 1)) xcd_barrier(bar); STAMP((k) + 1); } while (0)

#ifdef FK_TS
    unsigned long long fk_pa = 0, fk_pb = 0;
#endif
    STAMP(0);
    if (IN(0)) {
        if (blk >= G - 16) { const int pb = blk - (G - 16);
            const int kv = pb >> 3, c = (pb & 7) * 32 + (tid & 31), ks = tid >> 5; const float* pe = args.in[kv ? 7 : 4]; const float* w1 = args.in[kv ? 8 : 5]; float a = 0.f;
            for (int k = ks * 256; k < ks * 256 + 256; k += 16) { float pv[16], wv[16];
#pragma unroll
                for (int i = 0; i < 16; ++i) { pv[i] = pe[k + i]; wv[i] = w1[(size_t)(k + i) * 256 + c]; }
#pragma unroll
                for (int i = 0; i < 16; ++i) a += pv[i] * wv[i]; }
            LAS float* red = (LAS float*)lds; red[tid] = a; __syncthreads();
            if (tid < 32) { float s2 = 0.f; for (int q = 0; q < 16; ++q) s2 += red[q * 32 + tid]; ((float*)(ws + WS_PEB))[kv * 256 + (pb & 7) * 32 + tid] = s2; }
            __syncthreads();
        }
        LAS float* scr = (LAS float*)(lds + wave * 16384);
        constexpr int I_IN = 16 * 305, I_K1 = 64 * 8, I_PN = 8 * 64, I_OUT = 16 * 64, I_GU = 16 * 128, I_DN = 16 * 64;
        constexpr int NIT = I_IN + 2 * I_K1 + 2 * I_PN + I_OUT;
        { const int nw = NGW - 16 * NWAVES, U = 4 * nw + 3 * 16 * NWAVES, us = gw < nw ? 4 * gw : 4 * nw + 3 * (gw - nw), ue = us + (gw < nw ? 4 : 3);
          const int it0 = (int)((long long)us * NIT / U), it1 = (int)((long long)ue * NIT / U);
          for (int it = it0; it < it1; ++it) { int r = it;
            if (r < I_IN) { conv_win_item(r, args.in[3], (unsigned char*)(ws + WS_WIN_T), scr, lane); continue; } r -= I_IN;
            if (r < I_K1) { transpose_item(args.in[5], 4096, 256, (bf16*)(ws + WS_WK1_T), RmIdent{0}, scr, r, lane); continue; } r -= I_K1;
            if (r < I_K1) { transpose_item(args.in[8], 4096, 256, (bf16*)(ws + WS_WV1_T), RmIdent{0}, scr, r, lane); continue; } r -= I_K1;
            if (r < I_PN) { conv_plain_item(r, args.in[10], 1024, D, (unsigned char*)(ws + WS_WPN_T), scr, lane); continue; } r -= I_PN;
            if (r < I_PN) { conv_plain_item(r, args.in[11], 1024, D, (unsigned char*)(ws + WS_WPM_T), scr, lane); continue; } r -= I_PN;
            conv_plain_item(r, args.in[12], D, D, (unsigned char*)(ws + WS_WOUT_T), scr, lane);
          } }
        for (int row = gw; row < T; row += NGW) {
            const f32x4* xr = (const f32x4*)(x + (size_t)row * D); f32x4 v[8]; float ss = 0.f;
#pragma unroll
            for (int i = 0; i < 8; ++i) { v[i] = xr[lane + 64 * i]; ss += v[i][0] * v[i][0] + v[i][1] * v[i][1] + v[i][2] * v[i][2] + v[i][3] * v[i][3]; }
            ss = wave_sum(ss); const float rs = rsqrtf(ss * (1.0f / D) + 1e-5f);
            unsigned* hr8 = (unsigned*)(ws + WS_H8 + (size_t)row * D);
#pragma unroll
            for (int i = 0; i < 8; ++i) { const f32x4 gg = ((const f32x4*)args.in[2])[lane + 64 * i]; const f32x4 o = v[i] * rs * gg; hr8[lane + 64 * i] = pk4_fp8(o[0], o[1], o[2], o[3]); }
        }
        for (int i = blk * NTHREADS + tid; i < NE * T; i += G * NTHREADS) ((int*)(ws + WS_ROWDST))[i] = -1;
        for (int i = blk * NTHREADS + tid; i < T * 16; i += G * NTHREADS) { const int t = i >> 4, f = i & 15; const float inv = powf(500000.0f, -(float)(2 * f) / 32.0f); const float ang = (float)positions[t] * inv;
            float* cs = (float*)(ws + WS_CS) + (size_t)t * 32; cs[f] = cosf(ang); cs[16 + f] = sinf(ang); }
    }
    SEAM(0);
    if (IN(1)) {
        EpiIn E{ws, (const float*)(ws + WS_CS)};
        const int gsplit = blk % 10;
        { SchedIn Sc{G, blk, (const char*)(ws + WS_H8), (const char*)(ws + WS_WIN_T), 0, gsplit}; gemm_phase<EpiIn, SchedIn, false, true>(lds, Gemm{D / 2, D / 2, D / 2}, Sc, E); }
        { LAS float* scr = (LAS float*)(lds + wave * 16384);
          { constexpr int NTOT = NE * (16 * 128 + 16 * 64); const int per = (NTOT + NGW - 1) / NGW;
            cv_it = moe_convert<true>(args.in[16], args.in[18], (unsigned char*)(ws + WS_WGU_T), (unsigned char*)(ws + WS_WDN_T), scr, gw * per, 1, lane, per); }
          __syncthreads(); }
        { SchedIn Sc{G, blk, (const char*)(ws + WS_H8), (const char*)(ws + WS_WIN_T), gsplit, 1 << 20}; gemm_phase<EpiIn, SchedIn, false, true>(lds, Gemm{D / 2, D / 2, D / 2}, Sc, E); }
    }
    SEAM(1);
    if (IN(2)) {
        {
#if defined(FK_TS) && defined(FK_EXP) && FK_EXP == 12
            fk_pa = __builtin_amdgcn_s_memrealtime();
#endif
            SchedOne Sc; Sc.has = blk < 64;
            const int kv = blk >> 5, pm = (blk & 31) >> 2, ks = blk & 3;
            Sc.u.a = (const char*)(ws + (kv ? WS_VCMP : WS_KCMP)) + ((size_t)pm * 256 * 2048 + ks * 1024) * 2; Sc.u.b = (const char*)(ws + (kv ? WS_WV1_T : WS_WK1_T)) + (size_t)ks * 1024 * 2; Sc.u.pm = pm; Sc.u.pn = 0; Sc.u.kind = 0;
            EpiHid E{(float*)(ws + WS_HIDP) + ((size_t)(kv * 4 + ks) * 2048 + pm * 256) * 256};
            gemm_phase<EpiHid, SchedOne>(lds, Gemm{1024, 2048, 4096}, Sc, E);
#if defined(FK_TS) && defined(FK_EXP) && FK_EXP == 12
            fk_pb = __builtin_amdgcn_s_memrealtime();
#endif
        }
#if defined(FK_TS) && defined(FK_EXP) && FK_EXP == 11
        for (int rep = 0; rep < 2; ++rep) { if (rep == 1) { xcd_barrier(bar); fk_pa = __builtin_amdgcn_s_memrealtime(); }
#else
        for (int rep = 0; rep < 1; ++rep) {
#endif
        for (;;) {
            const int it = queue_pop(misc, ctl + CW_Q + 64 * (rep ? 7 : 0));
            if (it >= 1024) break;
            if (it < 512) {
                const int bg = it & 7, qc = it >> 3, b = bg >> 1, g = bg & 1, head = g * 4 + (wave >> 1), tq = qc * 64 + (wave & 1) * 32 + (lane & 31);
                const bf16* qrow = (const bf16*)(ws + WS_QN) + (((size_t)b * 8 + head) * S + tq) * HD;
                bf16* orow = (bf16*)(ws + WS_OWIN) + ((size_t)b * S + tq) * 1024 + head * HD;
                attn_item<0, false>(lds, qrow, (const bf16*)(ws + WS_KWIN) + (size_t)bg * S * HD, (const bf16*)(ws + WS_VWIN) + (size_t)bg * S * HD, ~0ull, tq, 512, qc > 8 ? qc - 8 : 0, qc + 1, orow, nullptr, nullptr, 0.f, 0.f, 0.f);
            } else {
                const int id = it - 512, bh = id >> 4, nb = id & 15, p = tid & 15, kg = tid >> 4;
                const bf16* kb = (const bf16*)(ws + WS_MK) + ((size_t)bh * S + nb * 256) * HD; float a[8];
#pragma unroll
                for (int i = 0; i < 8; ++i) a[i] = 0.f;
                for (int kk = 0; kk < 8; ++kk) { const int key = kg * 8 + kk; const u32x4 w = *(const u32x4*)(kb + (size_t)key * HD + ((p ^ (key & 15)) * 8));
                    a[0] += bf2f(w.x & 0xffff); a[1] += bf2f(w.x >> 16); a[2] += bf2f(w.y & 0xffff); a[3] += bf2f(w.y >> 16); a[4] += bf2f(w.z & 0xffff); a[5] += bf2f(w.z >> 16); a[6] += bf2f(w.w & 0xffff); a[7] += bf2f(w.w >> 16); }
                LAS float* red = (LAS float*)lds;
#pragma unroll
                for (int i = 0; i < 8; ++i) red[kg * 128 + p * 8 + i] = a[i];
                __syncthreads();
                if (tid < 128) { float s = 0.f; for (int q = 0; q < 32; ++q) s += red[q * 128 + tid]; ((float*)(ws + WS_KMEAN))[((size_t)bh * 16 + nb) * HD + tid] = s * (1.0f / 256.0f); }
            }
        }
#if defined(FK_TS) && defined(FK_EXP) && FK_EXP == 11
        if (rep == 1) { xcd_barrier(bar); fk_pb = __builtin_amdgcn_s_memrealtime(); }
#endif
        }
    }
    SEAM(2);
    if (IN(3)) {
        for (int it = blk; it < 256; it += G) {
            __syncthreads();
            {
                const int kv = it >> 7, m0 = (it & 127) * 16;
                LAS float* hid = (LAS float*)lds;
                LAS float* outb = (LAS float*)(lds + 16384);
                const float* hp = (const float*)(ws + WS_HIDP) + (size_t)kv * 4 * 2048 * 256; const float* peb = (const float*)(ws + WS_PEB) + kv * 256;
                for (int i = tid; i < 16 * 256; i += NTHREADS) { const int r = i >> 8, c = i & 255; const size_t o = (size_t)(m0 + r) * 256 + c;
                    const float v = ((hp[o] + hp[o + 2048 * 256]) + (hp[o + 2 * 2048 * 256] + hp[o + 3 * 2048 * 256])) + peb[c]; hid[i] = gelu_tanh_f(v); }
                __syncthreads();
                { const int n = tid & 127, rg = tid >> 7; const float* w2 = args.in[kv ? 9 : 6]; float a0 = 0.f, a1 = 0.f, a2 = 0.f, a3 = 0.f;
#pragma unroll 16
                  for (int j = 0; j < 256; ++j) { const float w = w2[j * 128 + n]; a0 += hid[(rg * 4 + 0) * 256 + j] * w; a1 += hid[(rg * 4 + 1) * 256 + j] * w; a2 += hid[(rg * 4 + 2) * 256 + j] * w; a3 += hid[(rg * 4 + 3) * 256 + j] * w; }
                  outb[(rg * 4 + 0) * 128 + n] = a0; outb[(rg * 4 + 1) * 128 + n] = a1; outb[(rg * 4 + 2) * 128 + n] = a2; outb[(rg * 4 + 3) * 128 + n] = a3; }
                __syncthreads();
                const int bg = m0 >> 8, i0 = m0 & 255;
                if (kv == 0) {
                    if (tid < 256) { const int r = tid >> 4, p = tid & 15, i = i0 + r; float v[8];
#pragma unroll
                        for (int e = 0; e < 8; ++e) v[e] = outb[r * 128 + p * 8 + e];
                        if (p < 4) { int tk = 16 * i + 31; tk = tk < S ? tk : S - 1; const float* cs = (const float*)(ws + WS_CS) + ((size_t)(bg >> 1) * S + tk) * 32 + 8 * (p & 1);
#pragma unroll
                            for (int e = 0; e < 8; ++e) { const float o = outb[r * 128 + (p ^ 2) * 8 + e]; v[e] = p < 2 ? v[e] * cs[e] - o * cs[16 + e] : v[e] * cs[e] + o * cs[16 + e]; } }
                        u32x4 w; w.x = pk2(v[0], v[1]); w.y = pk2(v[2], v[3]); w.z = pk2(v[4], v[5]); w.w = pk2(v[6], v[7]);
                        *(u32x4*)((bf16*)(ws + WS_KC) + (size_t)bg * 4 * 8192 + (size_t)i * HD + ((p ^ (i & 15)) * 8)) = w; }
                } else {
                    const int qd = tid >> 7, d = tid & 127, i = i0 + 4 * qd;
                    u32x2 w; w.x = pk2(outb[(4 * qd) * 128 + d], outb[(4 * qd + 1) * 128 + d]); w.y = pk2(outb[(4 * qd + 2) * 128 + d], outb[(4 * qd + 3) * 128 + d]);
                    *(u32x2*)((bf16*)(ws + WS_VC) + (size_t)bg * 4 * 8192 + (size_t)(i >> 6) * 8192 + (((i & 63) >> 2) * 128 + d) * 4) = w;
                }
            }
        }
        for (int it = blk; it < 256; it += G) {
            __syncthreads();
            const int bh = it >> 3, t = (it & 7) * 512 + tid, own = t >> 8;
            LAS float* km = (LAS float*)lds;
            for (int i = tid; i < 16 * HD; i += NTHREADS) km[i] = ((const float*)(ws + WS_KMEAN))[(size_t)bh * 16 * HD + i];
            __syncthreads();
            const bf16* qr = (const bf16*)(ws + WS_MQ) + ((size_t)bh * S + t) * HD;
            u32x4 qw[16];
#pragma unroll
            for (int d8 = 0; d8 < 16; ++d8) qw[d8] = *(const u32x4*)(qr + d8 * 8);
            float gt[16];
#pragma unroll
            for (int n = 0; n < 16; ++n) { float a = 0.f;
                if (n < own) {
#pragma unroll
                    for (int d8 = 0; d8 < 16; ++d8) { const f32x4 k0 = *(const LAS f32x4*)(km + n * HD + d8 * 8), k1 = *(const LAS f32x4*)(km + n * HD + d8 * 8 + 4); const u32x4 w = qw[d8];
                        a += bf2f(w.x & 0xffff) * k0[0] + bf2f(w.x >> 16) * k0[1] + bf2f(w.y & 0xffff) * k0[2] + bf2f(w.y >> 16) * k0[3] + bf2f(w.z & 0xffff) * k1[0] + bf2f(w.z >> 16) * k1[1] + bf2f(w.w & 0xffff) * k1[2] + bf2f(w.w >> 16) * k1[3]; } }
                gt[n] = n < own ? a : -1e9f; }
            u64 m = 0xFull << (4 * own);
#pragma unroll
            for (int n = 0; n < 16; ++n) { int rank = 0;
#pragma unroll
                for (int np = 0; np < 16; ++np) rank += (gt[np] > gt[n] || (gt[np] == gt[n] && np < n)) ? 1 : 0;
                if (rank < 3 && gt[n] > -0.5e9f) m |= 0xFull << (4 * n); }
            ((u64*)(ws + WS_MMOBA))[(size_t)bh * S + t] = m;
        }
    }
    SEAM(3);
    if (IN(4)) {
        for (;;) {
            const int it = queue_pop(misc, ctl + CW_Q + 64 * 1);
            if (it >= 1024) break;
            if (it < 512) {
                const int qb = 15 - (it >> 5), bh = it & 31, b = bh >> 3, head = bh & 7, tq = qb * 256 + wave * 32 + (lane & 31);
                const bf16* qrow = (const bf16*)(ws + WS_MQ) + ((size_t)bh * S + tq) * HD;
                const u64 mk = ((const u64*)(ws + WS_MMOBA))[(size_t)bh * S + tq];
                unsigned char* orow = (unsigned char*)(ws + WS_OB) + ((size_t)b * S + tq) * 1024 + head * HD;
                attn_item<1, false>(lds, qrow, (const bf16*)(ws + WS_MK) + (size_t)bh * S * HD, (const bf16*)(ws + WS_MV) + (size_t)bh * S * HD, mk, tq, 1 << 30, 0, 4 * (qb + 1), orow, nullptr, nullptr, 0.f, 0.f, 0.f);
            } else { const int id = it - 512; cmp_item(lds, ws, id & 7, 63 - (id >> 3)); }
        }
    }
    SEAM(4);
    if (IN(5)) {
        for (;;) {
            const int it = queue_pop(misc, ctl + CW_Q + 64 * 2);
            if (it >= 512) break;
            const int bg = it & 7, qc = 63 - (it >> 3), b = bg >> 1, g = bg & 1, head = g * 4 + (wave >> 1), tq = qc * 64 + (wave & 1) * 32 + (lane & 31);
            const size_t trow = (size_t)b * S + tq;
            const bf16* qrow = (const bf16*)(ws + WS_QN) + (((size_t)b * 8 + head) * S + tq) * HD;
            const u64 mk = ((const u64*)(ws + WS_MSEL))[(size_t)bg * S + tq];
            const float* gn = (const float*)(ws + WS_GN) + trow * 24;
            attn_item<2, false>(lds, qrow, (const bf16*)(ws + WS_KSLC) + (size_t)bg * S * HD, (const bf16*)(ws + WS_VSLC) + (size_t)bg * S * HD, mk, tq, 1 << 30, 0, qc + 1,
                         (unsigned char*)(ws + WS_OA) + trow * 1024 + head * HD, (const bf16*)(ws + WS_OCMP) + trow * 1024 + head * HD, (const bf16*)(ws + WS_OWIN) + trow * 1024 + head * HD, gn[head], gn[8 + head], gn[16 + head]);
        }
    }
    SEAM(5);
    if (IN(6)) {
        SchedProj Sc{G, blk, (const char*)(ws + WS_OA), (const char*)(ws + WS_OB), (const char*)(ws + WS_WPN_T), (const char*)(ws + WS_WPM_T)}; EpiProj E{ws};
        gemm_phase<EpiProj, SchedProj, false, true>(lds, Gemm{512, 512, 512}, Sc, E);
#if defined(FK_TS) && defined(FK_EXP) && FK_EXP == 8
        xcd_barrier(bar); STAMP(14);
        gemm_phase<EpiProj, SchedProj, false, true>(lds, Gemm{512, 512, 512}, Sc, E, nullptr, nullptr, true);
        xcd_barrier(bar); STAMP(15);
#endif
    }
    SEAM(6);
    if (IN(7)) {
        SchedOut Sc{G, blk, (const char*)(ws + WS_MIX), (const char*)(ws + WS_WOUT_T)}; EpiOut E{x, (bf16*)(ws + WS_X1)};
        gemm_phase<EpiOut, SchedOut, false, true>(lds, Gemm{D / 2, D / 2, D / 2}, Sc, E);
    }
    SEAM(7);
    if (IN(8)) {
        LAS float* part = (LAS float*)lds;
        LAS float* rsv = (LAS float*)(lds + 65536);
        LAS int* lcnt = (LAS int*)(lds + 65536 + 8192);
        LAS int* lbase = lcnt + 32;
        LAS int* lsel = lcnt + 64;
        LAS int* lidx = lcnt + 64 + 2048;
        LAS float* lwt = (LAS float*)(lcnt + 64 + 4096);
        if (tid < NE) lcnt[tid] = 0;
        const int tok0 = blk * 64, fe = lane & 15, kq = lane >> 4;
        { f32x4 gg8[8]; u32x2 vr[8];
#pragma unroll
          for (int i = 0; i < 8; ++i) gg8[i] = ((const f32x4*)args.in[13])[lane + 64 * i];
          { const u32x2* xr = (const u32x2*)((const bf16*)(ws + WS_X1) + (size_t)(tok0 + 8 * wave) * D);
#pragma unroll
            for (int i = 0; i < 8; ++i) vr[i] = xr[lane + 64 * i]; }
          for (int r = 0; r < 8; ++r) { const int tok = tok0 + 8 * wave + r; float ss = 0.f; f32x4 v[8];
              int ln = lane; asm volatile("" : "+v"(ln));
#pragma unroll
              for (int i = 0; i < 8; ++i) { v[i][0] = bf2f(vr[i].x & 0xffff); v[i][1] = bf2f(vr[i].x >> 16); v[i][2] = bf2f(vr[i].y & 0xffff); v[i][3] = bf2f(vr[i].y >> 16); }
              if (r + 1 < 8) { const u32x2* xr = (const u32x2*)((const bf16*)(ws + WS_X1) + (size_t)(tok + 1) * D);
#pragma unroll
                  for (int i = 0; i < 8; ++i) vr[i] = xr[ln + 64 * i]; }
#pragma unroll
              for (int i = 0; i < 8; ++i) ss += v[i][0] * v[i][0] + v[i][1] * v[i][1] + v[i][2] * v[i][2] + v[i][3] * v[i][3];
              ss = wave_sum(ss); const float rs = rsqrtf(ss * (1.0f / D) + 1e-5f);
              unsigned* hr = (unsigned*)(ws + WS_H8 + (size_t)tok * D);
#pragma unroll
              for (int i = 0; i < 8; ++i) { const f32x4 o = v[i] * rs * gg8[i]; hr[ln + 64 * i] = pk4_fp8(o[0], o[1], o[2], o[3]); }
              if (lane == 0) rsv[8 * wave + r] = rs; } }
        bf16x8 bhi[8][2], blo[8][2];
#pragma unroll
        for (int j = 0; j < 8; ++j) { const int k0 = 256 * wave + 64 * (j >> 1) + 16 * kq + 8 * (j & 1);
            const f32x4 g0 = *(const f32x4*)(args.in[13] + k0), g1 = *(const f32x4*)(args.in[13] + k0 + 4);
#pragma unroll
            for (int eb = 0; eb < 2; ++eb) { float v[8], r[8];
#pragma unroll
                for (int i = 0; i < 8; ++i) v[i] = args.in[14][(size_t)(k0 + i) * NE + 16 * eb + fe] * (i < 4 ? g0[i & 3] : g1[i & 3]);
                u32x4 h, l; h.x = pk2(v[0], v[1]); h.y = pk2(v[2], v[3]); h.z = pk2(v[4], v[5]); h.w = pk2(v[6], v[7]);
                r[0] = v[0] - bf2f(h.x & 0xffff); r[1] = v[1] - bf2f(h.x >> 16); r[2] = v[2] - bf2f(h.y & 0xffff); r[3] = v[3] - bf2f(h.y >> 16);
                r[4] = v[4] - bf2f(h.z & 0xffff); r[5] = v[5] - bf2f(h.z >> 16); r[6] = v[6] - bf2f(h.w & 0xffff); r[7] = v[7] - bf2f(h.w >> 16);
                l.x = pk2(r[0], r[1]); l.y = pk2(r[2], r[3]); l.z = pk2(r[4], r[5]); l.w = pk2(r[6], r[7]);
                bhi[j][eb] = __builtin_bit_cast(bf16x8, h); blo[j][eb] = __builtin_bit_cast(bf16x8, l); } }
        { f32x4 lacc[4][2];
#pragma unroll
          for (int rb = 0; rb < 4; ++rb)
#pragma unroll
              for (int eb = 0; eb < 2; ++eb) lacc[rb][eb] = (f32x4){0.f, 0.f, 0.f, 0.f};
#pragma unroll
          for (int rbp = 0; rbp < 2; ++rbp) { bf16x8 af[2][8];
#pragma unroll
              for (int rr = 0; rr < 2; ++rr)
#pragma unroll
                  for (int j = 0; j < 8; ++j) af[rr][j] = *(const bf16x8*)((const bf16*)(ws + WS_X1) + (size_t)(tok0 + 16 * (2 * rbp + rr) + fe) * D + 256 * wave + 64 * (j >> 1) + 16 * kq + 8 * (j & 1));
#pragma unroll
              for (int rr = 0; rr < 2; ++rr)
#pragma unroll
                  for (int j = 0; j < 8; ++j)
#pragma unroll
                      for (int eb = 0; eb < 2; ++eb) { lacc[2 * rbp + rr][eb] = __builtin_amdgcn_mfma_f32_16x16x32_bf16(af[rr][j], bhi[j][eb], lacc[2 * rbp + rr][eb], 0, 0, 0);
                          lacc[2 * rbp + rr][eb] = __builtin_amdgcn_mfma_f32_16x16x32_bf16(af[rr][j], blo[j][eb], lacc[2 * rbp + rr][eb], 0, 0, 0); } }
#pragma unroll
          for (int rb = 0; rb < 4; ++rb)
#pragma unroll
              for (int eb = 0; eb < 2; ++eb)
#pragma unroll
                  for (int i = 0; i < 4; ++i) part[(wave * 64 + 16 * rb + 4 * kq + i) * 32 + 16 * eb + fe] = lacc[rb][eb][i]; }
        __syncthreads();
#pragma unroll 1
        for (int q4 = 0; q4 < 4; ++q4) { const int tl = 16 * q4 + (tid >> 5), e = lane & 31, tok = tok0 + tl; float lg = 0.f;
#pragma unroll
            for (int w8 = 0; w8 < 8; ++w8) lg += part[(w8 * 64 + tl) * 32 + e];
            lg = lg * rsv[tl] + args.in[15][e];
            int rank = 0; float mx = lg;
#pragma unroll
            for (int ep = 0; ep < 32; ++ep) { const float o = __shfl(lg, (lane & 32) + ep); rank += (o > lg || (o == lg && ep < e)) ? 1 : 0; mx = fmaxf(mx, o); }
            const bool sel = rank < 4; const float ex = sel ? __expf(lg - mx) : 0.f; float sum = ex;
#pragma unroll
            for (int o = 1; o < 32; o <<= 1) sum += __shfl_xor(sum, o);
            if (sel) { const int slot = (tl << 2) + rank;
                lsel[slot] = e; lidx[slot] = (int)__hip_atomic_fetch_add((LAS unsigned*)lcnt + e, 1u, __ATOMIC_RELAXED, __HIP_MEMORY_SCOPE_WORKGROUP);
                lwt[slot] = ex / sum; } (void)tok; }
        __syncthreads();
        if (tid < NE) lbase[tid] = (int)__hip_atomic_fetch_add(ctl + CW_CNT + 64 * tid, (unsigned)lcnt[tid], __ATOMIC_RELAXED, __HIP_MEMORY_SCOPE_AGENT);
        __syncthreads();
        if (tid < 256) { const int e = lsel[tid], r = e * T + lbase[e] + lidx[tid];
            ((int*)(ws + WS_ROWDST))[r] = (tok0 + (tid >> 2)) * 4 + (tid & 3); ((float*)(ws + WS_ROWW))[r] = lwt[tid]; }
    }
    SEAM(8);
    STAMP(10);
    if (IN(10)) {
        moe_offsets(misc, ctl + CW_CNT);
        SchedMoe Sc{G, blk, 16, (const LAS int*)(misc + 16), (const char*)(ws + WS_H8), (const char*)(ws + WS_WGU_T), (size_t)4096 * 2048, (size_t)256 * 2048}; EpiAct E{args.in[17], (unsigned char*)(ws + WS_ACT)};
        LAS unsigned short* gtab = (LAS unsigned short*)(lds + MISC_OFF + 1024);
        for (int ui0 = 0; ui0 < 28; ui0 += 4) {
            Unit uu[4]; bool ok[4]; int vv[4];
#pragma unroll
            for (int q = 0; q < 4; ++q) { ok[q] = Sc.next(ui0 + q, uu[q]); vv[q] = (ok[q] && tid < 256) ? ((const int*)(ws + WS_ROWDST))[uu[q].kind * T - (int)misc[16 + uu[q].kind] + uu[q].pm * 256 + tid] : 0; }
#pragma unroll
            for (int q = 0; q < 4; ++q) if (ok[q] && tid < 256) gtab[(ui0 + q) * 256 + tid] = (unsigned short)(vv[q] < 0 ? 0 : (vv[q] >> 2));
            if (!ok[3]) break; }
        __syncthreads();
        gemm_phase<EpiAct, SchedMoe, true, true>(lds, Gemm{D / 2, D / 2, D / 2}, Sc, E, (const char*)(ws + WS_H8), gtab);
#if defined(FK_TS) && defined(FK_EXP) && FK_EXP != 8
        xcd_barrier(bar); STAMP(14);
#if FK_EXP == 1
        gemm_phase<EpiAct, SchedMoe, true, true>(lds, Gemm{D / 2, D / 2, D / 2}, Sc, E, (const char*)(ws + WS_H8), gtab, true);
#elif FK_EXP == 3
        { struct SX { SchedMoe s; __device__ __forceinline__ bool next(int i, Unit& u) const { if (!s.next(i, u)) return false; u.a = s.A + (size_t)(u.pm & 63) * s.ts; return true; } } Sx{Sc};
          gemm_phase<EpiAct, SX, false, true>(lds, Gemm{D / 2, D / 2, D / 2}, Sx, E, nullptr, nullptr, true); }
#elif FK_EXP == 4
        gemm_phase<EpiAct, SchedMoe, true, true, 1>(lds, Gemm{D / 2, D / 2, D / 2}, Sc, E, (const char*)(ws + WS_H8), gtab, true);
#elif FK_EXP == 5
        gemm_phase<EpiAct, SchedMoe, true, true, 2>(lds, Gemm{D / 2, D / 2, D / 2}, Sc, E, (const char*)(ws + WS_H8), gtab, true);
#elif FK_EXP == 6
        gemm_phase<EpiAct, SchedMoe, true, true, 0, true>(lds, Gemm{D / 2, D / 2, D / 2}, Sc, E, (const char*)(ws + WS_H8), gtab, true);
#elif FK_EXP == 7
        { struct SX { SchedMoe s; __device__ __forceinline__ bool next(int i, Unit& u) const { if (!s.next(i, u)) return false; u.a = s.A + (size_t)(u.pm & 1) * s.ts; u.b = s.W + (size_t)(u.pn & 1) * s.ts; return true; } } Sx{Sc};
          gemm_phase<EpiAct, SX, false, true>(lds, Gemm{D / 2, D / 2, D / 2}, Sx, E, nullptr, nullptr, true); }
#elif FK_EXP == 2
        gemm_phase<EpiAct, SchedMoe, true, true>(lds, Gemm{D / 2, D / 2, D / 2}, Sc, E, (const char*)(ws + WS_H8), gtab, false);
#endif
        xcd_barrier(bar); STAMP(15);
#endif
    }
    SEAM(10);
    if (IN(11)) {
        moe_offsets(misc, ctl + CW_CNT);
        SchedMoe Sc{G, blk, 8, (const LAS int*)(misc + 16), (const char*)(ws + WS_ACT), (const char*)(ws + WS_WDN_T), (size_t)2048 * 2048, (size_t)256 * 2048}; EpiDown E{args.in[19], (const int*)(ws + WS_ROWDST), (const float*)(ws + WS_ROWW), (unsigned char*)(ws + WS_YS), (const LAS int*)(misc + 16)};
        gemm_phase<EpiDown, SchedMoe, false, true>(lds, Gemm{FF / 2, FF / 2, FF / 2}, Sc, E);
    }
    SEAM(11);
    if (IN(12)) {
        for (int tok = gw; tok < T; tok += NGW) {
            f32x4 v[8]; float ss = 0.f;
#pragma unroll
            for (int i = 0; i < 8; ++i) { const u32x2 xb = ((const u32x2*)((const bf16*)(ws + WS_X1) + (size_t)tok * D))[lane + 64 * i]; f32x4 a = {bf2f(xb.x & 0xffff), bf2f(xb.x >> 16), bf2f(xb.y & 0xffff), bf2f(xb.y >> 16)}, ysum = {0.f, 0.f, 0.f, 0.f};
#pragma unroll
                for (int k = 0; k < 4; ++k) { const int y = ((const int*)(ws + WS_YS + ((size_t)tok * 4 + k) * D))[lane + 64 * i];
                    const auto lo = __builtin_amdgcn_cvt_pk_f32_fp8(y, false), hi = __builtin_amdgcn_cvt_pk_f32_fp8(y, true);
                    ysum[0] += lo[0]; ysum[1] += lo[1]; ysum[2] += hi[0]; ysum[3] += hi[1]; }
                a = a + ysum * (1.0f / YS_SCALE);
                v[i] = a; ss += a[0] * a[0] + a[1] * a[1] + a[2] * a[2] + a[3] * a[3]; }
            ss = wave_sum(ss); const float rs = rsqrtf(ss * (1.0f / D) + 1e-5f);
#pragma unroll
            for (int i = 0; i < 8; ++i) { const f32x4 gg = ((const f32x4*)args.in[20])[lane + 64 * i]; ((f32x4*)(args.out + (size_t)tok * D))[lane + 64 * i] = v[i] * rs * gg; }
        }
    }
#ifdef FK_TS
    if (blk == 0 && tid == 0) {
        asm volatile("s_waitcnt vmcnt(0)" ::: "memory");
        const unsigned long long tend = __builtin_amdgcn_s_memrealtime();
        misc[64 + 2 * 13] = (unsigned)tend; misc[65 + 2 * 13] = (unsigned)(tend >> 32);
        const unsigned long long ta = ((unsigned long long)misc[65 + 2 * FK_TS_LO] << 32) | misc[64 + 2 * FK_TS_LO], tb = ((unsigned long long)misc[65 + 2 * FK_TS_HI] << 32) | misc[64 + 2 * FK_TS_HI];
#if FK_TS_LO == 99
        const unsigned long long span = (fk_pb - fk_pa) * FK_TS_F;
#else
        const unsigned long long span = (tb - ta) * FK_TS_F;
#endif
        if (span < 2000000ull) while (__builtin_amdgcn_s_memrealtime() - tend < span) __builtin_amdgcn_s_sleep(8);
    }
#endif
#undef IN
#undef SEAM
}

static void launch_phases(void* const* d_in, void* d_out, void* d_ws, hipStream_t stream, int lo, int hi, bool per_phase) {
    static int grid = 0;
    if (grid == 0) {
        int dev = 0, cus = 0;
        (void)hipGetDevice(&dev); (void)hipDeviceGetAttribute(&cus, hipDeviceAttributeMultiprocessorCount, dev);
        (void)hipFuncSetAttribute((const void*)fwd, hipFuncAttributeMaxDynamicSharedMemorySize, LDS_BYTES);
        grid = cus > 0 ? cus : 256;
    }
    Args a{};
    for (int i = 0; i < 21; ++i) a.in[i] = (const float*)d_in[i];
    a.out = (float*)d_out; a.ws = (unsigned char*)d_ws;
    if (per_phase) { for (int p = lo; p < hi; ++p) { a.ph_lo = p; a.ph_hi = p + 1; hipLaunchKernelGGL(fwd, dim3(grid), dim3(NTHREADS), LDS_BYTES, stream, a); } }
    else { a.ph_lo = lo; a.ph_hi = hi; hipLaunchKernelGGL(fwd, dim3(grid), dim3(NTHREADS), LDS_BYTES, stream, a); }
}
}
extern "C" void kernel_launch(void* const* d_in, const int* in_sizes, int n_in, void* d_out, int out_size, void* d_ws, size_t ws_size, hipStream_t stream) {
    using namespace fk;
    (void)hipMemsetAsync((char*)d_ws + WS_CTL, 0, CTL_BYTES, stream);
    launch_phases(d_in, d_out, d_ws, stream, 0, NPHASE, false);
}
```

```cpp
#include <hip/hip_runtime.h>
#include <stdint.h>
namespace fk {
#define LAS __attribute__((address_space(3)))
#define GAS __attribute__((address_space(1)))
typedef unsigned short bf16;
typedef unsigned long long u64;
typedef short bf16x8 __attribute__((ext_vector_type(8)));
typedef float f32x4 __attribute__((ext_vector_type(4)));
typedef float f32x16 __attribute__((ext_vector_type(16)));
typedef unsigned u32x4 __attribute__((ext_vector_type(4)));
typedef unsigned u32x2 __attribute__((ext_vector_type(2)));
typedef float f32x2_t __attribute__((ext_vector_type(2)));
typedef __bf16 bf16x2_t __attribute__((ext_vector_type(2)));

constexpr int D = 2048, NB = 4, S = 4096, T = NB * S, HD = 128, NE = 32, FF = 2048, INW = 9752;
constexpr int NTHREADS = 512, NWAVES = 8;

__device__ __forceinline__ unsigned pk2(float lo, float hi) { f32x2_t v = {lo, hi}; bf16x2_t b = __builtin_convertvector(v, bf16x2_t); return __builtin_bit_cast(unsigned, b); }
__device__ __forceinline__ float bf2f(unsigned short b) { return __builtin_bit_cast(float, (unsigned)b << 16); }
__device__ __forceinline__ float wave_sum(float v) {
#pragma unroll
    for (int o = 1; o < 64; o <<= 1) v += __shfl_xor(v, o);
    return v;
}
__device__ __forceinline__ float sigmoid_f(float x) { return __builtin_amdgcn_rcpf(1.0f + __expf(-x)); }

#define XB_TMO      128
#define XB_XCNT(j)  (256  + 64 * (j))
#define XB_XSUB(j)  (1280 + 64 * (j))
#define XB_XGEN(j)  (2304 + 64 * (j))
#define XB_TOP      3328
#define XB_TOPGEN   3392
#define XCD_BAR_WORDS 3456
#define XB_SPIN_CAP (1u << 18)
__device__ __forceinline__ unsigned xb_ld(unsigned* p)              { return __hip_atomic_load(p, __ATOMIC_RELAXED, __HIP_MEMORY_SCOPE_AGENT); }
__device__ __forceinline__ unsigned xb_add(unsigned* p, unsigned v) { return __hip_atomic_fetch_add(p, v, __ATOMIC_RELAXED, __HIP_MEMORY_SCOPE_AGENT); }
__device__ __forceinline__ unsigned xb_xcc_id() { return (unsigned)__builtin_amdgcn_s_getreg((3 << 11) | 20) & 0xFu; }
#define XB_SPIN(cond, bar) do { unsigned _sp = 0; while (cond) { __builtin_amdgcn_s_sleep(1); \
    if ((++_sp & 255u) == 0u) { if (xb_ld(&(bar)[XB_TMO])) break; if (_sp > XB_SPIN_CAP) { atomicAdd(&(bar)[XB_TMO], 1u); break; } } } } while (0)
struct XcdBarrier { unsigned* bar; unsigned x; volatile LAS unsigned* st; };
__device__ __forceinline__ XcdBarrier xcd_barrier_post(unsigned* bar, volatile LAS unsigned* st) {
    XcdBarrier b; b.bar = bar; b.x = xb_xcc_id(); b.st = st;
    if (threadIdx.x == 0) (void)xb_add(&bar[XB_XCNT(b.x)], 1u);
    return b;
}
__device__ __forceinline__ void xcd_barrier_complete(unsigned* bar, unsigned x, unsigned& nloc, unsigned& nx) {
    const unsigned G = gridDim.x * gridDim.y * gridDim.z;
    unsigned sum, cnt, mine, sp = 0u;
    for (;;) {
        sum = 0u; cnt = 0u; mine = 0u;
#pragma unroll
        for (unsigned j = 0; j < 16; ++j) { const unsigned c = xb_ld(&bar[XB_XCNT(j)]); sum += c; cnt += (c > 0u) ? 1u : 0u; mine = (j == x) ? c : mine; }
        if (sum == G) break;
        __builtin_amdgcn_s_sleep(1);
        if ((++sp & 255u) == 0u) { if (xb_ld(&bar[XB_TMO])) break; if (sp > XB_SPIN_CAP) { atomicAdd(&bar[XB_TMO], 1u); break; } }
    }
    nloc = mine > 0u ? mine : 1u; nx = cnt > 0u ? cnt : 1u;
}
__device__ __forceinline__ void xcd_barrier(const XcdBarrier& b) {
    asm volatile("s_waitcnt vmcnt(0)" ::: "memory");
    __syncthreads();
    if (threadIdx.x == 0) {
        unsigned* bar = b.bar;
        __builtin_amdgcn_s_waitcnt(0);
        unsigned nloc = b.st[0], nx = b.st[1];
        if (nloc == 0u) { xcd_barrier_complete(bar, b.x, nloc, nx); b.st[0] = nloc; b.st[1] = nx; }
        const unsigned old = xb_add(&bar[XB_XSUB(b.x)], 1u);
        const unsigned gen = old / nloc;
        if (old + 1u == (gen + 1u) * nloc) {
            __builtin_amdgcn_fence(__ATOMIC_RELEASE, "agent");
            asm volatile("s_waitcnt vmcnt(0)" ::: "memory");
            const unsigned og = xb_add(&bar[XB_TOP], 1u);
            const unsigned tg = og / nx;
            if (og + 1u == (tg + 1u) * nx) xb_add(&bar[XB_TOPGEN], 1u);
            else XB_SPIN(xb_ld(&bar[XB_TOPGEN]) == tg, bar);
            __builtin_amdgcn_fence(__ATOMIC_ACQUIRE, "agent");
            xb_add(&bar[XB_XGEN(b.x)], 1u);
            asm volatile("s_waitcnt vmcnt(0)" ::: "memory");
        } else {
            XB_SPIN(xb_ld(&bar[XB_XGEN(b.x)]) == gen, bar);
            __builtin_amdgcn_fence(__ATOMIC_ACQUIRE, "agent");
            asm volatile("s_waitcnt vmcnt(0)" ::: "memory");
        }
    }
    __syncthreads();
}

constexpr int BM = 256, BK = 64, HALF = 128, HTB = HALF * BK * 2, STAGE_BYTES = 8 * HTB, NXCD = 8, WGM = 8;
__host__ __device__ __forceinline__ int lds_byte(int r, int c) { const int st = (r >> 4) * 2 + (c >> 5), rr = r & 15, cc = c & 31, ob = rr * 64 + cc * 2; return st * 1024 + (ob ^ (((ob >> 9) & 1) << 5)); }
__host__ __device__ __forceinline__ void stage_rc(int b, int& R, int& C) { const int st = b / 1024, sb = b % 1024, swz = sb ^ (((sb >> 9) & 1) << 5); R = (st >> 1) * 16 + swz / 64; C = (st & 1) * 32 + (swz % 64) / 2; }
__host__ __device__ __forceinline__ int lds_byte8(int r, int q) { return ((r >> 4) * 2 + (q >> 2)) * 1024 + (((r & 15) * 64 + (q & 3) * 16) ^ (((r >> 3) & 1) << 4)); }
__host__ __device__ __forceinline__ void stage_rc8(int b, int& R, int& C) { const int st = b / 1024, sb = b % 1024, rr = sb / 64, swz = sb ^ (((rr >> 3) & 1) << 4); R = (st >> 1) * 16 + rr; C = ((st & 1) * 4 + (swz % 64) / 16) * 8; }
__host__ __device__ __forceinline__ int perm32(int rho) { const int n = rho >> 4, i = rho & 15; return 8 * (i >> 2) + 4 * n + (i & 3); }

struct Unit { const char* a; const char* b; int pm, pn, kind; };
struct Gemm { int K, lda, ldb; };
__device__ __forceinline__ void tile_map(int L, int nM, int nN, int& pm, int& pn) {
    const int nwg = nM * nN; int wgid = L;
    { const int q = nwg / NXCD, r = nwg % NXCD, xcd = wgid % NXCD, off = wgid / NXCD; wgid = (xcd < r ? xcd * (q + 1) : r * (q + 1) + (xcd - r) * q) + off; }
    const int nig = WGM * nN, gid = wgid / nig, fm = gid * WGM, gsz = (nM - fm) < WGM ? (nM - fm) : WGM;
    pm = fm + ((wgid % nig) % gsz); pn = (wgid % nig) / gsz;
}
typedef int i32x8 __attribute__((ext_vector_type(8)));
typedef int i32x4 __attribute__((ext_vector_type(4)));
template <class Epi, class Sched, bool GATHER = false, bool FP8 = false, int DBG = 0, bool DMAX = false>
__device__ __forceinline__ void gemm_phase(LAS unsigned char* lds, const Gemm g, const Sched& S, const Epi& E, const char* A0 = nullptr, const LAS unsigned short* gtab = nullptr, const bool skip_epi = false) {
    const int tid = threadIdx.x, wid = __builtin_amdgcn_readfirstlane(tid >> 6), lane = tid & 63, wr = wid >> 2, wc = wid & 3, fr = lane & 15, fq = lane >> 4;
    const int K = g.K, nt = K / BK;
    unsigned voffA[2], voffB[2]; int gR[2], gC[2];
#pragma unroll
    for (int i = 0; i < 2; ++i) { int R, C; if constexpr (FP8) stage_rc8(tid * 16 + i * 8192, R, C); else stage_rc(tid * 16 + i * 8192, R, C); const int Rb = Epi::PERM ? ((R & ~31) + perm32(R & 31)) : R; gR[i] = R; gC[i] = C * 2;
        voffA[i] = (unsigned)(R * g.lda + C) * 2u; voffB[i] = (unsigned)(Rb * g.ldb + C) * 2u; }
    unsigned gaC[2][2], gaN[2][2];
#define PG8_GA(ga, slot) do { _Pragma("unroll") for (int _h = 0; _h < 2; ++_h) _Pragma("unroll") for (int _i = 0; _i < 2; ++_i) \
        ga[_h][_i] = (unsigned)gtab[(slot) * 256 + _h * 128 + gR[_i]] * (unsigned)(g.lda * 2) + (unsigned)gC[_i]; } while (0)
#define PG8_STAGEA(bufoff, h, kofs, nx) do { if constexpr (GATHER) { const char* _gb = A0 + (kofs); asm volatile("" : "+s"(_gb)); _Pragma("unroll") for (int _i = 0; _i < 2; ++_i) \
        __builtin_amdgcn_global_load_lds((const unsigned*)(_gb + ((nx) ? gaN[h][_i] : gaC[h][_i])), (LAS unsigned*)(lds + (bufoff) + ldsw + _i * 8192), 16, 0, 0); } \
    else { PG8_STAGE(bufoff, ((nx) ? nA : cA) + (kofs) + (h) * hstepA, voffA); } } while (0)
    const size_t kstep = (size_t)(BK * 2);
    const size_t hstepA = (size_t)HALF * g.lda * 2, hstepB = (size_t)HALF * g.ldb * 2;
    const unsigned ldsw = (unsigned)wid * 1024u;
    const int aoff = lds_byte(wr * 64 + fr, fq * 8), boff = lds_byte(wc * 32 + fr, fq * 8);
    const int aoff80 = lds_byte8(wr * 64 + fr, 2 * fq), aoff81 = lds_byte8(wr * 64 + fr, 2 * fq + 1), boff80 = lds_byte8(wc * 32 + fr, 2 * fq), boff81 = lds_byte8(wc * 32 + fr, 2 * fq + 1);
#define PG8_SA(b, h) (((b) * 2 + (h)) * HTB)
#define PG8_SB(b, h) ((4 + (b) * 2 + (h)) * HTB)
#define PG8_STAGE(bufoff, gbase, voff) do { const char* _gb = (const char*)(gbase); asm volatile("" : "+s"(_gb)); _Pragma("unroll") for (int _i = 0; _i < 2; ++_i) \
        __builtin_amdgcn_global_load_lds((const unsigned*)(_gb + (voff)[_i]), (LAS unsigned*)(lds + (bufoff) + ldsw + _i * 8192), 16, 0, 0); } while (0)
#define PG8_FRAG8(dst, p0, p1) do { const i32x4 _lo = *(const LAS i32x4*)(p0), _hi = *(const LAS i32x4*)(p1); dst = __builtin_shufflevector(_lo, _hi, 0, 1, 2, 3, 4, 5, 6, 7); } while (0)
#define PG8_LDA(dst, b, h) do { if constexpr (DBG == 2) { } else if constexpr (FP8) { _Pragma("unroll") for (int m = 0; m < 4; ++m) PG8_FRAG8(dst##8[m], lds + PG8_SA(b, h) + aoff80 + m * 2048, lds + PG8_SA(b, h) + aoff81 + m * 2048); } \
    else { _Pragma("unroll") for (int m = 0; m < 4; ++m) _Pragma("unroll") for (int k = 0; k < 2; ++k) dst[m][k] = *(const LAS bf16x8*)(lds + PG8_SA(b, h) + aoff + m * 2048 + k * 1024); } } while (0)
#define PG8_LDB(dst, b, h) do { if constexpr (DBG == 2) { } else if constexpr (FP8) { _Pragma("unroll") for (int n = 0; n < 2; ++n) PG8_FRAG8(dst##8[n], lds + PG8_SB(b, h) + boff80 + n * 2048, lds + PG8_SB(b, h) + boff81 + n * 2048); } \
    else { _Pragma("unroll") for (int n = 0; n < 2; ++n) _Pragma("unroll") for (int k = 0; k < 2; ++k) dst[n][k] = *(const LAS bf16x8*)(lds + PG8_SB(b, h) + boff + n * 2048 + k * 1024); } } while (0)
#define PG8_MMA(ai, bj, At, Bt) do { __builtin_amdgcn_s_setprio(1); if constexpr (DBG == 1) { _Pragma("unroll") for (int m = 0; m < 4; ++m) asm volatile("" :: "v"(At##8[m])); _Pragma("unroll") for (int n = 0; n < 2; ++n) asm volatile("" :: "v"(Bt##8[n])); } else if constexpr (FP8) { _Pragma("unroll") for (int m = 0; m < 4; ++m) _Pragma("unroll") for (int n = 0; n < 2; ++n) \
        asm volatile("v_mfma_scale_f32_16x16x128_f8f6f4 %0, %1, %2, %0, %3, %3 op_sel_hi:[0,0,0]" : "+v"(acc[ai][bj][m][n]) : "v"(Bt##8[n]), "v"(At##8[m]), "v"(sc8)); } \
    else { _Pragma("unroll") for (int m = 0; m < 4; ++m) _Pragma("unroll") for (int n = 0; n < 2; ++n) _Pragma("unroll") for (int k = 0; k < 2; ++k) \
        acc[ai][bj][m][n] = __builtin_amdgcn_mfma_f32_16x16x32_bf16(Bt[n][k], At[m][k], acc[ai][bj][m][n], 0, 0, 0); } __builtin_amdgcn_s_setprio(0); } while (0)
#define PG8_MF8(ai, bj, At, Bt, m, n) asm volatile("v_mfma_scale_f32_16x16x128_f8f6f4 %0, %1, %2, %0, %3, %3 op_sel_hi:[0,0,0]" : "+v"(acc[ai][bj][m][n]) : "v"(Bt##8[n]), "v"(At##8[m]), "v"(sc8))
#define PG8_MMAX(ai, bj, At, Bt, X1, X2) do { __builtin_amdgcn_s_setprio(1); PG8_MF8(ai, bj, At, Bt, 0, 0); PG8_MF8(ai, bj, At, Bt, 0, 1); X1; PG8_MF8(ai, bj, At, Bt, 1, 0); PG8_MF8(ai, bj, At, Bt, 1, 1); \
        PG8_MF8(ai, bj, At, Bt, 2, 0); PG8_MF8(ai, bj, At, Bt, 2, 1); X2; PG8_MF8(ai, bj, At, Bt, 3, 0); PG8_MF8(ai, bj, At, Bt, 3, 1); __builtin_amdgcn_s_setprio(0); } while (0)
#define PG8_WAIT_V(n) asm volatile("s_waitcnt vmcnt(" #n ")" ::: "memory")
#define PG8_WAIT_L(n) asm volatile("s_waitcnt lgkmcnt(" #n ")" ::: "memory")
#define PG8_BAR __builtin_amdgcn_s_barrier()
#define PG8_SCHED __builtin_amdgcn_sched_barrier(0)
    Unit cur, nxt; int ui = 0;
    if (!S.next(0, cur)) return;
    f32x4 acc[2][2][4][2];
#pragma unroll
    for (int a = 0; a < 2; ++a)
#pragma unroll
        for (int b = 0; b < 2; ++b)
#pragma unroll
            for (int m = 0; m < 4; ++m)
#pragma unroll
                for (int n = 0; n < 2; ++n) acc[a][b][m][n] = (f32x4){0.f, 0.f, 0.f, 0.f};
    bf16x8 At[4][2], B0[2][2], B1[2][2];
    i32x8 At8[4], B08[2], B18[2];
    if constexpr (DBG == 2) {
#pragma unroll
        for (int m = 0; m < 4; ++m) { At8[m] = (i32x8){0, 0, 0, 0, 0, 0, 0, 0}; asm volatile("" : "+v"(At8[m])); }
#pragma unroll
        for (int n = 0; n < 2; ++n) { B08[n] = (i32x8){0, 0, 0, 0, 0, 0, 0, 0}; B18[n] = B08[n]; asm volatile("" : "+v"(B08[n]), "+v"(B18[n])); } }
    const int sc8 = 0x7f7f7f7f;
    const char* cA = cur.a; const char* cB = cur.b; const char* nA = cA;
    if constexpr (GATHER) { PG8_GA(gaC, 0); }
    {
        PG8_STAGE(PG8_SB(0, 0), cB, voffB); PG8_STAGE(PG8_SB(0, 1), cB + hstepB, voffB); PG8_STAGEA(PG8_SA(0, 0), 0, (size_t)0, false); PG8_STAGEA(PG8_SA(0, 1), 1, (size_t)0, false);
        if (wr == 1) PG8_BAR;
        PG8_WAIT_V(2); PG8_BAR;
        PG8_STAGE(PG8_SB(1, 0), cB + kstep, voffB); PG8_STAGEA(PG8_SA(1, 0), 0, kstep, false); PG8_STAGE(PG8_SB(1, 1), cB + hstepB + kstep, voffB);
        PG8_WAIT_V(6); PG8_BAR;
    }
    for (;;) {
        const bool has_next = S.next(ui + 1, nxt);
        nA = has_next ? nxt.a : cA; const char* nB = has_next ? nxt.b : cB;
        if constexpr (GATHER) { if (has_next) { PG8_GA(gaN, ui + 1); } else {
#pragma unroll
            for (int _h = 0; _h < 2; ++_h)
#pragma unroll
                for (int _i = 0; _i < 2; ++_i) gaN[_h][_i] = gaC[_h][_i]; } }
        for (int t = 0; t < nt; t += 2) {
            const bool last = (t == nt - 2);
            const size_t k1 = (size_t)(t + 1) * kstep, k2 = last ? (size_t)0 : (size_t)(t + 2) * kstep, k3 = k2 + kstep;
            const char* b2 = last ? nB : cB + (size_t)(t + 2) * kstep;
            const char* b3 = b2 + kstep;
            if constexpr (FP8 && DMAX) {
            PG8_LDB(B0, 0, 0); PG8_LDB(B1, 0, 1); PG8_SCHED; PG8_LDA(At, 0, 0); PG8_STAGEA(PG8_SA(1, 1), 1, k1, false);
            PG8_WAIT_V(8); PG8_WAIT_L(0); PG8_BAR; PG8_MMAX(0, 0, At, B0, (void)0, (void)0); PG8_MMAX(0, 1, At, B1, (void)0, (void)0); PG8_BAR; PG8_SCHED;
            PG8_LDA(At, 0, 1); PG8_STAGE(PG8_SB(0, 0), b2, voffB); PG8_STAGEA(PG8_SA(0, 0), 0, k2, last);
            PG8_WAIT_V(6); PG8_WAIT_L(0); PG8_BAR; PG8_MMAX(1, 0, At, B0, PG8_STAGE(PG8_SB(0, 1), b2 + hstepB, voffB), (void)0); PG8_MMAX(1, 1, At, B1, (void)0, (void)0); PG8_BAR; PG8_SCHED;
            PG8_LDB(B0, 1, 0); PG8_LDB(B1, 1, 1); PG8_SCHED; PG8_LDA(At, 1, 0); PG8_STAGEA(PG8_SA(0, 1), 1, k2, last);
            PG8_WAIT_V(8); PG8_WAIT_L(0); PG8_BAR; PG8_MMAX(0, 0, At, B0, (void)0, (void)0); PG8_MMAX(0, 1, At, B1, (void)0, (void)0); PG8_BAR; PG8_SCHED;
            PG8_LDA(At, 1, 1); PG8_STAGE(PG8_SB(1, 0), b3, voffB); PG8_STAGEA(PG8_SA(1, 0), 0, k3, last);
            PG8_WAIT_V(6); PG8_WAIT_L(0); PG8_BAR; PG8_MMAX(1, 0, At, B0, PG8_STAGE(PG8_SB(1, 1), b3 + hstepB, voffB), (void)0); PG8_MMAX(1, 1, At, B1, (void)0, (void)0); PG8_BAR; PG8_SCHED;
            continue; }
            PG8_LDB(B0, 0, 0); PG8_LDB(B1, 0, 1); PG8_SCHED; PG8_LDA(At, 0, 0); PG8_STAGEA(PG8_SA(1, 1), 1, k1, false);
            PG8_WAIT_V(8); PG8_WAIT_L(0); PG8_BAR; PG8_MMA(0, 0, At, B0); PG8_MMA(0, 1, At, B1); PG8_BAR; PG8_SCHED;
            PG8_LDA(At, 0, 1); PG8_STAGE(PG8_SB(0, 0), b2, voffB); PG8_STAGE(PG8_SB(0, 1), b2 + hstepB, voffB); PG8_STAGEA(PG8_SA(0, 0), 0, k2, last);
            PG8_WAIT_V(8); PG8_WAIT_L(0); PG8_BAR; PG8_MMA(1, 0, At, B0); PG8_MMA(1, 1, At, B1); PG8_BAR; PG8_SCHED;
            PG8_LDB(B0, 1, 0); PG8_LDB(B1, 1, 1); PG8_SCHED; PG8_LDA(At, 1, 0); PG8_STAGEA(PG8_SA(0, 1), 1, k2, last);
            PG8_WAIT_V(8); PG8_WAIT_L(0); PG8_BAR; PG8_MMA(0, 0, At, B0); PG8_MMA(0, 1, At, B1); PG8_BAR; PG8_SCHED;
            PG8_LDA(At, 1, 1); PG8_STAGE(PG8_SB(1, 0), b3, voffB); PG8_STAGE(PG8_SB(1, 1), b3 + hstepB, voffB); PG8_STAGEA(PG8_SA(1, 0), 0, k3, last);
            PG8_WAIT_V(8); PG8_WAIT_L(0); PG8_BAR; PG8_MMA(1, 0, At, B0); PG8_MMA(1, 1, At, B1); PG8_BAR; PG8_SCHED;
        }
        if (wr == 0) PG8_BAR;
        if constexpr (FP8) asm volatile("s_nop 15\n\ts_nop 15" ::: "memory");
        { int fr_ = fr, fq_ = fq; asm volatile("" : "+v"(fr_), "+v"(fq_));
          if (!skip_epi) E(acc, cur, wr, wc, fr_, fq_); }
        if (!has_next) break;
#pragma unroll
        for (int a = 0; a < 2; ++a)
#pragma unroll
            for (int b = 0; b < 2; ++b)
#pragma unroll
                for (int m = 0; m < 4; ++m)
#pragma unroll
                    for (int n = 0; n < 2; ++n) acc[a][b][m][n] = (f32x4){0.f, 0.f, 0.f, 0.f};
        cur = nxt; cA = nA; cB = nB; ++ui;
        if constexpr (GATHER) {
#pragma unroll
            for (int _h = 0; _h < 2; ++_h)
#pragma unroll
                for (int _i = 0; _i < 2; ++_i) gaC[_h][_i] = gaN[_h][_i]; }
        if (wr == 1) PG8_BAR;
    }
    PG8_WAIT_V(0);
    PG8_BAR;
#undef PG8_SA
#undef PG8_SB
#undef PG8_STAGE
#undef PG8_STAGEA
#undef PG8_GA
#undef PG8_LDA
#undef PG8_FRAG8
#undef PG8_LDB
#undef PG8_MMA
#undef PG8_WAIT_V
#undef PG8_WAIT_L
#undef PG8_BAR
#undef PG8_SCHED
}

constexpr size_t al256(size_t x) { return (x + 255) & ~(size_t)255; }
constexpr int PMAX = T * 4 + NE * 256;
constexpr size_t WS_CTL = 0, CTL_BYTES = 1u << 20;
constexpr size_t WS_WIN_T  = CTL_BYTES;
constexpr size_t WS_WK1_T  = WS_WIN_T + al256((size_t)9984 * 2048 * 2);
constexpr size_t WS_WV1_T  = WS_WK1_T + al256((size_t)256 * 4096 * 2);
constexpr size_t WS_WPN_T  = WS_WV1_T + al256((size_t)256 * 4096 * 2);
constexpr size_t WS_WPM_T  = WS_WPN_T + al256((size_t)2048 * 1024 * 2);
constexpr size_t WS_WOUT_T = WS_WPM_T + al256((size_t)2048 * 1024 * 2);
constexpr size_t WS_WGU_T  = WS_WOUT_T + al256((size_t)2048 * 2048 * 2);
constexpr size_t WS_WDN_T  = WS_WGU_T + al256((size_t)NE * 4096 * 2048 * 2);
constexpr size_t WS_H      = WS_WDN_T + al256((size_t)NE * 2048 * 2048 * 2);
constexpr size_t WS_X1     = WS_H + al256((size_t)T * D * 2);
constexpr size_t WS_SELE   = WS_X1 + al256((size_t)T * D * 4);
constexpr size_t WS_SELW   = WS_SELE + al256((size_t)T * 4 * 4);
constexpr size_t WS_SELP   = WS_SELW + al256((size_t)T * 4 * 4);
constexpr size_t WS_ROWDST = WS_SELP + al256((size_t)T * 4 * 4);
constexpr size_t WS_ROWW   = WS_ROWDST + al256((size_t)NE * T * 4);
constexpr size_t WS_H8     = WS_ROWW + al256((size_t)NE * T * 4);
constexpr size_t WS_WGM8   = WS_H8 + al256((size_t)T * D);
constexpr size_t WS_U0     = WS_WGM8 + al256((size_t)4096 * 2048);
constexpr size_t WS_QN     = WS_U0;
constexpr size_t HB2 = al256((size_t)T * 2 * HD * 2 + 65536);
constexpr size_t HB8 = al256((size_t)T * 8 * HD * 2);
constexpr size_t WS_KCMP   = WS_QN + HB8;
constexpr size_t WS_VCMP   = WS_KCMP + HB2;
constexpr size_t WS_KSLC   = WS_VCMP + HB2;
constexpr size_t WS_KWIN   = WS_KSLC + HB2;
constexpr size_t WS_VSLC   = WS_KWIN + HB2;
constexpr size_t WS_VWIN   = WS_VSLC + HB2;
constexpr size_t WS_MQ     = WS_VWIN + HB2;
constexpr size_t WS_MK     = WS_MQ + HB8;
constexpr size_t WS_MV     = WS_MK + HB8;
constexpr size_t WS_GN     = WS_MV + HB8;
constexpr size_t WS_GM     = WS_GN + al256((size_t)T * 24 * 4);
constexpr size_t WS_CS     = WS_GM + al256((size_t)T * 4096 * 2);
constexpr size_t WS_HIDP   = WS_CS + al256((size_t)T * 32 * 4);
constexpr size_t WS_PEB    = WS_HIDP + al256((size_t)2 * 4 * 2048 * 256 * 4);
constexpr size_t WS_KC     = WS_PEB + al256(2 * 256 * 4);
constexpr size_t WS_VC     = WS_KC + al256((size_t)8 * 4 * 8192 * 2);
constexpr size_t WS_KMEAN  = WS_VC + al256((size_t)8 * 4 * 8192 * 2);
constexpr size_t WS_MSEL   = WS_KMEAN + al256((size_t)NB * 8 * 16 * HD * 4);
constexpr size_t WS_MMOBA  = WS_MSEL + al256((size_t)NB * 2 * S * 8);
constexpr size_t WS_OCMP   = WS_MMOBA + al256((size_t)NB * 8 * S * 8);
constexpr size_t WS_OWIN   = WS_OCMP + al256((size_t)T * 1024 * 4);
constexpr size_t WS_OA     = WS_OWIN + al256((size_t)T * 1024 * 4);
constexpr size_t WS_OB     = WS_OA + al256((size_t)T * 1024 * 2);
constexpr size_t WS_MIXP   = WS_OB + al256((size_t)T * 1024 * 2);
constexpr size_t WS_MIX    = WS_MIXP + al256((size_t)T * D * 4);
constexpr size_t WS_ATT_END = WS_MIX + al256((size_t)T * D * 2);
constexpr size_t WS_XPAD   = WS_U0;
constexpr size_t WS_ACT    = WS_XPAD + al256((size_t)PMAX * D * 2);
constexpr size_t WS_YS     = WS_ACT + al256((size_t)PMAX * FF * 2);
constexpr size_t WS_MOE_END = WS_YS + al256((size_t)T * 4 * D * 2);
constexpr size_t WS_END    = WS_ATT_END > WS_MOE_END ? WS_ATT_END : WS_MOE_END;
constexpr int CW_BAR = 4096;
constexpr int CW_CNT = 16384;
constexpr int CW_Q   = 16384 + 64 * 32;
constexpr int RING_BYTES = 131072, MISC_OFF = 131072, LDS_BYTES = 147456;

constexpr float A8_SCALE = 64.0f;
constexpr float YS_SCALE = 32.0f;
constexpr float W8_SCALE = 64.0f;
struct Args { const float* in[21]; float* out; unsigned char* ws; int ph_lo, ph_hi; };

template <class RowMap>
__device__ __forceinline__ void transpose_item(const float* __restrict__ W, int K, int N, bf16* WT, const RowMap& rm, LAS float* scr, int item, int lane, int nblk_use = 0) {
    const int nblk = nblk_use ? nblk_use : (N + 31) / 32, kb = item / nblk, nb = item % nblk, k0 = 64 * kb, n0 = 32 * nb;
    const bool cok = (n0 + (lane & 31)) < N;
#pragma unroll 8
    for (int i = 0; i < 32; ++i) { const int kk = 2 * i + (lane >> 5); scr[kk * 33 + (lane & 31)] = cok ? W[(size_t)(k0 + kk) * N + n0 + (lane & 31)] : 0.f; }
    asm volatile("s_waitcnt lgkmcnt(0)" ::: "memory");
    const int c = lane & 7;
#pragma unroll
    for (int j = 0; j < 4; ++j) { const int n = (lane >> 3) + 8 * j; const LAS float* s = scr + (8 * c) * 33 + n;
        u32x4 o; o.x = pk2(s[0 * 33], s[1 * 33]); o.y = pk2(s[2 * 33], s[3 * 33]); o.z = pk2(s[4 * 33], s[5 * 33]); o.w = pk2(s[6 * 33], s[7 * 33]);
        const long dr = (n0 + n) < N ? rm(n0 + n) : -1;
        if (dr >= 0) *(u32x4*)(WT + (size_t)dr * K + k0 + 8 * c) = o; }
    asm volatile("s_waitcnt lgkmcnt(0)" ::: "memory");
}
__device__ __forceinline__ unsigned pk4_fp8(float a, float b, float c, float d) { int p = __builtin_amdgcn_cvt_pk_fp8_f32(a, b, 0, false); p = __builtin_amdgcn_cvt_pk_fp8_f32(c, d, p, true); return (unsigned)p; }
struct ConvItem { const float* src; unsigned char* dst; int N, n0, gu; long roff; };
__device__ __forceinline__ ConvItem conv_item(int it, const float* wgu, const float* wdn, unsigned char* wgu8, unsigned char* wdn8, int lane) {
    constexpr int I_GU = 16 * 128, I_DN = 16 * 64; ConvItem c; int e, r, nblk;
    if (it < NE * I_GU) { e = it / I_GU; r = it % I_GU; nblk = 128; c.N = 2 * FF; c.gu = 1; c.roff = (long)e * 4096; c.src = wgu + (size_t)e * D * 2 * FF; c.dst = wgu8; }
    else { it -= NE * I_GU; e = it / I_DN; r = it % I_DN; nblk = 64; c.N = D; c.gu = 0; c.roff = (long)e * 2048; c.src = wdn + (size_t)e * FF * D; c.dst = wdn8; }
    const int kb = r / nblk, nb = r % nblk; c.n0 = 32 * nb;
    c.src += (size_t)(128 * kb + (lane >> 3)) * c.N + c.n0 + 4 * (lane & 7); c.dst += 128 * kb + 16 * (lane & 7);
    return c;
}
#define CONV_LOAD(v, c) do { _Pragma("unroll") for (int _i = 0; _i < 16; ++_i) v[_i] = __builtin_nontemporal_load((const f32x4*)((c).src + (size_t)(8 * _i) * (c).N)); } while (0)
#define CONV_PROC(v, c) do { const int _lr = lane >> 3, _lg = lane & 7; \
    _Pragma("unroll") for (int _i = 0; _i < 16; ++_i) { const int _k = 8 * _i + _lr; *(LAS f32x4*)(scr + _k * 32 + 4 * (_lg ^ (((_k >> 4) ^ _k) & 7))) = v[_i] * W8_SCALE; } \
    asm volatile("s_waitcnt lgkmcnt(0)" ::: "memory"); \
    _Pragma("unroll") for (int _jj = 0; _jj < 4; ++_jj) { const int _n = _lr + 8 * _jj; float _f[16]; \
        _Pragma("unroll") for (int _j = 0; _j < 16; ++_j) { const int _k = 16 * _lg + _j; _f[_j] = scr[_k * 32 + 4 * ((_n >> 2) ^ (((_k >> 4) ^ _k) & 7)) + (_n & 3)]; } \
        u32x4 _o; _o.x = pk4_fp8(_f[0], _f[1], _f[2], _f[3]); _o.y = pk4_fp8(_f[4], _f[5], _f[6], _f[7]); _o.z = pk4_fp8(_f[8], _f[9], _f[10], _f[11]); _o.w = pk4_fp8(_f[12], _f[13], _f[14], _f[15]); \
        const int _nn = (c).n0 + _n; const long _dr = (c).gu ? ((c).roff + ((_nn >= FF ? _nn - FF : _nn) >> 7) * 256 + (_nn >= FF ? 128 : 0) + (_nn & 127)) : ((c).roff + _nn); \
        *(u32x4*)((c).dst + (size_t)_dr * 2048) = _o; } \
    asm volatile("s_waitcnt lgkmcnt(0)" ::: "memory"); } while (0)
__device__ __forceinline__ ConvItem conv_item_gm(int it, const float* win, unsigned char* wgm8, int lane) {
    ConvItem c; const int kb = it >> 7, nb = it & 127; c.N = INW; c.gu = 0; c.roff = 0; c.n0 = 32 * nb;
    c.src = win + 5656 + (size_t)(128 * kb + (lane >> 3)) * INW + c.n0 + 4 * (lane & 7); c.dst = wgm8 + 128 * kb + 16 * (lane & 7); return c;
}
template <bool PIPE>
__device__ __forceinline__ int moe_convert(const float* wgu, const float* wdn, unsigned char* wgu8, unsigned char* wdn8, LAS float* scr, int first, int stride, int lane, int maxn) {
    constexpr int NTOT = NE * (16 * 128 + 16 * 64);
    int it = first; if (it >= NTOT || maxn <= 0) return it;
    const long lim = (long)first + (long)maxn * stride; const int end = lim < NTOT ? (int)lim : NTOT;
    if constexpr (!PIPE) { f32x4 va[16];
        for (; it < end; it += stride) { asm volatile("" : "+v"(lane)); const ConvItem ca = conv_item(it, wgu, wdn, wgu8, wdn8, lane); CONV_LOAD(va, ca); CONV_PROC(va, ca); }
        return it; }
    f32x4 va[16], vb[16];
    ConvItem ca = conv_item(it, wgu, wdn, wgu8, wdn8, lane), cb = ca; CONV_LOAD(va, ca);
    for (;;) {
        const int itb = it + stride; if (itb < end) { cb = conv_item(itb, wgu, wdn, wgu8, wdn8, lane); CONV_LOAD(vb, cb); }
        CONV_PROC(va, ca);
        if (itb >= end) return itb;
        const int ita = itb + stride; if (ita < end) { ca = conv_item(ita, wgu, wdn, wgu8, wdn8, lane); CONV_LOAD(va, ca); }
        CONV_PROC(vb, cb);
        if (ita >= end) return ita;
        it = ita;
    }
}
struct RmIdent { long off; __device__ long operator()(int n) const { return off + n; } };
struct RmWin { __device__ long operator()(int n) const {
    if (n < 1024) return n;
    if (n < 2560) { const int c = n - 1024, which = c >> 8, r = c & 255;
        return which == 0 ? 1024 + r : which == 1 ? 1280 + r : which == 2 ? 1536 + r : which == 3 ? 8448 + r : which == 4 ? 1792 + r : 8448 + 256 + r; }
    if (n < 2584) return 8192 + (n - 2560);
    if (n < 5656) { const int c = n - 2584, which = c >> 10, r = c & 1023; return which == 0 ? 2048 + r : which == 1 ? 3072 + r : 8448 + 512 + r; }
    return 4096 + (n - 5656); } };
__device__ __forceinline__ void conv_win_item(int it, const float* win, unsigned char* w8, LAS float* scr, int lane) {
    const int kb = it / 305, nb = it % 305, k0 = 128 * kb, n0 = 32 * nb, lr = lane >> 3, lg = lane & 7;
    const bool cok = n0 + 4 * lg < INW;
    f32x4 v[16];
#pragma unroll
    for (int i = 0; i < 16; ++i) v[i] = cok ? __builtin_nontemporal_load((const f32x4*)(win + (size_t)(k0 + lr + 8 * i) * INW + n0 + 4 * lg)) : (f32x4){0.f, 0.f, 0.f, 0.f};
#pragma unroll
    for (int i = 0; i < 16; ++i) { const int k = 8 * i + lr; *(LAS f32x4*)(scr + k * 32 + 4 * (lg ^ (((k >> 4) ^ k) & 7))) = v[i] * W8_SCALE; }
    asm volatile("s_waitcnt lgkmcnt(0)" ::: "memory");
#pragma unroll
    for (int jj = 0; jj < 4; ++jj) { const int n = lr + 8 * jj; float f[16];
#pragma unroll
        for (int j = 0; j < 16; ++j) { const int k = 16 * lg + j; f[j] = scr[k * 32 + 4 * ((n >> 2) ^ (((k >> 4) ^ k) & 7)) + (n & 3)]; }
        u32x4 o; o.x = pk4_fp8(f[0], f[1], f[2], f[3]); o.y = pk4_fp8(f[4], f[5], f[6], f[7]); o.z = pk4_fp8(f[8], f[9], f[10], f[11]); o.w = pk4_fp8(f[12], f[13], f[14], f[15]);
        if (n0 + n < INW) *(u32x4*)(w8 + (size_t)RmWin{}(n0 + n) * 2048 + k0 + 16 * lg) = o; }
    asm volatile("s_waitcnt lgkmcnt(0)" ::: "memory");
}
__device__ __forceinline__ void conv_plain_item(int it, const float* W, int K, int N, unsigned char* w8, LAS float* scr, int lane) {
    const int nblk = N / 32, kb = it / nblk, nb = it % nblk, k0 = 128 * kb, n0 = 32 * nb, lr = lane >> 3, lg = lane & 7;
    f32x4 v[16];
#pragma unroll
    for (int i = 0; i < 16; ++i) v[i] = __builtin_nontemporal_load((const f32x4*)(W + (size_t)(k0 + lr + 8 * i) * N + n0 + 4 * lg));
#pragma unroll
    for (int i = 0; i < 16; ++i) { const int k = 8 * i + lr; *(LAS f32x4*)(scr + k * 32 + 4 * (lg ^ (((k >> 4) ^ k) & 7))) = v[i] * W8_SCALE; }
    asm volatile("s_waitcnt lgkmcnt(0)" ::: "memory");
#pragma unroll
    for (int jj = 0; jj < 4; ++jj) { const int n = lr + 8 * jj; float f[16];
#pragma unroll
        for (int j = 0; j < 16; ++j) { const int k = 16 * lg + j; f[j] = scr[k * 32 + 4 * ((n >> 2) ^ (((k >> 4) ^ k) & 7)) + (n & 3)]; }
        u32x4 o; o.x = pk4_fp8(f[0], f[1], f[2], f[3]); o.y = pk4_fp8(f[4], f[5], f[6], f[7]); o.z = pk4_fp8(f[8], f[9], f[10], f[11]); o.w = pk4_fp8(f[12], f[13], f[14], f[15]);
        *(u32x4*)(w8 + (size_t)(n0 + n) * K + k0 + 16 * lg) = o; }
    asm volatile("s_waitcnt lgkmcnt(0)" ::: "memory");
}
struct RmGu { long off; __device__ long operator()(int n) const { const int lin = n >= FF, j = lin ? n - FF : n; return off + (j >> 7) * 256 + lin * 128 + (j & 127); } };

struct EpiIn {
    static constexpr bool PERM = true;
    unsigned char* ws; const float* cs;
    __device__ __forceinline__ void operator()(const f32x4 (&acc)[2][2][4][2], const Unit& u, int wr, int wc, int fr, int fq) const {
        const int lane = threadIdx.x & 63;
        if (u.kind != 1) {
            const int pn = u.pn, tok0 = u.pm * 256; constexpr float usc = 1.0f / W8_SCALE;
            const bool is_rope = (pn < 4) || pn == 6 || pn == 7 || (pn >= 8 && pn < 16);
#pragma unroll
            for (int ai = 0; ai < 2; ++ai)
#pragma unroll
              for (int mh = 0; mh < 2; ++mh) { f32x4 csv[2][4];
                if (is_rope && wc == 0) {
#pragma unroll
                    for (int mm = 0; mm < 2; ++mm) { const float* cst = cs + (size_t)(tok0 + ai * 128 + wr * 64 + (2 * mh + mm) * 16 + fr) * 32 + 8 * (fq & 1);
                        csv[mm][0] = *(const f32x4*)cst; csv[mm][1] = *(const f32x4*)(cst + 4); csv[mm][2] = *(const f32x4*)(cst + 16); csv[mm][3] = *(const f32x4*)(cst + 20); } }
#pragma unroll
                for (int m = 2 * mh; m < 2 * mh + 2; ++m) {
                    const int t = tok0 + ai * 128 + wr * 64 + m * 16 + fr, b = t >> 12, s = t & (S - 1);
#pragma unroll
                    for (int bj = 0; bj < 2; ++bj) {
                        f32x4 v0 = acc[ai][bj][m][0] * usc, v1 = acc[ai][bj][m][1] * usc;
                        if (pn < 16) {
                            if (is_rope && wc == 0) {
                                f32x4 p0, p1;
#pragma unroll
                                for (int i = 0; i < 4; ++i) { p0[i] = __shfl_xor(v0[i], 32); p1[i] = __shfl_xor(v1[i], 32); }
                                const f32x4 c0 = csv[m & 1][0], c1 = csv[m & 1][1], s0 = csv[m & 1][2], s1 = csv[m & 1][3];
                                if (fq < 2) { v0 = v0 * c0 - p0 * s0; v1 = v1 * c1 - p1 * s1; }
                                else        { v0 = v0 * c0 + p0 * s0; v1 = v1 * c1 + p1 * s1; }
                            }
                            u32x4 w; w.x = pk2(v0[0], v0[1]); w.y = pk2(v0[2], v0[3]); w.z = pk2(v1[0], v1[1]); w.w = pk2(v1[2], v1[3]);
                            const int piece = 4 * wc + fq;
                            size_t off;
                            bf16* dst;
                            if (pn < 4) { dst = (bf16*)(ws + WS_QN); off = (((size_t)b * 8 + 2 * pn + bj) * S + s) * HD + piece * 8; }
                            else if (pn == 4) { dst = (bf16*)(ws + WS_KCMP); off = (((size_t)b * 2 + bj) * S + s) * HD + piece * 8; }
                            else if (pn == 5) { dst = (bf16*)(ws + WS_VCMP); off = (((size_t)b * 2 + bj) * S + s) * HD + piece * 8; }
                            else if (pn < 8) { dst = (bf16*)(ws + (pn == 6 ? WS_KSLC : WS_KWIN)); off = (((size_t)b * 2 + bj) * S + s) * HD + ((piece ^ (s & 15)) * 8); }
                            else if (pn < 12) { dst = (bf16*)(ws + WS_MQ); off = (((size_t)b * 8 + 2 * (pn - 8) + bj) * S + s) * HD + piece * 8; }
                            else { dst = (bf16*)(ws + WS_MK); off = (((size_t)b * 8 + 2 * (pn - 12) + bj) * S + s) * HD + ((piece ^ (s & 15)) * 8); }
                            *(u32x4*)(dst + off) = w;
                        } else if (pn < 32) {
                            unsigned q0[4], q1[4];
#pragma unroll
                            for (int i = 0; i < 4; ++i) { q0[i] = (unsigned)(255.0f * sigmoid_f(v0[i]) + 0.5f); q1[i] = (unsigned)(255.0f * sigmoid_f(v1[i]) + 0.5f); }
                            u32x2 w; w.x = q0[0] | (q0[1] << 8) | (q0[2] << 16) | (q0[3] << 24); w.y = q1[0] | (q1[1] << 8) | (q1[2] << 16) | (q1[3] << 24);
                            *(u32x2*)(ws + WS_GM + (size_t)t * 4096 + (pn - 16) * 256 + bj * 128 + wc * 32 + fq * 8) = w;
                        } else {
                            if (bj == 0 && wc == 0 && fq < 3) {
#pragma unroll
                                for (int i = 0; i < 4; ++i) { v0[i] = sigmoid_f(v0[i]); v1[i] = sigmoid_f(v1[i]); }
                                float* gp = (float*)(ws + WS_GN) + (size_t)t * 24 + fq * 8;
                                *(f32x4*)gp = v0; *(f32x4*)(gp + 4) = v1;
                            }
                        }
                    }
                } }
        } else {
            const int j = u.pm, tok0 = u.pn * 256;
#pragma unroll
            for (int ai = 0; ai < 2; ++ai) {
                bf16* dst; int nh, head;
                if (j == 0) { dst = (bf16*)(ws + WS_VSLC); nh = 2; head = ai; } else if (j == 1) { dst = (bf16*)(ws + WS_VWIN); nh = 2; head = ai; } else { dst = (bf16*)(ws + WS_MV); nh = 8; head = 2 * (j - 2) + ai; }
#pragma unroll
                for (int m = 0; m < 4; ++m) {
                    const int d = wr * 64 + m * 16 + fr;
#pragma unroll
                    for (int bj = 0; bj < 2; ++bj) {
                        const int t = tok0 + bj * 128 + wc * 32 + fq * 8, b = t >> 12, s = t & (S - 1);
                        const f32x4 v0 = acc[ai][bj][m][0] * (1.0f / W8_SCALE), v1 = acc[ai][bj][m][1] * (1.0f / W8_SCALE);
                        bf16* tp = dst + ((size_t)b * nh + head) * S * HD + (size_t)(s >> 6) * 8192 + (((s & 63) >> 2) * 128 + d) * 4;
                        u32x2 q0, q1; q0.x = pk2(v0[0], v0[1]); q0.y = pk2(v0[2], v0[3]); q1.x = pk2(v1[0], v1[1]); q1.y = pk2(v1[2], v1[3]);
                        *(u32x2*)tp = q0; *(u32x2*)(tp + 512) = q1;
                    }
                }
            }
        }
    }
};
struct SchedGm {
    int G, c; const char* Hp; const char* Wp;
    __device__ __forceinline__ bool next(int i, Unit& u) const { const int L = i * G + c; if (L >= 64 * 16) return false; int pj; tile_map(L, 64, 16, u.pm, pj); constexpr size_t ts = (size_t)256 * 2048;
        u.pn = 16 + pj; u.kind = 2; u.a = Hp + u.pm * ts; u.b = Wp + pj * ts; return true; }
};
struct SchedIn {
    int G, c; const char* Hp; const char* Wp; int lo, hi;
    __device__ __forceinline__ bool next(int i, Unit& u) const {
        if (lo + i >= hi) return false;
        int L = (lo + i) * G + c; constexpr size_t ts = (size_t)256 * 2048;
        if (L < 64 * 33) { tile_map(L, 64, 33, u.pm, u.pn); u.a = Hp + u.pm * ts; u.b = Wp + u.pn * ts; u.kind = 0; return true; }
        L -= 64 * 33;
        if (L < 6 * 64) { tile_map(L, 6, 64, u.pm, u.pn); u.a = Wp + (33 + u.pm) * ts; u.b = Hp + u.pn * ts; u.kind = 1; return true; }
        return false;
    }
};

#define ATT_C 0.12751743074602194f
#define ATT_MFMA(a, b, c) __builtin_amdgcn_mfma_f32_32x32x16_bf16((a), (b), (c), 0, 0, 0)
#define ATT_DMA(j, buf) do { const char* _kp = (const char*)kt + (size_t)(j) * 16384 + so; const char* _vp = (const char*)vt + (size_t)(j) * 16384 + so; \
    __builtin_amdgcn_global_load_lds((const unsigned*)_kp, (LAS unsigned*)(lds + (buf) * 16384 + wbase), 16, 0, 0); \
    __builtin_amdgcn_global_load_lds((const unsigned*)(_kp + 8192), (LAS unsigned*)(lds + (buf) * 16384 + 8192 + wbase), 16, 0, 0); \
    __builtin_amdgcn_global_load_lds((const unsigned*)_vp, (LAS unsigned*)(lds + 32768 + (buf) * 16384 + wbase), 16, 0, 0); \
    __builtin_amdgcn_global_load_lds((const unsigned*)(_vp + 8192), (LAS unsigned*)(lds + 32768 + (buf) * 16384 + 8192 + wbase), 16, 0, 0); } while (0)
#define ATT_SYNC() do { asm volatile("s_waitcnt vmcnt(0)" ::: "memory"); __syncthreads(); } while (0)
#define ATT_QK(buf) do { _Pragma("unroll") for (int _kh = 0; _kh < 2; ++_kh) { _Pragma("unroll") for (int _r = 0; _r < 16; ++_r) sacc[_kh][_r] = 0.f; \
    _Pragma("unroll") for (int _s = 0; _s < 8; ++_s) { const bf16x8 _a = *(const LAS bf16x8*)(lds + (buf) * 16384 + _kh * 8192 + kbase_l + (((2 * _s) ^ kx) << 4)); \
        sacc[_kh] = ATT_MFMA(_a, qf[_s], sacc[_kh]); } } } while (0)
#define ATT_MASK(lo_rel, hi_rel, bit) do { const bool _none = !(bit) || (hi_rel) < 0 || (lo_rel) > 63; const bool _full = (bit) && (lo_rel) <= 0 && (hi_rel) >= 63; \
    if (__all(_none || _full)) { const float _bias = _none ? -INFINITY : 0.f; \
        _Pragma("unroll") for (int _kh = 0; _kh < 2; ++_kh) _Pragma("unroll") for (int _r = 0; _r < 16; ++_r) sacc[_kh][_r] = __builtin_fmaf(sacc[_kh][_r], ATT_C, _bias); } \
    else { _Pragma("unroll") for (int _kh = 0; _kh < 2; ++_kh) _Pragma("unroll") for (int _r = 0; _r < 16; ++_r) { const int _k = 32 * _kh + (_r & 3) + 8 * (_r >> 2) + 4 * h; \
        const bool _ok = (bit) && _k >= (lo_rel) && _k <= (hi_rel); sacc[_kh][_r] = _ok ? sacc[_kh][_r] * ATT_C : -INFINITY; } } } while (0)
#define ATT_TILEMAX(mt) do { float _m = sacc[0][0]; _Pragma("unroll") for (int _r = 1; _r < 16; ++_r) _m = fmaxf(_m, sacc[0][_r]); \
    _Pragma("unroll") for (int _r = 0; _r < 16; ++_r) _m = fmaxf(_m, sacc[1][_r]); mt = fmaxf(_m, __shfl_xor(_m, 32)); } while (0)
#define ATT_PV(buf) do { _Pragma("unroll") for (int _kh = 0; _kh < 2; ++_kh) _Pragma("unroll") for (int _s = 0; _s < 2; ++_s) { \
    u32x4 _p; _p.x = pk2(sacc[_kh][8 * _s + 0], sacc[_kh][8 * _s + 1]); _p.y = pk2(sacc[_kh][8 * _s + 2], sacc[_kh][8 * _s + 3]); \
    _p.z = pk2(sacc[_kh][8 * _s + 4], sacc[_kh][8 * _s + 5]); _p.w = pk2(sacc[_kh][8 * _s + 6], sacc[_kh][8 * _s + 7]); const bf16x8 _pf = __builtin_bit_cast(bf16x8, _p); \
    _Pragma("unroll") for (int _db = 0; _db < 4; ++_db) { const LAS unsigned char* _vp = lds + 32768 + (buf) * 16384 + vbase_l + (8 * _kh + 4 * _s) * 1024 + _db * 256; \
        const u32x2 _v0 = *(const LAS u32x2*)_vp, _v1 = *(const LAS u32x2*)(_vp + 2048); u32x4 _v; _v.x = _v0.x; _v.y = _v0.y; _v.z = _v1.x; _v.w = _v1.y; \
        oacc[_db] = ATT_MFMA(__builtin_bit_cast(bf16x8, _v), _pf, oacc[_db]); } } } while (0)

#define ATT_DMA_KV(j, kb, vb) do { const char* _kp = (const char*)kt + (size_t)(j) * 16384 + so; const char* _vp = (const char*)vt + (size_t)(j) * 16384 + so; \
    __builtin_amdgcn_global_load_lds((const unsigned*)_kp, (LAS unsigned*)(lds + (kb) * 16384 + wbase), 16, 0, 0); \
    __builtin_amdgcn_global_load_lds((const unsigned*)(_kp + 8192), (LAS unsigned*)(lds + (kb) * 16384 + 8192 + wbase), 16, 0, 0); \
    __builtin_amdgcn_global_load_lds((const unsigned*)_vp, (LAS unsigned*)(lds + 32768 + (vb) * 16384 + wbase), 16, 0, 0); \
    __builtin_amdgcn_global_load_lds((const unsigned*)(_vp + 8192), (LAS unsigned*)(lds + 32768 + (vb) * 16384 + 8192 + wbase), 16, 0, 0); } while (0)
#define ATT_DMA_KV3(j, st) do { const char* _kp = (const char*)kt + (size_t)(j) * 16384 + so; const char* _vp = (const char*)vt + (size_t)(j) * 16384 + so; \
    __builtin_amdgcn_global_load_lds((const unsigned*)_kp, (LAS unsigned*)(lds + (st) * 16384 + wbase), 16, 0, 0); \
    __builtin_amdgcn_global_load_lds((const unsigned*)(_kp + 8192), (LAS unsigned*)(lds + (st) * 16384 + 8192 + wbase), 16, 0, 0); \
    __builtin_amdgcn_global_load_lds((const unsigned*)_vp, (LAS unsigned*)(lds + 49152 + (st) * 16384 + wbase), 16, 0, 0); \
    __builtin_amdgcn_global_load_lds((const unsigned*)(_vp + 8192), (LAS unsigned*)(lds + 49152 + (st) * 16384 + 8192 + wbase), 16, 0, 0); } while (0)
#define ATT_QK3(buf) ATT_QK(buf)
#define ATT_PVP3(vb) do { _Pragma("unroll") for (int _ks = 0; _ks < 4; ++_ks) _Pragma("unroll") for (int _db = 0; _db < 4; ++_db) { const LAS unsigned char* _vp = lds + 49152 + (vb) * 16384 + vbase_l + (4 * _ks) * 1024 + _db * 256; \
        const u32x2 _v0 = *(const LAS u32x2*)_vp, _v1 = *(const LAS u32x2*)(_vp + 2048); u32x4 _v; _v.x = _v0.x; _v.y = _v0.y; _v.z = _v1.x; _v.w = _v1.y; \
        oacc[_db] = ATT_MFMA(__builtin_bit_cast(bf16x8, _v), pf[_ks], oacc[_db]); } } while (0)
#define ATT_PACKP() do { _Pragma("unroll") for (int _kh = 0; _kh < 2; ++_kh) _Pragma("unroll") for (int _s = 0; _s < 2; ++_s) { u32x4 _p; _p.x = pk2(sacc[_kh][8 * _s + 0], sacc[_kh][8 * _s + 1]); _p.y = pk2(sacc[_kh][8 * _s + 2], sacc[_kh][8 * _s + 3]); \
    _p.z = pk2(sacc[_kh][8 * _s + 4], sacc[_kh][8 * _s + 5]); _p.w = pk2(sacc[_kh][8 * _s + 6], sacc[_kh][8 * _s + 7]); pf[2 * _kh + _s] = __builtin_bit_cast(bf16x8, _p); } } while (0)
#define ATT_PVP(vb) do { _Pragma("unroll") for (int _ks = 0; _ks < 4; ++_ks) _Pragma("unroll") for (int _db = 0; _db < 4; ++_db) { const LAS unsigned char* _vp = lds + 32768 + (vb) * 16384 + vbase_l + (4 * _ks) * 1024 + _db * 256; \
        const u32x2 _v0 = *(const LAS u32x2*)_vp, _v1 = *(const LAS u32x2*)(_vp + 2048); u32x4 _v; _v.x = _v0.x; _v.y = _v0.y; _v.z = _v1.x; _v.w = _v1.y; \
        oacc[_db] = ATT_MFMA(__builtin_bit_cast(bf16x8, _v), pf[_ks], oacc[_db]); } } while (0)
template <int MODE, bool SKEW>
__device__ __forceinline__ void attn_item(LAS unsigned char* lds, const bf16* qrow, const bf16* kt, const bf16* vt, u64 mask, int tq, int W, int tile_lo, int tile_hi,
                                          void* o0, const bf16* o1, const bf16* o2, float g0, float g1, float g2) {
    int tid = threadIdx.x; asm volatile("" : "+v"(tid));
    const int lane = tid & 63, r32 = lane & 31, h = lane >> 5;
    const unsigned so = (unsigned)tid * 16u;
    const unsigned kbase_l = (unsigned)r32 * 256u, kx = (unsigned)(h ^ (lane & 15)), vbase_l = (unsigned)(h * 1024 + r32 * 8);
    bf16x8 qf[8];
#pragma unroll
    for (int s = 0; s < 8; ++s) qf[s] = *(const bf16x8*)(qrow + 16 * s + 8 * h);
    f32x16 oacc[4], sacc[2]; bf16x8 pf[4];
#pragma unroll
    for (int d = 0; d < 4; ++d)
#pragma unroll
        for (int r = 0; r < 16; ++r) oacc[d][r] = 0.f;
    float m_run = 0.f, l_run = 0.f;
    const int khi = tq, klo = (tq - W + 1) > 0 ? (tq - W + 1) : 0;
    const int wv_ = __builtin_amdgcn_readfirstlane(tid >> 6);
    const unsigned wbase = (unsigned)wv_ * 1024u;
    if (SKEW) { ATT_DMA_KV3(tile_lo, 0); if (tile_lo + 1 < tile_hi) { ATT_DMA_KV3(tile_lo + 1, 1); asm volatile("s_waitcnt vmcnt(4)" ::: "memory"); } else asm volatile("s_waitcnt vmcnt(0)" ::: "memory"); __builtin_amdgcn_s_barrier(); asm volatile("" ::: "memory"); }
    else { ATT_DMA_KV(tile_lo, 0, 0); ATT_SYNC(); }
    int kb = 0, vb = 0;
    for (int j = tile_lo; j < tile_hi; ++j) {
        const int kbn = SKEW ? (kb == 2 ? 0 : kb + 1) : (kb ^ 1), vbn = kbn;
        if (SKEW) { if (j + 2 < tile_hi) ATT_DMA_KV3(j + 2, (kbn == 2 ? 0 : kbn + 1)); }
        else { if (j + 1 < tile_hi) ATT_DMA_KV(j + 1, kbn, vbn); }
        const bool bit = (mask >> j) & 1ull;
        const int lo_rel = klo - 64 * j, hi_rel = khi - 64 * j;
        const bool none = !bit || hi_rel < 0 || lo_rel > 63;
        if (!__all(none)) {
            if (SKEW) { ATT_QK3(kb); } else { ATT_QK(kb); }
            float ls = 0.f;
            if (((j - tile_lo) & 3) == 0) {
                ATT_MASK(lo_rel, hi_rel, bit);
                float mt; ATT_TILEMAX(mt); const bool upd = mt > m_run + 8.0f;
                if (__any(upd)) {
                    const float m_new = upd ? mt : m_run, alpha = __builtin_amdgcn_exp2f(m_run - m_new);
                    l_run *= alpha; m_run = m_new;
#pragma unroll
                    for (int d = 0; d < 4; ++d)
#pragma unroll
                        for (int r = 0; r < 16; ++r) oacc[d][r] *= alpha;
                }
#pragma unroll
                for (int kh = 0; kh < 2; ++kh)
#pragma unroll
                    for (int r = 0; r < 16; ++r) { const float p = __builtin_amdgcn_exp2f(sacc[kh][r] - m_run); sacc[kh][r] = p; ls += p; }
            } else {
                const bool full_ = bit && lo_rel <= 0 && hi_rel >= 63;
                if (__all(none || full_)) { const float bm = none ? -INFINITY : -m_run;
#pragma unroll
                    for (int kh = 0; kh < 2; ++kh)
#pragma unroll
                        for (int r = 0; r < 16; ++r) { const float p = __builtin_amdgcn_exp2f(__builtin_fmaf(sacc[kh][r], ATT_C, bm)); sacc[kh][r] = p; ls += p; } }
                else {
#pragma unroll
                    for (int kh = 0; kh < 2; ++kh)
#pragma unroll
                        for (int r = 0; r < 16; ++r) { const int k_ = 32 * kh + (r & 3) + 8 * (r >> 2) + 4 * h; const bool ok_ = bit && k_ >= lo_rel && k_ <= hi_rel;
                            const float p = ok_ ? __builtin_amdgcn_exp2f(__builtin_fmaf(sacc[kh][r], ATT_C, -m_run)) : 0.f; sacc[kh][r] = p; ls += p; } }
            }
            l_run += ls;
            ATT_PACKP();
            if (SKEW) { ATT_PVP3(vb); } else { ATT_PVP(vb); }
        }
        if (SKEW) { if (j + 2 < tile_hi) asm volatile("s_waitcnt vmcnt(4) lgkmcnt(0)" ::: "memory"); else asm volatile("s_waitcnt vmcnt(0) lgkmcnt(0)" ::: "memory"); __builtin_amdgcn_s_barrier(); asm volatile("" ::: "memory"); }
        else ATT_SYNC();
        kb = kbn; vb = vbn;
    }
    const float l_tot = l_run + __shfl_xor(l_run, 32);
    const float inv = l_tot > 0.f ? 1.0f / l_tot : 0.f;
#pragma unroll
    for (int db = 0; db < 4; ++db)
#pragma unroll
        for (int i4 = 0; i4 < 4; ++i4) {
            const int d = 32 * db + 8 * i4 + 4 * h;
            f32x4 v = {oacc[db][4 * i4] * inv, oacc[db][4 * i4 + 1] * inv, oacc[db][4 * i4 + 2] * inv, oacc[db][4 * i4 + 3] * inv};
            if (MODE == 0) { u32x2 w; w.x = pk2(v[0], v[1]); w.y = pk2(v[2], v[3]); *(u32x2*)((bf16*)o0 + d) = w; }
            else {
                if (MODE == 2) { const u32x2 aw = *(const u32x2*)((const bf16*)o1 + d), cw = *(const u32x2*)((const bf16*)o2 + d);
                    const f32x4 a = {bf2f(aw.x & 0xffff), bf2f(aw.x >> 16), bf2f(aw.y & 0xffff), bf2f(aw.y >> 16)}, c = {bf2f(cw.x & 0xffff), bf2f(cw.x >> 16), bf2f(cw.y & 0xffff), bf2f(cw.y >> 16)}; v = a * g0 + v * g1 + c * g2; }
                v = v * A8_SCALE; *(unsigned*)((unsigned char*)o0 + d) = pk4_fp8(v[0], v[1], v[2], v[3]);
            }
        }
}

__device__ __forceinline__ void cmp_item(LAS unsigned char* lds, unsigned char* ws, int bg, int qc) {
    int tid = threadIdx.x; asm volatile("" : "+v"(tid));
    const int lane = tid & 63, wv = tid >> 6, r32 = lane & 31, h = lane >> 5;
    const int b = bg >> 1, g = bg & 1, head = r32 >> 3, qi = 8 * wv + (r32 & 7), tq = qc * 64 + qi;
    const unsigned so = (unsigned)tid * 16u;
    const unsigned kbase_l = (unsigned)r32 * 256u, kx = (unsigned)(h ^ (lane & 15)), vbase_l = (unsigned)(h * 1024 + r32 * 8);
    const bf16* qrow = (const bf16*)(ws + WS_QN) + (((size_t)b * 8 + g * 4 + head) * S + tq) * HD;
    const bf16* kt = (const bf16*)(ws + WS_KC) + (size_t)bg * 4 * 8192;
    const bf16* vt = (const bf16*)(ws + WS_VC) + (size_t)bg * 4 * 8192;
    LAS float* impA = (LAS float*)(lds + 65536);
    LAS float* impB = (LAS float*)(lds + 65536 + 16384);
    f32x16 oacc[4], sacc[2];
#define CMP_LOADQ() bf16x8 qf[8]; { const bf16* _qp = qrow; asm volatile("" : "+v"(_qp)); _Pragma("unroll") for (int _s = 0; _s < 8; ++_s) qf[_s] = *(const bf16x8*)(_qp + 16 * _s + 8 * h); }
#pragma unroll
    for (int d = 0; d < 4; ++d)
#pragma unroll
        for (int r = 0; r < 16; ++r) oacc[d][r] = 0.f;
    const int khi = (tq - 31) >> 4;
    const int nmax = (qc * 64 + 63 - 31) >> 4;
    const int ntile = nmax < 0 ? 0 : (nmax >> 6) + 1;
    for (int i = tid; i < 8192; i += NTHREADS) impA[i] = 0.f;
    float m_run = -1e30f, l_run = 0.f;
    const unsigned wbase = (unsigned)__builtin_amdgcn_readfirstlane(tid >> 6) * 1024u;
    if (ntile > 0) {
        ATT_DMA(0, 0);
        { CMP_LOADQ();
        ATT_SYNC();
        for (int j = 0; j < ntile; ++j) {
            const int cur = j & 1;
            if (j + 1 < ntile) ATT_DMA(j + 1, cur ^ 1);
            const int hi_rel = khi - 64 * j;
            ATT_QK(cur);
            ATT_MASK(0, hi_rel, true);
            float mt; ATT_TILEMAX(mt);
            const float m_new = fmaxf(m_run, mt);
            float ls = 0.f;
#pragma unroll
            for (int kh = 0; kh < 2; ++kh)
#pragma unroll
                for (int r = 0; r < 16; ++r) ls += __builtin_amdgcn_exp2f(sacc[kh][r] - m_new);
            l_run = l_run * __builtin_amdgcn_exp2f(m_run - m_new) + ls; m_run = m_new;
            ATT_SYNC();
        } }
        const float l_tot = l_run + __shfl_xor(l_run, 32);
        const float inv = l_tot > 0.f ? 1.0f / l_tot : 0.f;
        ATT_DMA(0, 0);
        { CMP_LOADQ();
        ATT_SYNC();
        for (int j = 0; j < ntile; ++j) {
            const int cur = j & 1;
            if (j + 1 < ntile) ATT_DMA(j + 1, cur ^ 1);
            const int hi_rel = khi - 64 * j;
            ATT_QK(cur);
            ATT_MASK(0, hi_rel, true);
#pragma unroll
            for (int kh = 0; kh < 2; ++kh)
#pragma unroll
                for (int r = 0; r < 16; ++r) sacc[kh][r] = __builtin_amdgcn_exp2f(sacc[kh][r] - m_run) * inv;
#pragma unroll
            for (int kh = 0; kh < 2; ++kh)
#pragma unroll
                for (int i4 = 0; i4 < 4; ++i4) {
                    float a = sacc[kh][4 * i4] + sacc[kh][4 * i4 + 1] + sacc[kh][4 * i4 + 2] + 0.5f * sacc[kh][4 * i4 + 3], bb = 0.5f * sacc[kh][4 * i4 + 3];
                    a += __shfl_xor(a, 8); a += __shfl_xor(a, 16); bb += __shfl_xor(bb, 8); bb += __shfl_xor(bb, 16);
                    if (head == 0) { const int jj = 16 * j + 8 * kh + 2 * i4 + h; impA[qi * 64 + jj] = a; impB[qi * 64 + jj] = bb; }
                }
            ATT_SYNC();
        } }
#pragma unroll
        for (int d = 0; d < 4; ++d)
#pragma unroll
            for (int r = 0; r < 16; ++r) oacc[d][r] = 0.f;
        ATT_DMA(0, 0);
        ATT_SYNC();
        for (int j = 0; j < ntile; ++j) {
            const int cur = j & 1;
            if (j + 1 < ntile) ATT_DMA(j + 1, cur ^ 1);
            const int hi_rel = khi - 64 * j;
            { CMP_LOADQ(); ATT_QK(cur); }
            ATT_MASK(0, hi_rel, true);
#pragma unroll
            for (int kh = 0; kh < 2; ++kh)
#pragma unroll
                for (int r = 0; r < 16; ++r) sacc[kh][r] = __builtin_amdgcn_exp2f(sacc[kh][r] - m_run) * inv;
            ATT_PV(cur);
            ATT_SYNC();
        }
    }
    {
        bf16* orow = (bf16*)(ws + WS_OCMP) + ((size_t)b * S + tq) * 1024 + (g * 4 + head) * HD;
#pragma unroll
        for (int db = 0; db < 4; ++db)
#pragma unroll
            for (int i4 = 0; i4 < 4; ++i4) { const int d = 32 * db + 8 * i4 + 4 * h;
                f32x4 v = {oacc[db][4 * i4], oacc[db][4 * i4 + 1], oacc[db][4 * i4 + 2], oacc[db][4 * i4 + 3]}; u32x2 w; w.x = pk2(v[0], v[1]); w.y = pk2(v[2], v[3]); *(u32x2*)(orow + d) = w; }
    }
    __syncthreads();
    {
        const int q = tid >> 3, jg = tid & 7, cur = qc;
        float sc[8];
#pragma unroll
        for (int i = 0; i < 8; ++i) { const int jj = 8 * jg + i; const float v = impA[q * 64 + jj] + (jj > 0 ? impB[q * 64 + jj - 1] : 0.f);
            const bool valid = jj <= cur, forced = (jj == 0) || (jj == cur) || (jj == cur - 1); sc[i] = forced ? 1e9f : (valid ? v : -1e9f); }
        __syncthreads();
#pragma unroll
        for (int i = 0; i < 8; ++i) impA[q * 64 + 8 * jg + i] = sc[i];
        __syncthreads();
        int rank[8];
#pragma unroll
        for (int i = 0; i < 8; ++i) rank[i] = 0;
#pragma unroll 2
        for (int jp = 0; jp < 64; ++jp) { const float v = impA[q * 64 + jp];
#pragma unroll
            for (int i = 0; i < 8; ++i) rank[i] += (v > sc[i] || (v == sc[i] && jp < 8 * jg + i)) ? 1 : 0; }
        unsigned bits = 0;
#pragma unroll
        for (int i = 0; i < 8; ++i) bits |= (rank[i] < 16 && sc[i] > -0.5e9f) ? (1u << i) : 0u;
        unsigned lo = jg < 4 ? (bits << (8 * jg)) : 0u, hi2 = jg >= 4 ? (bits << (8 * (jg - 4))) : 0u;
        lo |= __shfl_xor(lo, 1); lo |= __shfl_xor(lo, 2); lo |= __shfl_xor(lo, 4); hi2 |= __shfl_xor(hi2, 1); hi2 |= __shfl_xor(hi2, 2); hi2 |= __shfl_xor(hi2, 4);
        if (jg == 0) ((u64*)(ws + WS_MSEL))[(size_t)bg * S + qc * 64 + q] = ((u64)hi2 << 32) | lo;
    }
    __syncthreads();
}

struct SchedOne { Unit u; bool has; __device__ __forceinline__ bool next(int i, Unit& o) const { if (i == 0 && has) { o = u; return true; } return false; } };
struct EpiHid {
    static constexpr bool PERM = false; float* dst;
    __device__ __forceinline__ void operator()(const f32x4 (&acc)[2][2][4][2], const Unit& u, int wr, int wc, int fr, int fq) const {
#pragma unroll
        for (int ai = 0; ai < 2; ++ai)
#pragma unroll
            for (int m = 0; m < 4; ++m) { float* rp = dst + (size_t)(ai * 128 + wr * 64 + m * 16 + fr) * 256 + wc * 32 + 4 * fq;
#pragma unroll
                for (int bj = 0; bj < 2; ++bj)
#pragma unroll
                    for (int n = 0; n < 2; ++n) *(f32x4*)(rp + bj * 128 + n * 16) = acc[ai][bj][m][n]; }
    }
};
struct EpiProj {
    static constexpr bool PERM = true; unsigned char* ws;
    __device__ __forceinline__ void operator()(const f32x4 (&acc)[2][2][4][2], const Unit& u, int wr, int wc, int fr, int fq) const {
#pragma unroll
        for (int ai = 0; ai < 2; ++ai) { u32x2 gw[4][2]; u32x4 pw[4][2];
#pragma unroll
            for (int m = 0; m < 4; ++m) { const int t = u.pm * 256 + ai * 128 + wr * 64 + m * 16 + fr;
#pragma unroll
                for (int bj = 0; bj < 2; ++bj) { const int c = u.pn * 256 + bj * 128 + wc * 32 + fq * 8;
                    gw[m][bj] = *(const u32x2*)(ws + WS_GM + (size_t)t * 4096 + u.kind * 2048 + c);
                    if (u.kind != 0) pw[m][bj] = *(const u32x4*)((const bf16*)(ws + WS_MIXP) + (size_t)t * D + c); } }
#pragma unroll
            for (int m = 0; m < 4; ++m) { const int t = u.pm * 256 + ai * 128 + wr * 64 + m * 16 + fr;
#pragma unroll
                for (int bj = 0; bj < 2; ++bj) { const int c = u.pn * 256 + bj * 128 + wc * 32 + fq * 8; const u32x2 g = gw[m][bj];
                    f32x4 g0 = {(float)(g.x & 0xff), (float)((g.x >> 8) & 0xff), (float)((g.x >> 16) & 0xff), (float)(g.x >> 24)}, g1 = {(float)(g.y & 0xff), (float)((g.y >> 8) & 0xff), (float)((g.y >> 16) & 0xff), (float)(g.y >> 24)};
                    constexpr float us = 1.0f / (W8_SCALE * A8_SCALE * 255.0f);
                    f32x4 v0 = acc[ai][bj][m][0] * us * g0, v1 = acc[ai][bj][m][1] * us * g1;
                    bf16* mp = (bf16*)(ws + WS_MIXP) + (size_t)t * D + c;
                    if (u.kind == 0) { u32x4 w; w.x = pk2(v0[0], v0[1]); w.y = pk2(v0[2], v0[3]); w.z = pk2(v1[0], v1[1]); w.w = pk2(v1[2], v1[3]); *(u32x4*)mp = w; }
                    else { const u32x4 q = pw[m][bj]; v0 += (f32x4){bf2f(q.x & 0xffff), bf2f(q.x >> 16), bf2f(q.y & 0xffff), bf2f(q.y >> 16)}; v1 += (f32x4){bf2f(q.z & 0xffff), bf2f(q.z >> 16), bf2f(q.w & 0xffff), bf2f(q.w >> 16)};
                        v0 = v0 * A8_SCALE; v1 = v1 * A8_SCALE; u32x2 w; w.x = pk4_fp8(v0[0], v0[1], v0[2], v0[3]); w.y = pk4_fp8(v1[0], v1[1], v1[2], v1[3]);
                        *(u32x2*)(ws + WS_MIX + (size_t)t * D + c) = w; } } } }
    }
};
struct SchedProj { int G, c; const char* oa; const char* ob; const char* wn; const char* wm;
    __device__ __forceinline__ bool next(int i, Unit& u) const { const int p = (i >> 1) * G + c; if (p >= 512) return false; tile_map(p, 64, 8, u.pm, u.pn); u.kind = i & 1;
        constexpr size_t ts = (size_t)256 * 1024; u.a = (u.kind ? ob : oa) + u.pm * ts; u.b = (u.kind ? wm : wn) + u.pn * ts; return true; } };
struct EpiOut {
    static constexpr bool PERM = true; const float* x; bf16* x1;
    __device__ __forceinline__ void operator()(const f32x4 (&acc)[2][2][4][2], const Unit& u, int wr, int wc, int fr, int fq) const {
#pragma unroll
        for (int ai = 0; ai < 2; ++ai) { f32x4 xv[4][2][2];
#pragma unroll
            for (int m = 0; m < 4; ++m) { const size_t ro = (size_t)(u.pm * 256 + ai * 128 + wr * 64 + m * 16 + fr) * D + u.pn * 256 + wc * 32 + 8 * fq;
#pragma unroll
                for (int bj = 0; bj < 2; ++bj) { xv[m][bj][0] = __builtin_nontemporal_load((const f32x4*)(x + ro + bj * 128)); xv[m][bj][1] = __builtin_nontemporal_load((const f32x4*)(x + ro + bj * 128 + 4)); } }
#pragma unroll
            for (int m = 0; m < 4; ++m) { const size_t ro = (size_t)(u.pm * 256 + ai * 128 + wr * 64 + m * 16 + fr) * D + u.pn * 256 + wc * 32 + 8 * fq;
#pragma unroll
                for (int bj = 0; bj < 2; ++bj) { constexpr float us = 1.0f / (W8_SCALE * A8_SCALE);
                    const f32x4 v0 = xv[m][bj][0] + acc[ai][bj][m][0] * us, v1 = xv[m][bj][1] + acc[ai][bj][m][1] * us;
                    u32x4 w; w.x = pk2(v0[0], v0[1]); w.y = pk2(v0[2], v0[3]); w.z = pk2(v1[0], v1[1]); w.w = pk2(v1[2], v1[3]);
                    *(u32x4*)(x1 + ro + bj * 128) = w; } } }
    }
};
struct SchedOut { int G, c; const char* a; const char* b;
    __device__ __forceinline__ bool next(int i, Unit& u) const { const int L = i * G + c; if (L >= 512) return false; tile_map(L, 64, 8, u.pm, u.pn); constexpr size_t ts = (size_t)256 * 2048;
        u.a = a + u.pm * ts; u.b = b + u.pn * ts; u.kind = 0; return true; } };
struct SchedMoe { int G, c, nN; const LAS int* offs; const char* A; const char* W; size_t wstride, ts;
    __device__ __forceinline__ bool next(int i, Unit& u) const { const int ntile = __builtin_amdgcn_readfirstlane(offs[NE]) >> 8, L = i * G + c; if (L >= ntile * nN) return false; tile_map(L, ntile, nN, u.pm, u.pn);
        int e = 0;
        for (int k = 1; k < NE; ++k) e = (__builtin_amdgcn_readfirstlane(offs[k]) <= u.pm * 256) ? k : e;
        u.kind = e; u.a = A + u.pm * ts; u.b = W + e * wstride + u.pn * ts; return true; } };
typedef _Float16 h2_t __attribute__((ext_vector_type(2)));
typedef short s2_t __attribute__((ext_vector_type(2)));
struct EpiAct {
    static constexpr bool PERM = true; const float* bgu; unsigned char* act;
    __device__ __forceinline__ void operator()(const f32x4 (&acc)[2][2][4][2], const Unit& u, int wr, int wc, int fr, int fq) const {
        const int c = u.pn * 128 + wc * 32 + fq * 8; const float* bp = bgu + (size_t)u.kind * 2 * FF + c;
        const f32x4 bg0 = *(const f32x4*)bp, bg1 = *(const f32x4*)(bp + 4), bl0 = *(const f32x4*)(bp + FF), bl1 = *(const f32x4*)(bp + FF + 4);
        h2_t bg[4], bl[4];
        bg[0] = (h2_t){(_Float16)bg0[0], (_Float16)bg0[1]}; bg[1] = (h2_t){(_Float16)bg0[2], (_Float16)bg0[3]}; bg[2] = (h2_t){(_Float16)bg1[0], (_Float16)bg1[1]}; bg[3] = (h2_t){(_Float16)bg1[2], (_Float16)bg1[3]};
        bl[0] = (h2_t){(_Float16)bl0[0], (_Float16)bl0[1]}; bl[1] = (h2_t){(_Float16)bl0[2], (_Float16)bl0[3]}; bl[2] = (h2_t){(_Float16)bl1[0], (_Float16)bl1[1]}; bl[3] = (h2_t){(_Float16)bl1[2], (_Float16)bl1[3]};
        const h2_t us = {(_Float16)(1.0f / W8_SCALE), (_Float16)(1.0f / W8_SCALE)}, seven = {(_Float16)7.0f, (_Float16)7.0f}, one = {(_Float16)1.0f, (_Float16)1.0f}, na = {(_Float16)(-1.702f * 1.4426950408889634f), (_Float16)(-1.702f * 1.4426950408889634f)};
#pragma unroll
        for (int ai = 0; ai < 2; ++ai)
#pragma unroll
            for (int m = 0; m < 4; ++m) { const size_t row = (size_t)u.pm * 256 + ai * 128 + wr * 64 + m * 16 + fr; h2_t a2[4];
#pragma unroll
                for (int p = 0; p < 4; ++p) { const f32x4 gv = acc[ai][0][m][p >> 1], lv = acc[ai][1][m][p >> 1];
                    h2_t g = __builtin_bit_cast(h2_t, __builtin_amdgcn_cvt_pkrtz(gv[2 * (p & 1)], gv[2 * (p & 1) + 1])), l = __builtin_bit_cast(h2_t, __builtin_amdgcn_cvt_pkrtz(lv[2 * (p & 1)], lv[2 * (p & 1) + 1]));
                    g = __builtin_elementwise_min(g * us + bg[p], seven); l = __builtin_elementwise_max(__builtin_elementwise_min(l * us + bl[p], seven), -seven);
                    const h2_t den = __builtin_elementwise_exp2(g * na) + one;
                    const h2_t sg = {(_Float16)__builtin_amdgcn_rcph(den[0]), (_Float16)__builtin_amdgcn_rcph(den[1])};
                    a2[p] = g * sg * (l + one); }
                s2_t w0 = {0, 0}, w1 = {0, 0};
                w0 = __builtin_amdgcn_cvt_scalef32_pk_fp8_f16(w0, a2[0], 1.0f, false); w0 = __builtin_amdgcn_cvt_scalef32_pk_fp8_f16(w0, a2[1], 1.0f, true);
                w1 = __builtin_amdgcn_cvt_scalef32_pk_fp8_f16(w1, a2[2], 1.0f, false); w1 = __builtin_amdgcn_cvt_scalef32_pk_fp8_f16(w1, a2[3], 1.0f, true);
                u32x2 w; w.x = __builtin_bit_cast(unsigned, w0); w.y = __builtin_bit_cast(unsigned, w1);
                *(u32x2*)(act + row * FF + c) = w; }
    }
};
struct EpiDown {
    static constexpr bool PERM = true; const float* bdn; const int* rowdst; const float* roww; unsigned char* ys; const LAS int* offs;
    __device__ __forceinline__ void operator()(const f32x4 (&acc)[2][2][4][2], const Unit& u, int wr, int wc, int fr, int fq) const {
        int dsts[2][4]; float ws_[2][4]; f32x4 bb[2][2];
#pragma unroll
        for (int ai = 0; ai < 2; ++ai)
#pragma unroll
            for (int m = 0; m < 4; ++m) { const int row = u.kind * T - offs[u.kind] + u.pm * 256 + ai * 128 + wr * 64 + m * 16 + fr; dsts[ai][m] = rowdst[row]; ws_[ai][m] = roww[row]; }
#pragma unroll
        for (int bj = 0; bj < 2; ++bj) { const float* bp = bdn + (size_t)u.kind * D + u.pn * 256 + bj * 128 + wc * 32 + fq * 8; bb[bj][0] = *(const f32x4*)bp; bb[bj][1] = *(const f32x4*)(bp + 4); }
#pragma unroll
        for (int ai = 0; ai < 2; ++ai)
#pragma unroll
            for (int m = 0; m < 4; ++m) { const int dst = dsts[ai][m]; const float w = ws_[ai][m] * YS_SCALE;
                if (dst >= 0) {
#pragma unroll
                    for (int bj = 0; bj < 2; ++bj) { const int c = u.pn * 256 + bj * 128 + wc * 32 + fq * 8;
                        constexpr float us = 1.0f / W8_SCALE;
                        const f32x4 v0 = (acc[ai][bj][m][0] * us + bb[bj][0]) * w, v1 = (acc[ai][bj][m][1] * us + bb[bj][1]) * w;
                        u32x2 o; o.x = pk4_fp8(v0[0], v0[1], v0[2], v0[3]); o.y = pk4_fp8(v1[0], v1[1], v1[2], v1[3]);
                        *(u32x2*)(ys + (size_t)dst * D + c) = o; } } }
    }
};
__device__ __forceinline__ float gelu_tanh_f(float x) { const float u = 0.7978845608028654f * (x + 0.044715f * x * x * x); const float e = __expf(2.0f * u); return 0.5f * x * (1.0f + (1.0f - 2.0f / (e + 1.0f))); }

__device__ __forceinline__ int queue_pop(volatile LAS unsigned* misc, unsigned* head) {
    __syncthreads();
    if (threadIdx.x == 0) misc[4] = __hip_atomic_fetch_add(head, 1u, __ATOMIC_RELAXED, __HIP_MEMORY_SCOPE_AGENT);
    __syncthreads();
    return (int)misc[4];
}
__device__ __forceinline__ void moe_offsets(volatile LAS unsigned* misc, const unsigned* counts) {
    __syncthreads();
    if (threadIdx.x < NE) misc[96 + threadIdx.x] = ((unsigned)__hip_atomic_load(counts + 64 * threadIdx.x, __ATOMIC_RELAXED, __HIP_MEMORY_SCOPE_AGENT) + 255u) / 256u * 256u;
    __syncthreads();
    if (threadIdx.x == 0) { unsigned o = 0; for (int e = 0; e < NE; ++e) { misc[16 + e] = o; o += misc[96 + e]; } misc[16 + NE] = o; }
    __syncthreads();
}

constexpr int NPHASE = 13;
__global__ void __launch_bounds__(NTHREADS, 2) fwd(Args args) {
    extern __shared__ __attribute__((aligned(16))) unsigned char lds_raw[];
    LAS unsigned char* lds = (LAS unsigned char*)lds_raw;
    volatile LAS unsigned* misc = (volatile LAS unsigned*)(lds + MISC_OFF);
    const int tid = threadIdx.x, lane = tid & 63, wave = __builtin_amdgcn_readfirstlane(tid >> 6);
    const int G = gridDim.x, blk = blockIdx.x, gw = blk * NWAVES + wave, NGW = G * NWAVES;
    unsigned char* ws = args.ws;
    unsigned* ctl = (unsigned*)(ws + WS_CTL);
    const float* x = args.in[0]; const int* positions = (const int*)args.in[1];
    for (int u = tid; u < 64; u += NTHREADS) misc[u] = 0u;
    __syncthreads();
    const int lo = args.ph_lo, hi = args.ph_hi;
    int cv_it = gw; constexpr int CV_P1 = 1 << 20;
    XcdBarrier bar; bar.bar = ctl + CW_BAR; bar.x = 0; bar.st = nullptr;
    if (hi - lo > 1) bar = xcd_barrier_post(ctl + CW_BAR, misc);
#ifndef FK_PHASE_MASK
#define FK_PHASE_MASK 0xFFFF
#endif
#define IN(k) (((FK_PHASE_MASK >> (k)) & 1) && lo <= (k) && (k) < hi)
#ifdef FK_TS
#define STAMP(k) do { if (blk == 0 && tid == 0) { const unsigned long long _t = __builtin_amdgcn_s_memrealtime(); misc[64 + 2 * (k)] = (unsigned)_t; misc[65 + 2 * (k)] = (unsigned)(_t >> 32); } } while (0)
#else
#define STAMP(k) do { } while (0)
#endif
#define SEAM(k) do { if (IN(k) && IN((k) + 1)) xcd_barrier(bar); STAMP((k) + 1); } while (0)

#ifdef FK_TS
    unsigned long long fk_pa = 0, fk_pb = 0;
#endif
    STAMP(0);
    if (IN(0)) {
        if (blk >= G - 16) { const int pb = blk - (G - 16);
            const int kv = pb >> 3, c = (pb & 7) * 32 + (tid & 31), ks = tid >> 5; const float* pe = args.in[kv ? 7 : 4]; const float* w1 = args.in[kv ? 8 : 5]; float a = 0.f;
            for (int k = ks * 256; k < ks * 256 + 256; k += 16) { float pv[16], wv[16];
#pragma unroll
                for (int i = 0; i < 16; ++i) { pv[i] = pe[k + i]; wv[i] = w1[(size_t)(k + i) * 256 + c]; }
#pragma unroll
                for (int i = 0; i < 16; ++i) a += pv[i] * wv[i]; }
            LAS float* red = (LAS float*)lds; red[tid] = a; __syncthreads();
            if (tid < 32) { float s2 = 0.f; for (int q = 0; q < 16; ++q) s2 += red[q * 32 + tid]; ((float*)(ws + WS_PEB))[kv * 256 + (pb & 7) * 32 + tid] = s2; }
            __syncthreads();
        }
        LAS float* scr = (LAS float*)(lds + wave * 16384);
        constexpr int I_IN = 16 * 305, I_K1 = 64 * 8, I_PN = 8 * 64, I_OUT = 16 * 64, I_GU = 16 * 128, I_DN = 16 * 64;
        constexpr int NIT = I_IN + 2 * I_K1 + 2 * I_PN + I_OUT;
        { const int nw = NGW - 16 * NWAVES, U = 4 * nw + 3 * 16 * NWAVES, us = gw < nw ? 4 * gw : 4 * nw + 3 * (gw - nw), ue = us + (gw < nw ? 4 : 3);
          const int it0 = (int)((long long)us * NIT / U), it1 = (int)((long long)ue * NIT / U);
          for (int it = it0; it < it1; ++it) { int r = it;
            if (r < I_IN) { conv_win_item(r, args.in[3], (unsigned char*)(ws + WS_WIN_T), scr, lane); continue; } r -= I_IN;
            if (r < I_K1) { transpose_item(args.in[5], 4096, 256, (bf16*)(ws + WS_WK1_T), RmIdent{0}, scr, r, lane); continue; } r -= I_K1;
            if (r < I_K1) { transpose_item(args.in[8], 4096, 256, (bf16*)(ws + WS_WV1_T), RmIdent{0}, scr, r, lane); continue; } r -= I_K1;
            if (r < I_PN) { conv_plain_item(r, args.in[10], 1024, D, (unsigned char*)(ws + WS_WPN_T), scr, lane); continue; } r -= I_PN;
            if (r < I_PN) { conv_plain_item(r, args.in[11], 1024, D, (unsigned char*)(ws + WS_WPM_T), scr, lane); continue; } r -= I_PN;
            conv_plain_item(r, args.in[12], D, D, (unsigned char*)(ws + WS_WOUT_T), scr, lane);
          } }
        for (int row = gw; row < T; row += NGW) {
            const f32x4* xr = (const f32x4*)(x + (size_t)row * D); f32x4 v[8]; float ss = 0.f;
#pragma unroll
            for (int i = 0; i < 8; ++i) { v[i] = xr[lane + 64 * i]; ss += v[i][0] * v[i][0] + v[i][1] * v[i][1] + v[i][2] * v[i][2] + v[i][3] * v[i][3]; }
            ss = wave_sum(ss); const float rs = rsqrtf(ss * (1.0f / D) + 1e-5f);
            unsigned* hr8 = (unsigned*)(ws + WS_H8 + (size_t)row * D);
#pragma unroll
            for (int i = 0; i < 8; ++i) { const f32x4 gg = ((const f32x4*)args.in[2])[lane + 64 * i]; const f32x4 o = v[i] * rs * gg; hr8[lane + 64 * i] = pk4_fp8(o[0], o[1], o[2], o[3]); }
        }
        for (int i = blk * NTHREADS + tid; i < NE * T; i += G * NTHREADS) ((int*)(ws + WS_ROWDST))[i] = -1;
        for (int i = blk * NTHREADS + tid; i < T * 16; i += G * NTHREADS) { const int t = i >> 4, f = i & 15; const float inv = powf(500000.0f, -(float)(2 * f) / 32.0f); const float ang = (float)positions[t] * inv;
            float* cs = (float*)(ws + WS_CS) + (size_t)t * 32; cs[f] = cosf(ang); cs[16 + f] = sinf(ang); }
    }
    SEAM(0);
    if (IN(1)) {
        EpiIn E{ws, (const float*)(ws + WS_CS)};
        const int gsplit = blk % 10;
        { SchedIn Sc{G, blk, (const char*)(ws + WS_H8), (const char*)(ws + WS_WIN_T), 0, gsplit}; gemm_phase<EpiIn, SchedIn, false, true>(lds, Gemm{D / 2, D / 2, D / 2}, Sc, E); }
        { LAS float* scr = (LAS float*)(lds + wave * 16384);
          { constexpr int NTOT = NE * (16 * 128 + 16 * 64); const int per = (NTOT + NGW - 1) / NGW;
            cv_it = moe_convert<true>(args.in[16], args.in[18], (unsigned char*)(ws + WS_WGU_T), (unsigned char*)(ws + WS_WDN_T), scr, gw * per, 1, lane, per); }
          __syncthreads(); }
        { SchedIn Sc{G, blk, (const char*)(ws + WS_H8), (const char*)(ws + WS_WIN_T), gsplit, 1 << 20}; gemm_phase<EpiIn, SchedIn, false, true>(lds, Gemm{D / 2, D / 2, D / 2}, Sc, E); }
    }
    SEAM(1);
    if (IN(2)) {
        {
#if defined(FK_TS) && defined(FK_EXP) && FK_EXP == 12
            fk_pa = __builtin_amdgcn_s_memrealtime();
#endif
            SchedOne Sc; Sc.has = blk < 64;
            const int kv = blk >> 5, pm = (blk & 31) >> 2, ks = blk & 3;
            Sc.u.a = (const char*)(ws + (kv ? WS_VCMP : WS_KCMP)) + ((size_t)pm * 256 * 2048 + ks * 1024) * 2; Sc.u.b = (const char*)(ws + (kv ? WS_WV1_T : WS_WK1_T)) + (size_t)ks * 1024 * 2; Sc.u.pm = pm; Sc.u.pn = 0; Sc.u.kind = 0;
            EpiHid E{(float*)(ws + WS_HIDP) + ((size_t)(kv * 4 + ks) * 2048 + pm * 256) * 256};
            gemm_phase<EpiHid, SchedOne>(lds, Gemm{1024, 2048, 4096}, Sc, E);
#if defined(FK_TS) && defined(FK_EXP) && FK_EXP == 12
            fk_pb = __builtin_amdgcn_s_memrealtime();
#endif
        }
#if defined(FK_TS) && defined(FK_EXP) && FK_EXP == 11
        for (int rep = 0; rep < 2; ++rep) { if (rep == 1) { xcd_barrier(bar); fk_pa = __builtin_amdgcn_s_memrealtime(); }
#else
        for (int rep = 0; rep < 1; ++rep) {
#endif
        for (;;) {
            const int it = queue_pop(misc, ctl + CW_Q + 64 * (rep ? 7 : 0));
            if (it >= 1024) break;
            if (it < 512) {
                const int bg = it & 7, qc = it >> 3, b = bg >> 1, g = bg & 1, head = g * 4 + (wave >> 1), tq = qc * 64 + (wave & 1) * 32 + (lane & 31);
                const bf16* qrow = (const bf16*)(ws + WS_QN) + (((size_t)b * 8 + head) * S + tq) * HD;
                bf16* orow = (bf16*)(ws + WS_OWIN) + ((size_t)b * S + tq) * 1024 + head * HD;
                attn_item<0, false>(lds, qrow, (const bf16*)(ws + WS_KWIN) + (size_t)bg * S * HD, (const bf16*)(ws + WS_VWIN) + (size_t)bg * S * HD, ~0ull, tq, 512, qc > 8 ? qc - 8 : 0, qc + 1, orow, nullptr, nullptr, 0.f, 0.f, 0.f);
            } else {
                const int id = it - 512, bh = id >> 4, nb = id & 15, p = tid & 15, kg = tid >> 4;
                const bf16* kb = (const bf16*)(ws + WS_MK) + ((size_t)bh * S + nb * 256) * HD; float a[8];
#pragma unroll
                for (int i = 0; i < 8; ++i) a[i] = 0.f;
                for (int kk = 0; kk < 8; ++kk) { const int key = kg * 8 + kk; const u32x4 w = *(const u32x4*)(kb + (size_t)key * HD + ((p ^ (key & 15)) * 8));
                    a[0] += bf2f(w.x & 0xffff); a[1] += bf2f(w.x >> 16); a[2] += bf2f(w.y & 0xffff); a[3] += bf2f(w.y >> 16); a[4] += bf2f(w.z & 0xffff); a[5] += bf2f(w.z >> 16); a[6] += bf2f(w.w & 0xffff); a[7] += bf2f(w.w >> 16); }
                LAS float* red = (LAS float*)lds;
#pragma unroll
                for (int i = 0; i < 8; ++i) red[kg * 128 + p * 8 + i] = a[i];
                __syncthreads();
                if (tid < 128) { float s = 0.f; for (int q = 0; q < 32; ++q) s += red[q * 128 + tid]; ((float*)(ws + WS_KMEAN))[((size_t)bh * 16 + nb) * HD + tid] = s * (1.0f / 256.0f); }
            }
        }
#if defined(FK_TS) && defined(FK_EXP) && FK_EXP == 11
        if (rep == 1) { xcd_barrier(bar); fk_pb = __builtin_amdgcn_s_memrealtime(); }
#endif
        }
    }
    SEAM(2);
    if (IN(3)) {
        for (int it = blk; it < 256; it += G) {
            __syncthreads();
            {
                const int kv = it >> 7, m0 = (it & 127) * 16;
                LAS float* hid = (LAS float*)lds;
                LAS float* outb = (LAS float*)(lds + 16384);
                const float* hp = (const float*)(ws + WS_HIDP) + (size_t)kv * 4 * 2048 * 256; const float* peb = (const float*)(ws + WS_PEB) + kv * 256;
                for (int i = tid; i < 16 * 256; i += NTHREADS) { const int r = i >> 8, c = i & 255; const size_t o = (size_t)(m0 + r) * 256 + c;
                    const float v = ((hp[o] + hp[o + 2048 * 256]) + (hp[o + 2 * 2048 * 256] + hp[o + 3 * 2048 * 256])) + peb[c]; hid[i] = gelu_tanh_f(v); }
                __syncthreads();
                { const int n = tid & 127, rg = tid >> 7; const float* w2 = args.in[kv ? 9 : 6]; float a0 = 0.f, a1 = 0.f, a2 = 0.f, a3 = 0.f;
#pragma unroll 16
                  for (int j = 0; j < 256; ++j) { const float w = w2[j * 128 + n]; a0 += hid[(rg * 4 + 0) * 256 + j] * w; a1 += hid[(rg * 4 + 1) * 256 + j] * w; a2 += hid[(rg * 4 + 2) * 256 + j] * w; a3 += hid[(rg * 4 + 3) * 256 + j] * w; }
                  outb[(rg * 4 + 0) * 128 + n] = a0; outb[(rg * 4 + 1) * 128 + n] = a1; outb[(rg * 4 + 2) * 128 + n] = a2; outb[(rg * 4 + 3) * 128 + n] = a3; }
                __syncthreads();
                const int bg = m0 >> 8, i0 = m0 & 255;
                if (kv == 0) {
                    if (tid < 256) { const int r = tid >> 4, p = tid & 15, i = i0 + r; float v[8];
#pragma unroll
                        for (int e = 0; e < 8; ++e) v[e] = outb[r * 128 + p * 8 + e];
                        if (p < 4) { int tk = 16 * i + 31; tk = tk < S ? tk : S - 1; const float* cs = (const float*)(ws + WS_CS) + ((size_t)(bg >> 1) * S + tk) * 32 + 8 * (p & 1);
#pragma unroll
                            for (int e = 0; e < 8; ++e) { const float o = outb[r * 128 + (p ^ 2) * 8 + e]; v[e] = p < 2 ? v[e] * cs[e] - o * cs[16 + e] : v[e] * cs[e] + o * cs[16 + e]; } }
                        u32x4 w; w.x = pk2(v[0], v[1]); w.y = pk2(v[2], v[3]); w.z = pk2(v[4], v[5]); w.w = pk2(v[6], v[7]);
                        *(u32x4*)((bf16*)(ws + WS_KC) + (size_t)bg * 4 * 8192 + (size_t)i * HD + ((p ^ (i & 15)) * 8)) = w; }
                } else {
                    const int qd = tid >> 7, d = tid & 127, i = i0 + 4 * qd;
                    u32x2 w; w.x = pk2(outb[(4 * qd) * 128 + d], outb[(4 * qd + 1) * 128 + d]); w.y = pk2(outb[(4 * qd + 2) * 128 + d], outb[(4 * qd + 3) * 128 + d]);
                    *(u32x2*)((bf16*)(ws + WS_VC) + (size_t)bg * 4 * 8192 + (size_t)(i >> 6) * 8192 + (((i & 63) >> 2) * 128 + d) * 4) = w;
                }
            }
        }
        for (int it = blk; it < 256; it += G) {
            const int bh = it >> 3, tbase = (it & 7) * 512 + 64 * wave, fe = lane & 15, q4 = lane >> 4;
            bf16x8 khi[4], klo[4];
#pragma unroll
            for (int ks = 0; ks < 4; ++ks) { const float* kp = (const float*)(ws + WS_KMEAN) + ((size_t)bh * 16 + fe) * HD + 32 * ks + 8 * q4; const f32x4 a = *(const f32x4*)kp, c = *(const f32x4*)(kp + 4);
                u32x4 h, l; h.x = pk2(a[0], a[1]); h.y = pk2(a[2], a[3]); h.z = pk2(c[0], c[1]); h.w = pk2(c[2], c[3]);
                l.x = pk2(a[0] - bf2f(h.x & 0xffff), a[1] - bf2f(h.x >> 16)); l.y = pk2(a[2] - bf2f(h.y & 0xffff), a[3] - bf2f(h.y >> 16));
                l.z = pk2(c[0] - bf2f(h.z & 0xffff), c[1] - bf2f(h.z >> 16)); l.w = pk2(c[2] - bf2f(h.w & 0xffff), c[3] - bf2f(h.w >> 16));
                khi[ks] = __builtin_bit_cast(bf16x8, h); klo[ks] = __builtin_bit_cast(bf16x8, l); }
#pragma unroll
            for (int rb = 0; rb < 4; ++rb) { const int t = tbase + 16 * rb + fe, own = t >> 8;
                const bf16* qr = (const bf16*)(ws + WS_MQ) + ((size_t)bh * S + t) * HD + 8 * q4; bf16x8 qa[4];
#pragma unroll
                for (int ks = 0; ks < 4; ++ks) qa[ks] = *(const bf16x8*)(qr + 32 * ks);
                f32x4 d = {0.f, 0.f, 0.f, 0.f};
#pragma unroll
                for (int ks = 0; ks < 4; ++ks) { d = __builtin_amdgcn_mfma_f32_16x16x32_bf16(khi[ks], qa[ks], d, 0, 0, 0); d = __builtin_amdgcn_mfma_f32_16x16x32_bf16(klo[ks], qa[ks], d, 0, 0, 0); }
                float g[4]; int rank[4];
#pragma unroll
                for (int r = 0; r < 4; ++r) { g[r] = (4 * q4 + r) < own ? d[r] : -1e9f; rank[r] = 0; }
#pragma unroll
                for (int r = 0; r < 4; ++r)
#pragma unroll
                    for (int rp = 0; rp < 4; ++rp) if (rp != r) rank[r] += (g[rp] > g[r] || (g[rp] == g[r] && rp < r)) ? 1 : 0;
#pragma unroll
                for (int xq = 1; xq < 4; ++xq)
#pragma unroll
                    for (int rp = 0; rp < 4; ++rp) { const float o = __shfl_xor(g[rp], 16 * xq); const int np = 4 * (q4 ^ xq) + rp;
#pragma unroll
                        for (int r = 0; r < 4; ++r) rank[r] += (o > g[r] || (o == g[r] && np < 4 * q4 + r)) ? 1 : 0; }
                unsigned mlo = 0u, mhi = 0u;
#pragma unroll
                for (int r = 0; r < 4; ++r) if (rank[r] < 3 && g[r] > -0.5e9f) { const unsigned nb = 0xFu << (4 * ((4 * q4 + r) & 7)); if (q4 < 2) mlo |= nb; else mhi |= nb; }
                mlo |= __shfl_xor(mlo, 16); mhi |= __shfl_xor(mhi, 16); mlo |= __shfl_xor(mlo, 32); mhi |= __shfl_xor(mhi, 32);
                if (q4 == 0) ((u64*)(ws + WS_MMOBA))[(size_t)bh * S + t] = (((u64)mhi << 32) | mlo) | (0xFull << (4 * own));
            }
        }
    }
    SEAM(3);
    if (IN(4)) {
        for (;;) {
            const int it = queue_pop(misc, ctl + CW_Q + 64 * 1);
            if (it >= 1024) break;
            if (it < 512) {
                const int qb = 15 - (it >> 5), bh = it & 31, b = bh >> 3, head = bh & 7, tq = qb * 256 + wave * 32 + (lane & 31);
                const bf16* qrow = (const bf16*)(ws + WS_MQ) + ((size_t)bh * S + tq) * HD;
                const u64 mk = ((const u64*)(ws + WS_MMOBA))[(size_t)bh * S + tq];
                unsigned char* orow = (unsigned char*)(ws + WS_OB) + ((size_t)b * S + tq) * 1024 + head * HD;
                attn_item<1, false>(lds, qrow, (const bf16*)(ws + WS_MK) + (size_t)bh * S * HD, (const bf16*)(ws + WS_MV) + (size_t)bh * S * HD, mk, tq, 1 << 30, 0, 4 * (qb + 1), orow, nullptr, nullptr, 0.f, 0.f, 0.f);
            } else { const int id = it - 512; cmp_item(lds, ws, id & 7, 63 - (id >> 3)); }
        }
    }
    SEAM(4);
    if (IN(5)) {
        for (;;) {
            const int it = queue_pop(misc, ctl + CW_Q + 64 * 2);
            if (it >= 512) break;
            const int bg = it & 7, qc = 63 - (it >> 3), b = bg >> 1, g = bg & 1, head = g * 4 + (wave >> 1), tq = qc * 64 + (wave & 1) * 32 + (lane & 31);
            const size_t trow = (size_t)b * S + tq;
            const bf16* qrow = (const bf16*)(ws + WS_QN) + (((size_t)b * 8 + head) * S + tq) * HD;
            const u64 mk = ((const u64*)(ws + WS_MSEL))[(size_t)bg * S + tq];
            const float* gn = (const float*)(ws + WS_GN) + trow * 24;
            attn_item<2, false>(lds, qrow, (const bf16*)(ws + WS_KSLC) + (size_t)bg * S * HD, (const bf16*)(ws + WS_VSLC) + (size_t)bg * S * HD, mk, tq, 1 << 30, 0, qc + 1,
                         (unsigned char*)(ws + WS_OA) + trow * 1024 + head * HD, (const bf16*)(ws + WS_OCMP) + trow * 1024 + head * HD, (const bf16*)(ws + WS_OWIN) + trow * 1024 + head * HD, gn[head], gn[8 + head], gn[16 + head]);
        }
    }
    SEAM(5);
    if (IN(6)) {
        SchedProj Sc{G, blk, (const char*)(ws + WS_OA), (const char*)(ws + WS_OB), (const char*)(ws + WS_WPN_T), (const char*)(ws + WS_WPM_T)}; EpiProj E{ws};
        gemm_phase<EpiProj, SchedProj, false, true>(lds, Gemm{512, 512, 512}, Sc, E);
#if defined(FK_TS) && defined(FK_EXP) && FK_EXP == 8
        xcd_barrier(bar); STAMP(14);
        gemm_phase<EpiProj, SchedProj, false, true>(lds, Gemm{512, 512, 512}, Sc, E, nullptr, nullptr, true);
        xcd_barrier(bar); STAMP(15);
#endif
    }
    SEAM(6);
    if (IN(7)) {
        SchedOut Sc{G, blk, (const char*)(ws + WS_MIX), (const char*)(ws + WS_WOUT_T)}; EpiOut E{x, (bf16*)(ws + WS_X1)};
        gemm_phase<EpiOut, SchedOut, false, true>(lds, Gemm{D / 2, D / 2, D / 2}, Sc, E);
    }
    SEAM(7);
    if (IN(8)) {
        LAS float* part = (LAS float*)lds;
        LAS float* rsv = (LAS float*)(lds + 65536);
        LAS int* lcnt = (LAS int*)(lds + 65536 + 8192);
        LAS int* lbase = lcnt + 32;
        LAS int* lsel = lcnt + 64;
        LAS int* lidx = lcnt + 64 + 2048;
        LAS float* lwt = (LAS float*)(lcnt + 64 + 4096);
        if (tid < NE) lcnt[tid] = 0;
        const int tok0 = blk * 64, fe = lane & 15, kq = lane >> 4;
        { f32x4 gg8[8]; u32x2 vr[8];
#pragma unroll
          for (int i = 0; i < 8; ++i) gg8[i] = ((const f32x4*)args.in[13])[lane + 64 * i];
          { const u32x2* xr = (const u32x2*)((const bf16*)(ws + WS_X1) + (size_t)(tok0 + 8 * wave) * D);
#pragma unroll
            for (int i = 0; i < 8; ++i) vr[i] = xr[lane + 64 * i]; }
          for (int r = 0; r < 8; ++r) { const int tok = tok0 + 8 * wave + r; float ss = 0.f; f32x4 v[8];
              int ln = lane; asm volatile("" : "+v"(ln));
#pragma unroll
              for (int i = 0; i < 8; ++i) { v[i][0] = bf2f(vr[i].x & 0xffff); v[i][1] = bf2f(vr[i].x >> 16); v[i][2] = bf2f(vr[i].y & 0xffff); v[i][3] = bf2f(vr[i].y >> 16); }
              if (r + 1 < 8) { const u32x2* xr = (const u32x2*)((const bf16*)(ws + WS_X1) + (size_t)(tok + 1) * D);
#pragma unroll
                  for (int i = 0; i < 8; ++i) vr[i] = xr[ln + 64 * i]; }
#pragma unroll
              for (int i = 0; i < 8; ++i) ss += v[i][0] * v[i][0] + v[i][1] * v[i][1] + v[i][2] * v[i][2] + v[i][3] * v[i][3];
              ss = wave_sum(ss); const float rs = rsqrtf(ss * (1.0f / D) + 1e-5f);
              unsigned* hr = (unsigned*)(ws + WS_H8 + (size_t)tok * D);
#pragma unroll
              for (int i = 0; i < 8; ++i) { const f32x4 o = v[i] * rs * gg8[i]; hr[ln + 64 * i] = pk4_fp8(o[0], o[1], o[2], o[3]); }
              if (lane == 0) rsv[8 * wave + r] = rs; } }
        bf16x8 bhi[8][2], blo[8][2];
#pragma unroll
        for (int j = 0; j < 8; ++j) { const int k0 = 256 * wave + 64 * (j >> 1) + 16 * kq + 8 * (j & 1);
            const f32x4 g0 = *(const f32x4*)(args.in[13] + k0), g1 = *(const f32x4*)(args.in[13] + k0 + 4);
#pragma unroll
            for (int eb = 0; eb < 2; ++eb) { float v[8], r[8];
#pragma unroll
                for (int i = 0; i < 8; ++i) v[i] = args.in[14][(size_t)(k0 + i) * NE + 16 * eb + fe] * (i < 4 ? g0[i & 3] : g1[i & 3]);
                u32x4 h, l; h.x = pk2(v[0], v[1]); h.y = pk2(v[2], v[3]); h.z = pk2(v[4], v[5]); h.w = pk2(v[6], v[7]);
                r[0] = v[0] - bf2f(h.x & 0xffff); r[1] = v[1] - bf2f(h.x >> 16); r[2] = v[2] - bf2f(h.y & 0xffff); r[3] = v[3] - bf2f(h.y >> 16);
                r[4] = v[4] - bf2f(h.z & 0xffff); r[5] = v[5] - bf2f(h.z >> 16); r[6] = v[6] - bf2f(h.w & 0xffff); r[7] = v[7] - bf2f(h.w >> 16);
                l.x = pk2(r[0], r[1]); l.y = pk2(r[2], r[3]); l.z = pk2(r[4], r[5]); l.w = pk2(r[6], r[7]);
                bhi[j][eb] = __builtin_bit_cast(bf16x8, h); blo[j][eb] = __builtin_bit_cast(bf16x8, l); } }
        { f32x4 lacc[4][2];
#pragma unroll
          for (int rb = 0; rb < 4; ++rb)
#pragma unroll
              for (int eb = 0; eb < 2; ++eb) lacc[rb][eb] = (f32x4){0.f, 0.f, 0.f, 0.f};
#pragma unroll
          for (int rbp = 0; rbp < 2; ++rbp) { bf16x8 af[2][8];
#pragma unroll
              for (int rr = 0; rr < 2; ++rr)
#pragma unroll
                  for (int j = 0; j < 8; ++j) af[rr][j] = *(const bf16x8*)((const bf16*)(ws + WS_X1) + (size_t)(tok0 + 16 * (2 * rbp + rr) + fe) * D + 256 * wave + 64 * (j >> 1) + 16 * kq + 8 * (j & 1));
#pragma unroll
              for (int rr = 0; rr < 2; ++rr)
#pragma unroll
                  for (int j = 0; j < 8; ++j)
#pragma unroll
                      for (int eb = 0; eb < 2; ++eb) { lacc[2 * rbp + rr][eb] = __builtin_amdgcn_mfma_f32_16x16x32_bf16(af[rr][j], bhi[j][eb], lacc[2 * rbp + rr][eb], 0, 0, 0);
                          lacc[2 * rbp + rr][eb] = __builtin_amdgcn_mfma_f32_16x16x32_bf16(af[rr][j], blo[j][eb], lacc[2 * rbp + rr][eb], 0, 0, 0); } }
#pragma unroll
          for (int rb = 0; rb < 4; ++rb)
#pragma unroll
              for (int eb = 0; eb < 2; ++eb)
#pragma unroll
                  for (int i = 0; i < 4; ++i) part[(wave * 64 + 16 * rb + 4 * kq + i) * 32 + 16 * eb + fe] = lacc[rb][eb][i]; }
        __syncthreads();
#pragma unroll 1
        for (int q4 = 0; q4 < 4; ++q4) { const int tl = 16 * q4 + (tid >> 5), e = lane & 31, tok = tok0 + tl; float lg = 0.f;
#pragma unroll
            for (int w8 = 0; w8 < 8; ++w8) lg += part[(w8 * 64 + tl) * 32 + e];
            lg = lg * rsv[tl] + args.in[15][e];
            int rank = 0; float mx = lg;
#pragma unroll
            for (int ep = 0; ep < 32; ++ep) { const float o = __shfl(lg, (lane & 32) + ep); rank += (o > lg || (o == lg && ep < e)) ? 1 : 0; mx = fmaxf(mx, o); }
            const bool sel = rank < 4; const float ex = sel ? __expf(lg - mx) : 0.f; float sum = ex;
#pragma unroll
            for (int o = 1; o < 32; o <<= 1) sum += __shfl_xor(sum, o);
            if (sel) { const int slot = (tl << 2) + rank;
                lsel[slot] = e; lidx[slot] = (int)__hip_atomic_fetch_add((LAS unsigned*)lcnt + e, 1u, __ATOMIC_RELAXED, __HIP_MEMORY_SCOPE_WORKGROUP);
                lwt[slot] = ex / sum; } (void)tok; }
        __syncthreads();
        if (tid < NE) lbase[tid] = (int)__hip_atomic_fetch_add(ctl + CW_CNT + 64 * tid, (unsigned)lcnt[tid], __ATOMIC_RELAXED, __HIP_MEMORY_SCOPE_AGENT);
        __syncthreads();
        if (tid < 256) { const int e = lsel[tid], r = e * T + lbase[e] + lidx[tid];
            ((int*)(ws + WS_ROWDST))[r] = (tok0 + (tid >> 2)) * 4 + (tid & 3); ((float*)(ws + WS_ROWW))[r] = lwt[tid]; }
    }
    SEAM(8);
    STAMP(10);
    if (IN(10)) {
        moe_offsets(misc, ctl + CW_CNT);
        SchedMoe Sc{G, blk, 16, (const LAS int*)(misc + 16), (const char*)(ws + WS_H8), (const char*)(ws + WS_WGU_T), (size_t)4096 * 2048, (size_t)256 * 2048}; EpiAct E{args.in[17], (unsigned char*)(ws + WS_ACT)};
        LAS unsigned short* gtab = (LAS unsigned short*)(lds + MISC_OFF + 1024);
        for (int ui0 = 0; ui0 < 28; ui0 += 4) {
            Unit uu[4]; bool ok[4]; int vv[4];
#pragma unroll
            for (int q = 0; q < 4; ++q) { ok[q] = Sc.next(ui0 + q, uu[q]); vv[q] = (ok[q] && tid < 256) ? ((const int*)(ws + WS_ROWDST))[uu[q].kind * T - (int)misc[16 + uu[q].kind] + uu[q].pm * 256 + tid] : 0; }
#pragma unroll
            for (int q = 0; q < 4; ++q) if (ok[q] && tid < 256) gtab[(ui0 + q) * 256 + tid] = (unsigned short)(vv[q] < 0 ? 0 : (vv[q] >> 2));
            if (!ok[3]) break; }
        __syncthreads();
        gemm_phase<EpiAct, SchedMoe, true, true>(lds, Gemm{D / 2, D / 2, D / 2}, Sc, E, (const char*)(ws + WS_H8), gtab);
#if defined(FK_TS) && defined(FK_EXP) && FK_EXP != 8
        xcd_barrier(bar); STAMP(14);
#if FK_EXP == 1
        gemm_phase<EpiAct, SchedMoe, true, true>(lds, Gemm{D / 2, D / 2, D / 2}, Sc, E, (const char*)(ws + WS_H8), gtab, true);
#elif FK_EXP == 3
        { struct SX { SchedMoe s; __device__ __forceinline__ bool next(int i, Unit& u) const { if (!s.next(i, u)) return false; u.a = s.A + (size_t)(u.pm & 63) * s.ts; return true; } } Sx{Sc};
          gemm_phase<EpiAct, SX, false, true>(lds, Gemm{D / 2, D / 2, D / 2}, Sx, E, nullptr, nullptr, true); }
#elif FK_EXP == 4
        gemm_phase<EpiAct, SchedMoe, true, true, 1>(lds, Gemm{D / 2, D / 2, D / 2}, Sc, E, (const char*)(ws + WS_H8), gtab, true);
#elif FK_EXP == 5
        gemm_phase<EpiAct, SchedMoe, true, true, 2>(lds, Gemm{D / 2, D / 2, D / 2}, Sc, E, (const char*)(ws + WS_H8), gtab, true);
#elif FK_EXP == 6
        gemm_phase<EpiAct, SchedMoe, true, true, 0, true>(lds, Gemm{D / 2, D / 2, D / 2}, Sc, E, (const char*)(ws + WS_H8), gtab, true);
#elif FK_EXP == 7
        { struct SX { SchedMoe s; __device__ __forceinline__ bool next(int i, Unit& u) const { if (!s.next(i, u)) return false; u.a = s.A + (size_t)(u.pm & 1) * s.ts; u.b = s.W + (size_t)(u.pn & 1) * s.ts; return true; } } Sx{Sc};
          gemm_phase<EpiAct, SX, false, true>(lds, Gemm{D / 2, D / 2, D / 2}, Sx, E, nullptr, nullptr, true); }
#elif FK_EXP == 2
        gemm_phase<EpiAct, SchedMoe, true, true>(lds, Gemm{D / 2, D / 2, D / 2}, Sc, E, (const char*)(ws + WS_H8), gtab, false);
#endif
        xcd_barrier(bar); STAMP(15);
#endif
    }
    SEAM(10);
    if (IN(11)) {
        moe_offsets(misc, ctl + CW_CNT);
        SchedMoe Sc{G, blk, 8, (const LAS int*)(misc + 16), (const char*)(ws + WS_ACT), (const char*)(ws + WS_WDN_T), (size_t)2048 * 2048, (size_t)256 * 2048}; EpiDown E{args.in[19], (const int*)(ws + WS_ROWDST), (const float*)(ws + WS_ROWW), (unsigned char*)(ws + WS_YS), (const LAS int*)(misc + 16)};
        gemm_phase<EpiDown, SchedMoe, false, true>(lds, Gemm{FF / 2, FF / 2, FF / 2}, Sc, E);
    }
    SEAM(11);
    if (IN(12)) {
        for (int tok = gw; tok < T; tok += NGW) {
            f32x4 v[8]; float ss = 0.f;
#pragma unroll
            for (int i = 0; i < 8; ++i) { const u32x2 xb = ((const u32x2*)((const bf16*)(ws + WS_X1) + (size_t)tok * D))[lane + 64 * i]; f32x4 a = {bf2f(xb.x & 0xffff), bf2f(xb.x >> 16), bf2f(xb.y & 0xffff), bf2f(xb.y >> 16)}, ysum = {0.f, 0.f, 0.f, 0.f};
#pragma unroll
                for (int k = 0; k < 4; ++k) { const int y = ((const int*)(ws + WS_YS + ((size_t)tok * 4 + k) * D))[lane + 64 * i];
                    const auto lo = __builtin_amdgcn_cvt_pk_f32_fp8(y, false), hi = __builtin_amdgcn_cvt_pk_f32_fp8(y, true);
                    ysum[0] += lo[0]; ysum[1] += lo[1]; ysum[2] += hi[0]; ysum[3] += hi[1]; }
                a = a + ysum * (1.0f / YS_SCALE);
                v[i] = a; ss += a[0] * a[0] + a[1] * a[1] + a[2] * a[2] + a[3] * a[3]; }
            ss = wave_sum(ss); const float rs = rsqrtf(ss * (1.0f / D) + 1e-5f);
#pragma unroll
            for (int i = 0; i < 8; ++i) { const f32x4 gg = ((const f32x4*)args.in[20])[lane + 64 * i]; ((f32x4*)(args.out + (size_t)tok * D))[lane + 64 * i] = v[i] * rs * gg; }
        }
    }
#ifdef FK_TS
    if (blk == 0 && tid == 0) {
        asm volatile("s_waitcnt vmcnt(0)" ::: "memory");
        const unsigned long long tend = __builtin_amdgcn_s_memrealtime();
        misc[64 + 2 * 13] = (unsigned)tend; misc[65 + 2 * 13] = (unsigned)(tend >> 32);
        const unsigned long long ta = ((unsigned long long)misc[65 + 2 * FK_TS_LO] << 32) | misc[64 + 2 * FK_TS_LO], tb = ((unsigned long long)misc[65 + 2 * FK_TS_HI] << 32) | misc[64 + 2 * FK_TS_HI];
#if FK_TS_LO == 99
        const unsigned long long span = (fk_pb - fk_pa) * FK_TS_F;
#else
        const unsigned long long span = (tb - ta) * FK_TS_F;
#endif
        if (span < 2000000ull) while (__builtin_amdgcn_s_memrealtime() - tend < span) __builtin_amdgcn_s_sleep(8);
    }
#endif
#undef IN
#undef SEAM
}

static void launch_phases(void* const* d_in, void* d_out, void* d_ws, hipStream_t stream, int lo, int hi, bool per_phase) {
    static int grid = 0;
    if (grid == 0) {
        int dev = 0, cus = 0;
        (void)hipGetDevice(&dev); (void)hipDeviceGetAttribute(&cus, hipDeviceAttributeMultiprocessorCount, dev);
        (void)hipFuncSetAttribute((const void*)fwd, hipFuncAttributeMaxDynamicSharedMemorySize, LDS_BYTES);
        grid = cus > 0 ? cus : 256;
    }
    Args a{};
    for (int i = 0; i < 21; ++i) a.in[i] = (const float*)d_in[i];
    a.out = (float*)d_out; a.ws = (unsigned char*)d_ws;
    if (per_phase) { for (int p = lo; p < hi; ++p) { a.ph_lo = p; a.ph_hi = p + 1; hipLaunchKernelGGL(fwd, dim3(grid), dim3(NTHREADS), LDS_BYTES, stream, a); } }
    else { a.ph_lo = lo; a.ph_hi = hi; hipLaunchKernelGGL(fwd, dim3(grid), dim3(NTHREADS), LDS_BYTES, stream, a); }
}
}
extern "C" void kernel_launch(void* const* d_in, const int* in_sizes, int n_in, void* d_out, int out_size, void* d_ws, size_t ws_size, hipStream_t stream) {
    using namespace fk;
    (void)hipMemsetAsync((char*)d_ws + WS_CTL, 0, CTL_BYTES, stream);
    launch_phases(d_in, d_out, d_ws, stream, 0, NPHASE, false);
}
```

```cpp
#include <hip/hip_runtime.h>
#include <stdint.h>
namespace fk {
#define LAS __attribute__((address_space(3)))
#define GAS __attribute__((address_space(1)))
typedef unsigned short bf16;
typedef unsigned long long u64;
typedef short bf16x8 __attribute__((ext_vector_type(8)));
typedef float f32x4 __attribute__((ext_vector_type(4)));
typedef float f32x16 __attribute__((ext_vector_type(16)));
typedef unsigned u32x4 __attribute__((ext_vector_type(4)));
typedef unsigned u32x2 __attribute__((ext_vector_type(2)));
typedef float f32x2_t __attribute__((ext_vector_type(2)));
typedef __bf16 bf16x2_t __attribute__((ext_vector_type(2)));

constexpr int D = 2048, NB = 4, S = 4096, T = NB * S, HD = 128, NE = 32, FF = 2048, INW = 9752;
constexpr int NTHREADS = 512, NWAVES = 8;

__device__ __forceinline__ unsigned pk2(float lo, float hi) { f32x2_t v = {lo, hi}; bf16x2_t b = __builtin_convertvector(v, bf16x2_t); return __builtin_bit_cast(unsigned, b); }
__device__ __forceinline__ float bf2f(unsigned short b) { return __builtin_bit_cast(float, (unsigned)b << 16); }
__device__ __forceinline__ float wave_sum(float v) {
#pragma unroll
    for (int o = 1; o < 64; o <<= 1) v += __shfl_xor(v, o);
    return v;
}
__device__ __forceinline__ float sigmoid_f(float x) { return __builtin_amdgcn_rcpf(1.0f + __expf(-x)); }

#define XB_TMO      128
#define XB_XCNT(j)  (256  + 64 * (j))
#define XB_XSUB(j)  (1280 + 64 * (j))
#define XB_XGEN(j)  (2304 + 64 * (j))
#define XB_TOP      3328
#define XB_TOPGEN   3392
#define XCD_BAR_WORDS 3456
#define XB_SPIN_CAP (1u << 18)
__device__ __forceinline__ unsigned xb_ld(unsigned* p)              { return __hip_atomic_load(p, __ATOMIC_RELAXED, __HIP_MEMORY_SCOPE_AGENT); }
__device__ __forceinline__ unsigned xb_add(unsigned* p, unsigned v) { return __hip_atomic_fetch_add(p, v, __ATOMIC_RELAXED, __HIP_MEMORY_SCOPE_AGENT); }
__device__ __forceinline__ unsigned xb_xcc_id() { return (unsigned)__builtin_amdgcn_s_getreg((3 << 11) | 20) & 0xFu; }
#define XB_SPIN(cond, bar) do { unsigned _sp = 0; while (cond) { __builtin_amdgcn_s_sleep(1); \
    if ((++_sp & 255u) == 0u) { if (xb_ld(&(bar)[XB_TMO])) break; if (_sp > XB_SPIN_CAP) { atomicAdd(&(bar)[XB_TMO], 1u); break; } } } } while (0)
struct XcdBarrier { unsigned* bar; unsigned x; volatile LAS unsigned* st; };
__device__ __forceinline__ XcdBarrier xcd_barrier_post(unsigned* bar, volatile LAS unsigned* st) {
    XcdBarrier b; b.bar = bar; b.x = xb_xcc_id(); b.st = st;
    if (threadIdx.x == 0) (void)xb_add(&bar[XB_XCNT(b.x)], 1u);
    return b;
}
__device__ __forceinline__ void xcd_barrier_complete(unsigned* bar, unsigned x, unsigned& nloc, unsigned& nx) {
    const unsigned G = gridDim.x * gridDim.y * gridDim.z;
    unsigned sum, cnt, mine, sp = 0u;
    for (;;) {
        sum = 0u; cnt = 0u; mine = 0u;
#pragma unroll
        for (unsigned j = 0; j < 16; ++j) { const unsigned c = xb_ld(&bar[XB_XCNT(j)]); sum += c; cnt += (c > 0u) ? 1u : 0u; mine = (j == x) ? c : mine; }
        if (sum == G) break;
        __builtin_amdgcn_s_sleep(1);
        if ((++sp & 255u) == 0u) { if (xb_ld(&bar[XB_TMO])) break; if (sp > XB_SPIN_CAP) { atomicAdd(&bar[XB_TMO], 1u); break; } }
    }
    nloc = mine > 0u ? mine : 1u; nx = cnt > 0u ? cnt : 1u;
}
__device__ __forceinline__ void xcd_barrier(const XcdBarrier& b) {
    asm volatile("s_waitcnt vmcnt(0)" ::: "memory");
    __syncthreads();
    if (threadIdx.x == 0) {
        unsigned* bar = b.bar;
        __builtin_amdgcn_s_waitcnt(0);
        unsigned nloc = b.st[0], nx = b.st[1];
        if (nloc == 0u) { xcd_barrier_complete(bar, b.x, nloc, nx); b.st[0] = nloc; b.st[1] = nx; }
        const unsigned old = xb_add(&bar[XB_XSUB(b.x)], 1u);
        const unsigned gen = old / nloc;
        if (old + 1u == (gen + 1u) * nloc) {
            __builtin_amdgcn_fence(__ATOMIC_RELEASE, "agent");
            asm volatile("s_waitcnt vmcnt(0)" ::: "memory");
            const unsigned og = xb_add(&bar[XB_TOP], 1u);
            const unsigned tg = og / nx;
            if (og + 1u == (tg + 1u) * nx) xb_add(&bar[XB_TOPGEN], 1u);
            else XB_SPIN(xb_ld(&bar[XB_TOPGEN]) == tg, bar);
            __builtin_amdgcn_fence(__ATOMIC_ACQUIRE, "agent");
            xb_add(&bar[XB_XGEN(b.x)], 1u);
            asm volatile("s_waitcnt vmcnt(0)" ::: "memory");
        } else {
            XB_SPIN(xb_ld(&bar[XB_XGEN(b.x)]) == gen, bar);
            __builtin_amdgcn_fence(__ATOMIC_ACQUIRE, "agent");
            asm volatile("s_waitcnt vmcnt(0)" ::: "memory");
        }
    }
    __syncthreads();
}

constexpr int BM = 256, BK = 64, HALF = 128, HTB = HALF * BK * 2, STAGE_BYTES = 8 * HTB, NXCD = 8, WGM = 8;
__host__ __device__ __forceinline__ int lds_byte(int r, int c) { const int st = (r >> 4) * 2 + (c >> 5), rr = r & 15, cc = c & 31, ob = rr * 64 + cc * 2; return st * 1024 + (ob ^ (((ob >> 9) & 1) << 5)); }
__host__ __device__ __forceinline__ void stage_rc(int b, int& R, int& C) { const int st = b / 1024, sb = b % 1024, swz = sb ^ (((sb >> 9) & 1) << 5); R = (st >> 1) * 16 + swz / 64; C = (st & 1) * 32 + (swz % 64) / 2; }
__host__ __device__ __forceinline__ int lds_byte8(int r, int q) { return ((r >> 4) * 2 + (q >> 2)) * 1024 + (((r & 15) * 64 + (q & 3) * 16) ^ (((r >> 3) & 1) << 4)); }
__host__ __device__ __forceinline__ void stage_rc8(int b, int& R, int& C) { const int st = b / 1024, sb = b % 1024, rr = sb / 64, swz = sb ^ (((rr >> 3) & 1) << 4); R = (st >> 1) * 16 + rr; C = ((st & 1) * 4 + (swz % 64) / 16) * 8; }
__host__ __device__ __forceinline__ int perm32(int rho) { const int n = rho >> 4, i = rho & 15; return 8 * (i >> 2) + 4 * n + (i & 3); }

struct Unit { const char* a; const char* b; int pm, pn, kind; };
struct Gemm { int K, lda, ldb; };
__device__ __forceinline__ void tile_map(int L, int nM, int nN, int& pm, int& pn) {
    const int nwg = nM * nN; int wgid = L;
    { const int q = nwg / NXCD, r = nwg % NXCD, xcd = wgid % NXCD, off = wgid / NXCD; wgid = (xcd < r ? xcd * (q + 1) : r * (q + 1) + (xcd - r) * q) + off; }
    const int nig = WGM * nN, gid = wgid / nig, fm = gid * WGM, gsz = (nM - fm) < WGM ? (nM - fm) : WGM;
    pm = fm + ((wgid % nig) % gsz); pn = (wgid % nig) / gsz;
}
typedef int i32x8 __attribute__((ext_vector_type(8)));
typedef int i32x4 __attribute__((ext_vector_type(4)));
template <class Epi, class Sched, bool GATHER = false, bool FP8 = false, int DBG = 0, bool DMAX = false>
__device__ __forceinline__ void gemm_phase(LAS unsigned char* lds, const Gemm g, const Sched& S, const Epi& E, const char* A0 = nullptr, const LAS unsigned short* gtab = nullptr, const bool skip_epi = false) {
    const int tid = threadIdx.x, wid = __builtin_amdgcn_readfirstlane(tid >> 6), lane = tid & 63, wr = wid >> 2, wc = wid & 3, fr = lane & 15, fq = lane >> 4;
    const int K = g.K, nt = K / BK;
    unsigned voffA[2], voffB[2]; int gR[2], gC[2];
#pragma unroll
    for (int i = 0; i < 2; ++i) { int R, C; if constexpr (FP8) stage_rc8(tid * 16 + i * 8192, R, C); else stage_rc(tid * 16 + i * 8192, R, C); const int Rb = Epi::PERM ? ((R & ~31) + perm32(R & 31)) : R; gR[i] = R; gC[i] = C * 2;
        voffA[i] = (unsigned)(R * g.lda + C) * 2u; voffB[i] = (unsigned)(Rb * g.ldb + C) * 2u; }
    unsigned gaC[2][2], gaN[2][2];
#define PG8_GA(ga, slot) do { _Pragma("unroll") for (int _h = 0; _h < 2; ++_h) _Pragma("unroll") for (int _i = 0; _i < 2; ++_i) \
        ga[_h][_i] = (unsigned)gtab[(slot) * 256 + _h * 128 + gR[_i]] * (unsigned)(g.lda * 2) + (unsigned)gC[_i]; } while (0)
#define PG8_STAGEA(bufoff, h, kofs, nx) do { if constexpr (GATHER) { const char* _gb = A0 + (kofs); asm volatile("" : "+s"(_gb)); _Pragma("unroll") for (int _i = 0; _i < 2; ++_i) \
        __builtin_amdgcn_global_load_lds((const unsigned*)(_gb + ((nx) ? gaN[h][_i] : gaC[h][_i])), (LAS unsigned*)(lds + (bufoff) + ldsw + _i * 8192), 16, 0, 0); } \
    else { PG8_STAGE(bufoff, ((nx) ? nA : cA) + (kofs) + (h) * hstepA, voffA); } } while (0)
    const size_t kstep = (size_t)(BK * 2);
    const size_t hstepA = (size_t)HALF * g.lda * 2, hstepB = (size_t)HALF * g.ldb * 2;
    const unsigned ldsw = (unsigned)wid * 1024u;
    const int aoff = lds_byte(wr * 64 + fr, fq * 8), boff = lds_byte(wc * 32 + fr, fq * 8);
    const int aoff80 = lds_byte8(wr * 64 + fr, 2 * fq), aoff81 = lds_byte8(wr * 64 + fr, 2 * fq + 1), boff80 = lds_byte8(wc * 32 + fr, 2 * fq), boff81 = lds_byte8(wc * 32 + fr, 2 * fq + 1);
#define PG8_SA(b, h) (((b) * 2 + (h)) * HTB)
#define PG8_SB(b, h) ((4 + (b) * 2 + (h)) * HTB)
#define PG8_STAGE(bufoff, gbase, voff) do { const char* _gb = (const char*)(gbase); asm volatile("" : "+s"(_gb)); _Pragma("unroll") for (int _i = 0; _i < 2; ++_i) \
        __builtin_amdgcn_global_load_lds((const unsigned*)(_gb + (voff)[_i]), (LAS unsigned*)(lds + (bufoff) + ldsw + _i * 8192), 16, 0, 0); } while (0)
#define PG8_FRAG8(dst, p0, p1) do { const i32x4 _lo = *(const LAS i32x4*)(p0), _hi = *(const LAS i32x4*)(p1); dst = __builtin_shufflevector(_lo, _hi, 0, 1, 2, 3, 4, 5, 6, 7); } while (0)
#define PG8_LDA(dst, b, h) do { if constexpr (DBG == 2) { } else if constexpr (FP8) { _Pragma("unroll") for (int m = 0; m < 4; ++m) PG8_FRAG8(dst##8[m], lds + PG8_SA(b, h) + aoff80 + m * 2048, lds + PG8_SA(b, h) + aoff81 + m * 2048); } \
    else { _Pragma("unroll") for (int m = 0; m < 4; ++m) _Pragma("unroll") for (int k = 0; k < 2; ++k) dst[m][k] = *(const LAS bf16x8*)(lds + PG8_SA(b, h) + aoff + m * 2048 + k * 1024); } } while (0)
#define PG8_LDB(dst, b, h) do { if constexpr (DBG == 2) { } else if constexpr (FP8) { _Pragma("unroll") for (int n = 0; n < 2; ++n) PG8_FRAG8(dst##8[n], lds + PG8_SB(b, h) + boff80 + n * 2048, lds + PG8_SB(b, h) + boff81 + n * 2048); } \
    else { _Pragma("unroll") for (int n = 0; n < 2; ++n) _Pragma("unroll") for (int k = 0; k < 2; ++k) dst[n][k] = *(const LAS bf16x8*)(lds + PG8_SB(b, h) + boff + n * 2048 + k * 1024); } } while (0)
#define PG8_MMA(ai, bj, At, Bt) do { __builtin_amdgcn_s_setprio(0);        if constexpr (DBG == 1) { _Pragma("unroll") for (int m = 0; m < 4; ++m) asm volatile("" :: "v"(At##8[m])); _Pragma("unroll") for (int n = 0; n < 2; ++n) asm volatile("" :: "v"(Bt##8[n])); } else if constexpr (FP8) { _Pragma("unroll") for (int m = 0; m < 4; ++m) _Pragma("unroll") for (int n = 0; n < 2; ++n) \
        asm volatile("v_mfma_scale_f32_16x16x128_f8f6f4 %0, %1, %2, %0, %3, %3 op_sel_hi:[0,0,0]" : "+v"(acc[ai][bj][m][n]) : "v"(Bt##8[n]), "v"(At##8[m]), "v"(sc8)); } \
    else { _Pragma("unroll") for (int m = 0; m < 4; ++m) _Pragma("unroll") for (int n = 0; n < 2; ++n) _Pragma("unroll") for (int k = 0; k < 2; ++k) \
        acc[ai][bj][m][n] = __builtin_amdgcn_mfma_f32_16x16x32_bf16(Bt[n][k], At[m][k], acc[ai][bj][m][n], 0, 0, 0); } __builtin_amdgcn_s_setprio(2); } while (0)
#define PG8_MF8(ai, bj, At, Bt, m, n) asm volatile("v_mfma_scale_f32_16x16x128_f8f6f4 %0, %1, %2, %0, %3, %3 op_sel_hi:[0,0,0]" : "+v"(acc[ai][bj][m][n]) : "v"(Bt##8[n]), "v"(At##8[m]), "v"(sc8))
#define PG8_MMAX(ai, bj, At, Bt, X1, X2) do { __builtin_amdgcn_s_setprio(1); PG8_MF8(ai, bj, At, Bt, 0, 0); PG8_MF8(ai, bj, At, Bt, 0, 1); X1; PG8_MF8(ai, bj, At, Bt, 1, 0); PG8_MF8(ai, bj, At, Bt, 1, 1); \
        PG8_MF8(ai, bj, At, Bt, 2, 0); PG8_MF8(ai, bj, At, Bt, 2, 1); X2; PG8_MF8(ai, bj, At, Bt, 3, 0); PG8_MF8(ai, bj, At, Bt, 3, 1); __builtin_amdgcn_s_setprio(0); } while (0)
#define PG8_WAIT_V(n) asm volatile("s_waitcnt vmcnt(" #n ")" ::: "memory")
#define PG8_WAIT_L(n) asm volatile("s_waitcnt lgkmcnt(" #n ")" ::: "memory")
#define PG8_BAR __builtin_amdgcn_s_barrier()
#define PG8_SCHED __builtin_amdgcn_sched_barrier(0)
    Unit cur, nxt; int ui = 0;
    if (!S.next(0, cur)) return;
    f32x4 acc[2][2][4][2];
#pragma unroll
    for (int a = 0; a < 2; ++a)
#pragma unroll
        for (int b = 0; b < 2; ++b)
#pragma unroll
            for (int m = 0; m < 4; ++m)
#pragma unroll
                for (int n = 0; n < 2; ++n) acc[a][b][m][n] = (f32x4){0.f, 0.f, 0.f, 0.f};
    bf16x8 At[4][2], B0[2][2], B1[2][2];
    i32x8 At8[4], B08[2], B18[2];
    if constexpr (DBG == 2) {
#pragma unroll
        for (int m = 0; m < 4; ++m) { At8[m] = (i32x8){0, 0, 0, 0, 0, 0, 0, 0}; asm volatile("" : "+v"(At8[m])); }
#pragma unroll
        for (int n = 0; n < 2; ++n) { B08[n] = (i32x8){0, 0, 0, 0, 0, 0, 0, 0}; B18[n] = B08[n]; asm volatile("" : "+v"(B08[n]), "+v"(B18[n])); } }
    const int sc8 = 0x7f7f7f7f;
    const char* cA = cur.a; const char* cB = cur.b; const char* nA = cA;
    if constexpr (GATHER) { PG8_GA(gaC, 0); }
    {
        PG8_STAGE(PG8_SB(0, 0), cB, voffB); PG8_STAGE(PG8_SB(0, 1), cB + hstepB, voffB); PG8_STAGEA(PG8_SA(0, 0), 0, (size_t)0, false); PG8_STAGEA(PG8_SA(0, 1), 1, (size_t)0, false);
        if (wr == 1) PG8_BAR;
        PG8_WAIT_V(2); PG8_BAR;
        PG8_STAGE(PG8_SB(1, 0), cB + kstep, voffB); PG8_STAGEA(PG8_SA(1, 0), 0, kstep, false); PG8_STAGE(PG8_SB(1, 1), cB + hstepB + kstep, voffB);
        PG8_WAIT_V(6); PG8_BAR;
    }
    for (;;) {
        const bool has_next = S.next(ui + 1, nxt);
        nA = has_next ? nxt.a : cA; const char* nB = has_next ? nxt.b : cB;
        if constexpr (GATHER) { if (has_next) { PG8_GA(gaN, ui + 1); } else {
#pragma unroll
            for (int _h = 0; _h < 2; ++_h)
#pragma unroll
                for (int _i = 0; _i < 2; ++_i) gaN[_h][_i] = gaC[_h][_i]; } }
        for (int t = 0; t < nt; t += 2) {
            const bool last = (t == nt - 2);
            const size_t k1 = (size_t)(t + 1) * kstep, k2 = last ? (size_t)0 : (size_t)(t + 2) * kstep, k3 = k2 + kstep;
            const char* b2 = last ? nB : cB + (size_t)(t + 2) * kstep;
            const char* b3 = b2 + kstep;
            if constexpr (FP8 && DMAX) {
            PG8_LDB(B0, 0, 0); PG8_LDB(B1, 0, 1); PG8_SCHED; PG8_LDA(At, 0, 0); PG8_STAGEA(PG8_SA(1, 1), 1, k1, false);
            PG8_WAIT_V(8); PG8_WAIT_L(0); PG8_BAR; PG8_MMAX(0, 0, At, B0, (void)0, (void)0); PG8_MMAX(0, 1, At, B1, (void)0, (void)0); PG8_BAR; PG8_SCHED;
            PG8_LDA(At, 0, 1); PG8_STAGE(PG8_SB(0, 0), b2, voffB); PG8_STAGEA(PG8_SA(0, 0), 0, k2, last);
            PG8_WAIT_V(6); PG8_WAIT_L(0); PG8_BAR; PG8_MMAX(1, 0, At, B0, PG8_STAGE(PG8_SB(0, 1), b2 + hstepB, voffB), (void)0); PG8_MMAX(1, 1, At, B1, (void)0, (void)0); PG8_BAR; PG8_SCHED;
            PG8_LDB(B0, 1, 0); PG8_LDB(B1, 1, 1); PG8_SCHED; PG8_LDA(At, 1, 0); PG8_STAGEA(PG8_SA(0, 1), 1, k2, last);
            PG8_WAIT_V(8); PG8_WAIT_L(0); PG8_BAR; PG8_MMAX(0, 0, At, B0, (void)0, (void)0); PG8_MMAX(0, 1, At, B1, (void)0, (void)0); PG8_BAR; PG8_SCHED;
            PG8_LDA(At, 1, 1); PG8_STAGE(PG8_SB(1, 0), b3, voffB); PG8_STAGEA(PG8_SA(1, 0), 0, k3, last);
            PG8_WAIT_V(6); PG8_WAIT_L(0); PG8_BAR; PG8_MMAX(1, 0, At, B0, PG8_STAGE(PG8_SB(1, 1), b3 + hstepB, voffB), (void)0); PG8_MMAX(1, 1, At, B1, (void)0, (void)0); PG8_BAR; PG8_SCHED;
            continue; }
            PG8_LDB(B0, 0, 0); PG8_LDB(B1, 0, 1); PG8_SCHED; PG8_LDA(At, 0, 0); PG8_STAGEA(PG8_SA(1, 1), 1, k1, false);
            PG8_WAIT_V(8); PG8_WAIT_L(0); PG8_BAR; PG8_MMA(0, 0, At, B0); PG8_MMA(0, 1, At, B1); PG8_BAR; PG8_SCHED;
            PG8_LDA(At, 0, 1); PG8_STAGE(PG8_SB(0, 0), b2, voffB); PG8_STAGE(PG8_SB(0, 1), b2 + hstepB, voffB); PG8_STAGEA(PG8_SA(0, 0), 0, k2, last);
            PG8_WAIT_V(8); PG8_WAIT_L(0); PG8_BAR; PG8_MMA(1, 0, At, B0); PG8_MMA(1, 1, At, B1); PG8_BAR; PG8_SCHED;
            PG8_LDB(B0, 1, 0); PG8_LDB(B1, 1, 1); PG8_SCHED; PG8_LDA(At, 1, 0); PG8_STAGEA(PG8_SA(0, 1), 1, k2, last);
            PG8_WAIT_V(8); PG8_WAIT_L(0); PG8_BAR; PG8_MMA(0, 0, At, B0); PG8_MMA(0, 1, At, B1); PG8_BAR; PG8_SCHED;
            PG8_LDA(At, 1, 1); PG8_STAGE(PG8_SB(1, 0), b3, voffB); PG8_STAGE(PG8_SB(1, 1), b3 + hstepB, voffB); PG8_STAGEA(PG8_SA(1, 0), 0, k3, last);
            PG8_WAIT_V(8); PG8_WAIT_L(0); PG8_BAR; PG8_MMA(1, 0, At, B0); PG8_MMA(1, 1, At, B1); PG8_BAR; PG8_SCHED;
        }
        if (wr == 0) PG8_BAR;
        if constexpr (FP8) asm volatile("s_nop 15\n\ts_nop 15" ::: "memory");
        { int fr_ = fr, fq_ = fq; asm volatile("" : "+v"(fr_), "+v"(fq_));
          if (!skip_epi) E(acc, cur, wr, wc, fr_, fq_); }
        if (!has_next) break;
#pragma unroll
        for (int a = 0; a < 2; ++a)
#pragma unroll
            for (int b = 0; b < 2; ++b)
#pragma unroll
                for (int m = 0; m < 4; ++m)
#pragma unroll
                    for (int n = 0; n < 2; ++n) acc[a][b][m][n] = (f32x4){0.f, 0.f, 0.f, 0.f};
        cur = nxt; cA = nA; cB = nB; ++ui;
        if constexpr (GATHER) {
#pragma unroll
            for (int _h = 0; _h < 2; ++_h)
#pragma unroll
                for (int _i = 0; _i < 2; ++_i) gaC[_h][_i] = gaN[_h][_i]; }
        if (wr == 1) PG8_BAR;
    }
    PG8_WAIT_V(0);
    PG8_BAR;
#undef PG8_SA
#undef PG8_SB
#undef PG8_STAGE
#undef PG8_STAGEA
#undef PG8_GA
#undef PG8_LDA
#undef PG8_FRAG8
#undef PG8_LDB
#undef PG8_MMA
#undef PG8_WAIT_V
#undef PG8_WAIT_L
#undef PG8_BAR
#undef PG8_SCHED
}

constexpr size_t al256(size_t x) { return (x + 255) & ~(size_t)255; }
constexpr int PMAX = T * 4 + NE * 256;
constexpr size_t WS_CTL = 0, CTL_BYTES = 1u << 20;
constexpr size_t WS_WIN_T  = CTL_BYTES;
constexpr size_t WS_WK1_T  = WS_WIN_T + al256((size_t)9984 * 2048 * 2);
constexpr size_t WS_WV1_T  = WS_WK1_T + al256((size_t)256 * 4096 * 2);
constexpr size_t WS_WPN_T  = WS_WV1_T + al256((size_t)256 * 4096 * 2);
constexpr size_t WS_WPM_T  = WS_WPN_T + al256((size_t)2048 * 1024 * 2);
constexpr size_t WS_WOUT_T = WS_WPM_T + al256((size_t)2048 * 1024 * 2);
constexpr size_t WS_WGU_T  = WS_WOUT_T + al256((size_t)2048 * 2048 * 2);
constexpr size_t WS_WDN_T  = WS_WGU_T + al256((size_t)NE * 4096 * 2048 * 2);
constexpr size_t WS_H      = WS_WDN_T + al256((size_t)NE * 2048 * 2048 * 2);
constexpr size_t WS_X1     = WS_H + al256((size_t)T * D * 2);
constexpr size_t WS_SELE   = WS_X1 + al256((size_t)T * D * 4);
constexpr size_t WS_SELW   = WS_SELE + al256((size_t)T * 4 * 4);
constexpr size_t WS_SELP   = WS_SELW + al256((size_t)T * 4 * 4);
constexpr size_t WS_ROWDST = WS_SELP + al256((size_t)T * 4 * 4);
constexpr size_t WS_ROWW   = WS_ROWDST + al256((size_t)NE * T * 4);
constexpr size_t WS_H8     = WS_ROWW + al256((size_t)NE * T * 4);
constexpr size_t WS_WGM8   = WS_H8 + al256((size_t)T * D);
constexpr size_t WS_U0     = WS_WGM8 + al256((size_t)4096 * 2048);
constexpr size_t WS_QN     = WS_U0;
constexpr size_t HB2 = al256((size_t)T * 2 * HD * 2 + 65536);
constexpr size_t HB8 = al256((size_t)T * 8 * HD * 2);
constexpr size_t WS_KCMP   = WS_QN + HB8;
constexpr size_t WS_VCMP   = WS_KCMP + HB2;
constexpr size_t WS_KSLC   = WS_VCMP + HB2;
constexpr size_t WS_KWIN   = WS_KSLC + HB2;
constexpr size_t WS_VSLC   = WS_KWIN + HB2;
constexpr size_t WS_VWIN   = WS_VSLC + HB2;
constexpr size_t WS_MQ     = WS_VWIN + HB2;
constexpr size_t WS_MK     = WS_MQ + HB8;
constexpr size_t WS_MV     = WS_MK + HB8;
constexpr size_t WS_GN     = WS_MV + HB8;
constexpr size_t WS_GM     = WS_GN + al256((size_t)T * 24 * 4);
constexpr size_t WS_CS     = WS_GM + al256((size_t)T * 4096 * 2);
constexpr size_t WS_HIDP   = WS_CS + al256((size_t)T * 32 * 4);
constexpr size_t WS_PEB    = WS_HIDP + al256((size_t)2 * 4 * 2048 * 256 * 4);
constexpr size_t WS_KC     = WS_PEB + al256(2 * 256 * 4);
constexpr size_t WS_VC     = WS_KC + al256((size_t)8 * 4 * 8192 * 2);
constexpr size_t WS_KMEAN  = WS_VC + al256((size_t)8 * 4 * 8192 * 2);
constexpr size_t WS_MSEL   = WS_KMEAN + al256((size_t)NB * 8 * 16 * HD * 4);
constexpr size_t WS_MMOBA  = WS_MSEL + al256((size_t)NB * 2 * S * 8);
constexpr size_t WS_OCMP   = WS_MMOBA + al256((size_t)NB * 8 * S * 8);
constexpr size_t WS_OWIN   = WS_OCMP + al256((size_t)T * 1024 * 4);
constexpr size_t WS_OA     = WS_OWIN + al256((size_t)T * 1024 * 4);
constexpr size_t WS_OB     = WS_OA + al256((size_t)T * 1024 * 2);
constexpr size_t WS_MIXP   = WS_OB + al256((size_t)T * 1024 * 2);
constexpr size_t WS_MIX    = WS_MIXP + al256((size_t)T * D * 4);
constexpr size_t WS_ATT_END = WS_MIX + al256((size_t)T * D * 2);
constexpr size_t WS_XPAD   = WS_U0;
constexpr size_t WS_ACT    = WS_XPAD + al256((size_t)PMAX * D * 2);
constexpr size_t WS_YS     = WS_ACT + al256((size_t)PMAX * FF * 2);
constexpr size_t WS_MOE_END = WS_YS + al256((size_t)T * 4 * D * 2);
constexpr size_t WS_END    = WS_ATT_END > WS_MOE_END ? WS_ATT_END : WS_MOE_END;
constexpr int CW_BAR = 4096;
constexpr int CW_CNT = 16384;
constexpr int CW_Q   = 16384 + 64 * 32;
constexpr int RING_BYTES = 131072, MISC_OFF = 131072, LDS_BYTES = 147456;

constexpr float A8_SCALE = 64.0f;
constexpr float YS_SCALE = 32.0f;
constexpr float W8_SCALE = 64.0f;
struct Args { const float* in[21]; float* out; unsigned char* ws; int ph_lo, ph_hi; };

template <class RowMap>
__device__ __forceinline__ void transpose_item(const float* __restrict__ W, int K, int N, bf16* WT, const RowMap& rm, LAS float* scr, int item, int lane, int nblk_use = 0) {
    const int nblk = nblk_use ? nblk_use : (N + 31) / 32, kb = item / nblk, nb = item % nblk, k0 = 64 * kb, n0 = 32 * nb;
    const bool cok = (n0 + (lane & 31)) < N;
#pragma unroll 8
    for (int i = 0; i < 32; ++i) { const int kk = 2 * i + (lane >> 5); scr[kk * 33 + (lane & 31)] = cok ? W[(size_t)(k0 + kk) * N + n0 + (lane & 31)] : 0.f; }
    asm volatile("s_waitcnt lgkmcnt(0)" ::: "memory");
    const int c = lane & 7;
#pragma unroll
    for (int j = 0; j < 4; ++j) { const int n = (lane >> 3) + 8 * j; const LAS float* s = scr + (8 * c) * 33 + n;
        u32x4 o; o.x = pk2(s[0 * 33], s[1 * 33]); o.y = pk2(s[2 * 33], s[3 * 33]); o.z = pk2(s[4 * 33], s[5 * 33]); o.w = pk2(s[6 * 33], s[7 * 33]);
        const long dr = (n0 + n) < N ? rm(n0 + n) : -1;
        if (dr >= 0) *(u32x4*)(WT + (size_t)dr * K + k0 + 8 * c) = o; }
    asm volatile("s_waitcnt lgkmcnt(0)" ::: "memory");
}
__device__ __forceinline__ unsigned pk4_fp8(float a, float b, float c, float d) { int p = __builtin_amdgcn_cvt_pk_fp8_f32(a, b, 0, false); p = __builtin_amdgcn_cvt_pk_fp8_f32(c, d, p, true); return (unsigned)p; }
struct ConvItem { const float* src; unsigned char* dst; int N, n0, gu; long roff; };
__device__ __forceinline__ ConvItem conv_item(int it, const float* wgu, const float* wdn, unsigned char* wgu8, unsigned char* wdn8, int lane) {
    constexpr int I_GU = 16 * 128, I_DN = 16 * 64; ConvItem c; int e, r, nblk;
    if (it < NE * I_GU) { e = it / I_GU; r = it % I_GU; nblk = 128; c.N = 2 * FF; c.gu = 1; c.roff = (long)e * 4096; c.src = wgu + (size_t)e * D * 2 * FF; c.dst = wgu8; }
    else { it -= NE * I_GU; e = it / I_DN; r = it % I_DN; nblk = 64; c.N = D; c.gu = 0; c.roff = (long)e * 2048; c.src = wdn + (size_t)e * FF * D; c.dst = wdn8; }
    const int kb = r / nblk, nb = r % nblk; c.n0 = 32 * nb;
    c.src += (size_t)(128 * kb + (lane >> 3)) * c.N + c.n0 + 4 * (lane & 7); c.dst += 128 * kb + 16 * (lane & 7);
    return c;
}
#define CONV_LOAD(v, c) do { _Pragma("unroll") for (int _i = 0; _i < 16; ++_i) v[_i] = __builtin_nontemporal_load((const f32x4*)((c).src + (size_t)(8 * _i) * (c).N)); } while (0)
#define CONV_PROC(v, c) do { const int _lr = lane >> 3, _lg = lane & 7; \
    _Pragma("unroll") for (int _i = 0; _i < 16; ++_i) { const int _k = 8 * _i + _lr; *(LAS f32x4*)(scr + _k * 32 + 4 * (_lg ^ (((_k >> 4) ^ _k) & 7))) = v[_i] * W8_SCALE; } \
    asm volatile("s_waitcnt lgkmcnt(0)" ::: "memory"); \
    _Pragma("unroll") for (int _jj = 0; _jj < 4; ++_jj) { const int _n = _lr + 8 * _jj; float _f[16]; \
        _Pragma("unroll") for (int _j = 0; _j < 16; ++_j) { const int _k = 16 * _lg + _j; _f[_j] = scr[_k * 32 + 4 * ((_n >> 2) ^ (((_k >> 4) ^ _k) & 7)) + (_n & 3)]; } \
        u32x4 _o; _o.x = pk4_fp8(_f[0], _f[1], _f[2], _f[3]); _o.y = pk4_fp8(_f[4], _f[5], _f[6], _f[7]); _o.z = pk4_fp8(_f[8], _f[9], _f[10], _f[11]); _o.w = pk4_fp8(_f[12], _f[13], _f[14], _f[15]); \
        const int _nn = (c).n0 + _n; const long _dr = (c).gu ? ((c).roff + ((_nn >= FF ? _nn - FF : _nn) >> 7) * 256 + (_nn >= FF ? 128 : 0) + (_nn & 127)) : ((c).roff + _nn); \
        *(u32x4*)((c).dst + (size_t)_dr * 2048) = _o; } \
    asm volatile("s_waitcnt lgkmcnt(0)" ::: "memory"); } while (0)
__device__ __forceinline__ ConvItem conv_item_gm(int it, const float* win, unsigned char* wgm8, int lane) {
    ConvItem c; const int kb = it >> 7, nb = it & 127; c.N = INW; c.gu = 0; c.roff = 0; c.n0 = 32 * nb;
    c.src = win + 5656 + (size_t)(128 * kb + (lane >> 3)) * INW + c.n0 + 4 * (lane & 7); c.dst = wgm8 + 128 * kb + 16 * (lane & 7); return c;
}
template <bool PIPE>
__device__ __forceinline__ int moe_convert(const float* wgu, const float* wdn, unsigned char* wgu8, unsigned char* wdn8, LAS float* scr, int first, int stride, int lane, int maxn) {
    constexpr int NTOT = NE * (16 * 128 + 16 * 64);
    int it = first; if (it >= NTOT || maxn <= 0) return it;
    const long lim = (long)first + (long)maxn * stride; const int end = lim < NTOT ? (int)lim : NTOT;
    if constexpr (!PIPE) { f32x4 va[16];
        for (; it < end; it += stride) { asm volatile("" : "+v"(lane)); const ConvItem ca = conv_item(it, wgu, wdn, wgu8, wdn8, lane); CONV_LOAD(va, ca); CONV_PROC(va, ca); }
        return it; }
    f32x4 va[16], vb[16];
    ConvItem ca = conv_item(it, wgu, wdn, wgu8, wdn8, lane), cb = ca; CONV_LOAD(va, ca);
    for (;;) {
        const int itb = it + stride; if (itb < end) { cb = conv_item(itb, wgu, wdn, wgu8, wdn8, lane); CONV_LOAD(vb, cb); }
        CONV_PROC(va, ca);
        if (itb >= end) return itb;
        const int ita = itb + stride; if (ita < end) { ca = conv_item(ita, wgu, wdn, wgu8, wdn8, lane); CONV_LOAD(va, ca); }
        CONV_PROC(vb, cb);
        if (ita >= end) return ita;
        it = ita;
    }
}
struct RmIdent { long off; __device__ long operator()(int n) const { return off + n; } };
struct RmWin { __device__ long operator()(int n) const {
    if (n < 1024) return n;
    if (n < 2560) { const int c = n - 1024, which = c >> 8, r = c & 255;
        return which == 0 ? 1024 + r : which == 1 ? 1280 + r : which == 2 ? 1536 + r : which == 3 ? 8448 + r : which == 4 ? 1792 + r : 8448 + 256 + r; }
    if (n < 2584) return 8192 + (n - 2560);
    if (n < 5656) { const int c = n - 2584, which = c >> 10, r = c & 1023; return which == 0 ? 2048 + r : which == 1 ? 3072 + r : 8448 + 512 + r; }
    return 4096 + (n - 5656); } };
__device__ __forceinline__ void conv_win_item(int it, const float* win, unsigned char* w8, LAS float* scr, int lane) {
    const int kb = it / 305, nb = it % 305, k0 = 128 * kb, n0 = 32 * nb, lr = lane >> 3, lg = lane & 7;
    const bool cok = n0 + 4 * lg < INW;
    f32x4 v[16];
#pragma unroll
    for (int i = 0; i < 16; ++i) v[i] = cok ? __builtin_nontemporal_load((const f32x4*)(win + (size_t)(k0 + lr + 8 * i) * INW + n0 + 4 * lg)) : (f32x4){0.f, 0.f, 0.f, 0.f};
#pragma unroll
    for (int i = 0; i < 16; ++i) { const int k = 8 * i + lr; *(LAS f32x4*)(scr + k * 32 + 4 * (lg ^ (((k >> 4) ^ k) & 7))) = v[i] * W8_SCALE; }
    asm volatile("s_waitcnt lgkmcnt(0)" ::: "memory");
#pragma unroll
    for (int jj = 0; jj < 4; ++jj) { const int n = lr + 8 * jj; float f[16];
#pragma unroll
        for (int j = 0; j < 16; ++j) { const int k = 16 * lg + j; f[j] = scr[k * 32 + 4 * ((n >> 2) ^ (((k >> 4) ^ k) & 7)) + (n & 3)]; }
        u32x4 o; o.x = pk4_fp8(f[0], f[1], f[2], f[3]); o.y = pk4_fp8(f[4], f[5], f[6], f[7]); o.z = pk4_fp8(f[8], f[9], f[10], f[11]); o.w = pk4_fp8(f[12], f[13], f[14], f[15]);
        if (n0 + n < INW) *(u32x4*)(w8 + (size_t)RmWin{}(n0 + n) * 2048 + k0 + 16 * lg) = o; }
    asm volatile("s_waitcnt lgkmcnt(0)" ::: "memory");
}
__device__ __forceinline__ void conv_plain_item(int it, const float* W, int K, int N, unsigned char* w8, LAS float* scr, int lane) {
    const int nblk = N / 32, kb = it / nblk, nb = it % nblk, k0 = 128 * kb, n0 = 32 * nb, lr = lane >> 3, lg = lane & 7;
    f32x4 v[16];
#pragma unroll
    for (int i = 0; i < 16; ++i) v[i] = __builtin_nontemporal_load((const f32x4*)(W + (size_t)(k0 + lr + 8 * i) * N + n0 + 4 * lg));
#pragma unroll
    for (int i = 0; i < 16; ++i) { const int k = 8 * i + lr; *(LAS f32x4*)(scr + k * 32 + 4 * (lg ^ (((k >> 4) ^ k) & 7))) = v[i] * W8_SCALE; }
    asm volatile("s_waitcnt lgkmcnt(0)" ::: "memory");
#pragma unroll
    for (int jj = 0; jj < 4; ++jj) { const int n = lr + 8 * jj; float f[16];
#pragma unroll
        for (int j = 0; j < 16; ++j) { const int k = 16 * lg + j; f[j] = scr[k * 32 + 4 * ((n >> 2) ^ (((k >> 4) ^ k) & 7)) + (n & 3)]; }
        u32x4 o; o.x = pk4_fp8(f[0], f[1], f[2], f[3]); o.y = pk4_fp8(f[4], f[5], f[6], f[7]); o.z = pk4_fp8(f[8], f[9], f[10], f[11]); o.w = pk4_fp8(f[12], f[13], f[14], f[15]);
        *(u32x4*)(w8 + (size_t)(n0 + n) * K + k0 + 16 * lg) = o; }
    asm volatile("s_waitcnt lgkmcnt(0)" ::: "memory");
}
struct RmGu { long off; __device__ long operator()(int n) const { const int lin = n >= FF, j = lin ? n - FF : n; return off + (j >> 7) * 256 + lin * 128 + (j & 127); } };

struct EpiIn {
    static constexpr bool PERM = true;
    unsigned char* ws; const float* cs;
    __device__ __forceinline__ void operator()(const f32x4 (&acc)[2][2][4][2], const Unit& u, int wr, int wc, int fr, int fq) const {
        const int lane = threadIdx.x & 63;
        if (u.kind != 1) {
            const int pn = u.pn, tok0 = u.pm * 256; constexpr float usc = 1.0f / W8_SCALE;
            const bool is_rope = (pn < 4) || pn == 6 || pn == 7 || (pn >= 8 && pn < 16);
#pragma unroll
            for (int ai = 0; ai < 2; ++ai)
#pragma unroll
              for (int mh = 0; mh < 2; ++mh) { f32x4 csv[2][4];
                if (is_rope && wc == 0) {
#pragma unroll
                    for (int mm = 0; mm < 2; ++mm) { const float* cst = cs + (size_t)(tok0 + ai * 128 + wr * 64 + (2 * mh + mm) * 16 + fr) * 32 + 8 * (fq & 1);
                        csv[mm][0] = *(const f32x4*)cst; csv[mm][1] = *(const f32x4*)(cst + 4); csv[mm][2] = *(const f32x4*)(cst + 16); csv[mm][3] = *(const f32x4*)(cst + 20); } }
#pragma unroll
                for (int m = 2 * mh; m < 2 * mh + 2; ++m) {
                    const int t = tok0 + ai * 128 + wr * 64 + m * 16 + fr, b = t >> 12, s = t & (S - 1);
#pragma unroll
                    for (int bj = 0; bj < 2; ++bj) {
                        f32x4 v0 = acc[ai][bj][m][0] * usc, v1 = acc[ai][bj][m][1] * usc;
                        if (pn < 16) {
                            if (is_rope && wc == 0) {
                                f32x4 p0, p1;
#pragma unroll
                                for (int i = 0; i < 4; ++i) { p0[i] = __shfl_xor(v0[i], 32); p1[i] = __shfl_xor(v1[i], 32); }
                                const f32x4 c0 = csv[m & 1][0], c1 = csv[m & 1][1], s0 = csv[m & 1][2], s1 = csv[m & 1][3];
                                if (fq < 2) { v0 = v0 * c0 - p0 * s0; v1 = v1 * c1 - p1 * s1; }
                                else        { v0 = v0 * c0 + p0 * s0; v1 = v1 * c1 + p1 * s1; }
                            }
                            u32x4 w; w.x = pk2(v0[0], v0[1]); w.y = pk2(v0[2], v0[3]); w.z = pk2(v1[0], v1[1]); w.w = pk2(v1[2], v1[3]);
                            const int piece = 4 * wc + fq;
                            size_t off;
                            bf16* dst;
                            if (pn < 4) { dst = (bf16*)(ws + WS_QN); off = (((size_t)b * 8 + 2 * pn + bj) * S + s) * HD + piece * 8; }
                            else if (pn == 4) { dst = (bf16*)(ws + WS_KCMP); off = (((size_t)b * 2 + bj) * S + s) * HD + piece * 8; }
                            else if (pn == 5) { dst = (bf16*)(ws + WS_VCMP); off = (((size_t)b * 2 + bj) * S + s) * HD + piece * 8; }
                            else if (pn < 8) { dst = (bf16*)(ws + (pn == 6 ? WS_KSLC : WS_KWIN)); off = (((size_t)b * 2 + bj) * S + s) * HD + ((piece ^ (s & 15)) * 8); }
                            else if (pn < 12) { dst = (bf16*)(ws + WS_MQ); off = (((size_t)b * 8 + 2 * (pn - 8) + bj) * S + s) * HD + piece * 8; }
                            else { dst = (bf16*)(ws + WS_MK); off = (((size_t)b * 8 + 2 * (pn - 12) + bj) * S + s) * HD + ((piece ^ (s & 15)) * 8); }
                            *(u32x4*)(dst + off) = w;
                        } else if (pn < 32) {
                            unsigned q0[4], q1[4];
#pragma unroll
                            for (int i = 0; i < 4; ++i) { q0[i] = (unsigned)(255.0f * sigmoid_f(v0[i]) + 0.5f); q1[i] = (unsigned)(255.0f * sigmoid_f(v1[i]) + 0.5f); }
                            u32x2 w; w.x = q0[0] | (q0[1] << 8) | (q0[2] << 16) | (q0[3] << 24); w.y = q1[0] | (q1[1] << 8) | (q1[2] << 16) | (q1[3] << 24);
                            *(u32x2*)(ws + WS_GM + (size_t)t * 4096 + (pn - 16) * 256 + bj * 128 + wc * 32 + fq * 8) = w;
                        } else {
                            if (bj == 0 && wc == 0 && fq < 3) {
#pragma unroll
                                for (int i = 0; i < 4; ++i) { v0[i] = sigmoid_f(v0[i]); v1[i] = sigmoid_f(v1[i]); }
                                float* gp = (float*)(ws + WS_GN) + (size_t)t * 24 + fq * 8;
                                *(f32x4*)gp = v0; *(f32x4*)(gp + 4) = v1;
                            }
                        }
                    }
                } }
        } else {
            const int j = u.pm, tok0 = u.pn * 256;
#pragma unroll
            for (int ai = 0; ai < 2; ++ai) {
                bf16* dst; int nh, head;
                if (j == 0) { dst = (bf16*)(ws + WS_VSLC); nh = 2; head = ai; } else if (j == 1) { dst = (bf16*)(ws + WS_VWIN); nh = 2; head = ai; } else { dst = (bf16*)(ws + WS_MV); nh = 8; head = 2 * (j - 2) + ai; }
#pragma unroll
                for (int m = 0; m < 4; ++m) {
                    const int d = wr * 64 + m * 16 + fr;
#pragma unroll
                    for (int bj = 0; bj < 2; ++bj) {
                        const int t = tok0 + bj * 128 + wc * 32 + fq * 8, b = t >> 12, s = t & (S - 1);
                        const f32x4 v0 = acc[ai][bj][m][0] * (1.0f / W8_SCALE), v1 = acc[ai][bj][m][1] * (1.0f / W8_SCALE);
                        bf16* tp = dst + ((size_t)b * nh + head) * S * HD + (size_t)(s >> 6) * 8192 + (((s & 63) >> 2) * 128 + d) * 4;
                        u32x2 q0, q1; q0.x = pk2(v0[0], v0[1]); q0.y = pk2(v0[2], v0[3]); q1.x = pk2(v1[0], v1[1]); q1.y = pk2(v1[2], v1[3]);
                        *(u32x2*)tp = q0; *(u32x2*)(tp + 512) = q1;
                    }
                }
            }
        }
    }
};
struct SchedGm {
    int G, c; const char* Hp; const char* Wp;
    __device__ __forceinline__ bool next(int i, Unit& u) const { const int L = i * G + c; if (L >= 64 * 16) return false; int pj; tile_map(L, 64, 16, u.pm, pj); constexpr size_t ts = (size_t)256 * 2048;
        u.pn = 16 + pj; u.kind = 2; u.a = Hp + u.pm * ts; u.b = Wp + pj * ts; return true; }
};
struct SchedIn {
    int G, c; const char* Hp; const char* Wp; int lo, hi;
    __device__ __forceinline__ bool next(int i, Unit& u) const {
        if (lo + i >= hi) return false;
        int L = (lo + i) * G + c; constexpr size_t ts = (size_t)256 * 2048;
        if (L < 64 * 33) { tile_map(L, 64, 33, u.pm, u.pn); u.a = Hp + u.pm * ts; u.b = Wp + u.pn * ts; u.kind = 0; return true; }
        L -= 64 * 33;
        if (L < 6 * 64) { tile_map(L, 6, 64, u.pm, u.pn); u.a = Wp + (33 + u.pm) * ts; u.b = Hp + u.pn * ts; u.kind = 1; return true; }
        return false;
    }
};

#define ATT_C 0.12751743074602194f
#define ATT_MFMA(a, b, c) __builtin_amdgcn_mfma_f32_32x32x16_bf16((a), (b), (c), 0, 0, 0)
#define ATT_DMA(j, buf) do { const char* _kp = (const char*)kt + (size_t)(j) * 16384 + so; const char* _vp = (const char*)vt + (size_t)(j) * 16384 + so; \
    __builtin_amdgcn_global_load_lds((const unsigned*)_kp, (LAS unsigned*)(lds + (buf) * 16384 + wbase), 16, 0, 0); \
    __builtin_amdgcn_global_load_lds((const unsigned*)(_kp + 8192), (LAS unsigned*)(lds + (buf) * 16384 + 8192 + wbase), 16, 0, 0); \
    __builtin_amdgcn_global_load_lds((const unsigned*)_vp, (LAS unsigned*)(lds + 32768 + (buf) * 16384 + wbase), 16, 0, 0); \
    __builtin_amdgcn_global_load_lds((const unsigned*)(_vp + 8192), (LAS unsigned*)(lds + 32768 + (buf) * 16384 + 8192 + wbase), 16, 0, 0); } while (0)
#define ATT_SYNC() do { asm volatile("s_waitcnt vmcnt(0)" ::: "memory"); __syncthreads(); } while (0)
#define ATT_QK(buf) do { _Pragma("unroll") for (int _kh = 0; _kh < 2; ++_kh) { _Pragma("unroll") for (int _r = 0; _r < 16; ++_r) sacc[_kh][_r] = 0.f; \
    _Pragma("unroll") for (int _s = 0; _s < 8; ++_s) { const bf16x8 _a = *(const LAS bf16x8*)(lds + (buf) * 16384 + _kh * 8192 + kbase_l + (((2 * _s) ^ kx) << 4)); \
        sacc[_kh] = ATT_MFMA(_a, qf[_s], sacc[_kh]); } } } while (0)
#define ATT_MASK(lo_rel, hi_rel, bit) do { const bool _none = !(bit) || (hi_rel) < 0 || (lo_rel) > 63; const bool _full = (bit) && (lo_rel) <= 0 && (hi_rel) >= 63; \
    if (__all(_none || _full)) { const float _bias = _none ? -INFINITY : 0.f; \
        _Pragma("unroll") for (int _kh = 0; _kh < 2; ++_kh) _Pragma("unroll") for (int _r = 0; _r < 16; ++_r) sacc[_kh][_r] = __builtin_fmaf(sacc[_kh][_r], ATT_C, _bias); } \
    else { _Pragma("unroll") for (int _kh = 0; _kh < 2; ++_kh) _Pragma("unroll") for (int _r = 0; _r < 16; ++_r) { const int _k = 32 * _kh + (_r & 3) + 8 * (_r >> 2) + 4 * h; \
        const bool _ok = (bit) && _k >= (lo_rel) && _k <= (hi_rel); sacc[_kh][_r] = _ok ? sacc[_kh][_r] * ATT_C : -INFINITY; } } } while (0)
#define ATT_TILEMAX(mt) do { float _m = sacc[0][0]; _Pragma("unroll") for (int _r = 1; _r < 16; ++_r) _m = fmaxf(_m, sacc[0][_r]); \
    _Pragma("unroll") for (int _r = 0; _r < 16; ++_r) _m = fmaxf(_m, sacc[1][_r]); mt = fmaxf(_m, __shfl_xor(_m, 32)); } while (0)
#define ATT_PV(buf) do { _Pragma("unroll") for (int _kh = 0; _kh < 2; ++_kh) _Pragma("unroll") for (int _s = 0; _s < 2; ++_s) { \
    u32x4 _p; _p.x = pk2(sacc[_kh][8 * _s + 0], sacc[_kh][8 * _s + 1]); _p.y = pk2(sacc[_kh][8 * _s + 2], sacc[_kh][8 * _s + 3]); \
    _p.z = pk2(sacc[_kh][8 * _s + 4], sacc[_kh][8 * _s + 5]); _p.w = pk2(sacc[_kh][8 * _s + 6], sacc[_kh][8 * _s + 7]); const bf16x8 _pf = __builtin_bit_cast(bf16x8, _p); \
    _Pragma("unroll") for (int _db = 0; _db < 4; ++_db) { const LAS unsigned char* _vp = lds + 32768 + (buf) * 16384 + vbase_l + (8 * _kh + 4 * _s) * 1024 + _db * 256; \
        const u32x2 _v0 = *(const LAS u32x2*)_vp, _v1 = *(const LAS u32x2*)(_vp + 2048); u32x4 _v; _v.x = _v0.x; _v.y = _v0.y; _v.z = _v1.x; _v.w = _v1.y; \
        oacc[_db] = ATT_MFMA(__builtin_bit_cast(bf16x8, _v), _pf, oacc[_db]); } } } while (0)

#define ATT_DMA_KV(j, kb, vb) do { const char* _kp = (const char*)kt + (size_t)(j) * 16384 + so; const char* _vp = (const char*)vt + (size_t)(j) * 16384 + so; \
    __builtin_amdgcn_global_load_lds((const unsigned*)_kp, (LAS unsigned*)(lds + (kb) * 16384 + wbase), 16, 0, 0); \
    __builtin_amdgcn_global_load_lds((const unsigned*)(_kp + 8192), (LAS unsigned*)(lds + (kb) * 16384 + 8192 + wbase), 16, 0, 0); \
    __builtin_amdgcn_global_load_lds((const unsigned*)_vp, (LAS unsigned*)(lds + 32768 + (vb) * 16384 + wbase), 16, 0, 0); \
    __builtin_amdgcn_global_load_lds((const unsigned*)(_vp + 8192), (LAS unsigned*)(lds + 32768 + (vb) * 16384 + 8192 + wbase), 16, 0, 0); } while (0)
#define ATT_DMA_KV3(j, st) do { const char* _kp = (const char*)kt + (size_t)(j) * 16384 + so; const char* _vp = (const char*)vt + (size_t)(j) * 16384 + so; \
    __builtin_amdgcn_global_load_lds((const unsigned*)_kp, (LAS unsigned*)(lds + (st) * 16384 + wbase), 16, 0, 0); \
    __builtin_amdgcn_global_load_lds((const unsigned*)(_kp + 8192), (LAS unsigned*)(lds + (st) * 16384 + 8192 + wbase), 16, 0, 0); \
    __builtin_amdgcn_global_load_lds((const unsigned*)_vp, (LAS unsigned*)(lds + 49152 + (st) * 16384 + wbase), 16, 0, 0); \
    __builtin_amdgcn_global_load_lds((const unsigned*)(_vp + 8192), (LAS unsigned*)(lds + 49152 + (st) * 16384 + 8192 + wbase), 16, 0, 0); } while (0)
#define ATT_QK3(buf) ATT_QK(buf)
#define ATT_PVP3(vb) do { _Pragma("unroll") for (int _ks = 0; _ks < 4; ++_ks) _Pragma("unroll") for (int _db = 0; _db < 4; ++_db) { const LAS unsigned char* _vp = lds + 49152 + (vb) * 16384 + vbase_l + (4 * _ks) * 1024 + _db * 256; \
        const u32x2 _v0 = *(const LAS u32x2*)_vp, _v1 = *(const LAS u32x2*)(_vp + 2048); u32x4 _v; _v.x = _v0.x; _v.y = _v0.y; _v.z = _v1.x; _v.w = _v1.y; \
        oacc[_db] = ATT_MFMA(__builtin_bit_cast(bf16x8, _v), pf[_ks], oacc[_db]); } } while (0)
#define ATT_PACKP() do { _Pragma("unroll") for (int _kh = 0; _kh < 2; ++_kh) _Pragma("unroll") for (int _s = 0; _s < 2; ++_s) { u32x4 _p; _p.x = pk2(sacc[_kh][8 * _s + 0], sacc[_kh][8 * _s + 1]); _p.y = pk2(sacc[_kh][8 * _s + 2], sacc[_kh][8 * _s + 3]); \
    _p.z = pk2(sacc[_kh][8 * _s + 4], sacc[_kh][8 * _s + 5]); _p.w = pk2(sacc[_kh][8 * _s + 6], sacc[_kh][8 * _s + 7]); pf[2 * _kh + _s] = __builtin_bit_cast(bf16x8, _p); } } while (0)
#define ATT_PVP(vb) do { _Pragma("unroll") for (int _ks = 0; _ks < 4; ++_ks) _Pragma("unroll") for (int _db = 0; _db < 4; ++_db) { const LAS unsigned char* _vp = lds + 32768 + (vb) * 16384 + vbase_l + (4 * _ks) * 1024 + _db * 256; \
        const u32x2 _v0 = *(const LAS u32x2*)_vp, _v1 = *(const LAS u32x2*)(_vp + 2048); u32x4 _v; _v.x = _v0.x; _v.y = _v0.y; _v.z = _v1.x; _v.w = _v1.y; \
        oacc[_db] = ATT_MFMA(__builtin_bit_cast(bf16x8, _v), pf[_ks], oacc[_db]); } } while (0)
template <int MODE, bool SKEW>
__device__ __forceinline__ void attn_item(LAS unsigned char* lds, const bf16* qrow, const bf16* kt, const bf16* vt, u64 mask, int tq, int W, int tile_lo, int tile_hi,
                                          void* o0, const bf16* o1, const bf16* o2, float g0, float g1, float g2) {
    int tid = threadIdx.x; asm volatile("" : "+v"(tid));
    const int lane = tid & 63, r32 = lane & 31, h = lane >> 5;
    const unsigned so = (unsigned)tid * 16u;
    const unsigned kbase_l = (unsigned)r32 * 256u, kx = (unsigned)(h ^ (lane & 15)), vbase_l = (unsigned)(h * 1024 + r32 * 8);
    bf16x8 qf[8];
#pragma unroll
    for (int s = 0; s < 8; ++s) qf[s] = *(const bf16x8*)(qrow + 16 * s + 8 * h);
    f32x16 oacc[4], sacc[2]; bf16x8 pf[4];
#pragma unroll
    for (int d = 0; d < 4; ++d)
#pragma unroll
        for (int r = 0; r < 16; ++r) oacc[d][r] = 0.f;
    float m_run = 0.f, l_run = 0.f;
    const int khi = tq, klo = (tq - W + 1) > 0 ? (tq - W + 1) : 0;
    const int wv_ = __builtin_amdgcn_readfirstlane(tid >> 6);
    const unsigned wbase = (unsigned)wv_ * 1024u;
    if (SKEW) { ATT_DMA_KV3(tile_lo, 0); if (tile_lo + 1 < tile_hi) { ATT_DMA_KV3(tile_lo + 1, 1); asm volatile("s_waitcnt vmcnt(4)" ::: "memory"); } else asm volatile("s_waitcnt vmcnt(0)" ::: "memory"); __builtin_amdgcn_s_barrier(); asm volatile("" ::: "memory"); }
    else { ATT_DMA_KV(tile_lo, 0, 0); ATT_SYNC(); }
    int kb = 0, vb = 0;
    for (int j = tile_lo; j < tile_hi; ++j) {
        const int kbn = SKEW ? (kb == 2 ? 0 : kb + 1) : (kb ^ 1), vbn = kbn;
        if (SKEW) { if (j + 2 < tile_hi) ATT_DMA_KV3(j + 2, (kbn == 2 ? 0 : kbn + 1)); }
        else { if (j + 1 < tile_hi) ATT_DMA_KV(j + 1, kbn, vbn); }
        const bool bit = (mask >> j) & 1ull;
        const int lo_rel = klo - 64 * j, hi_rel = khi - 64 * j;
        const bool none = !bit || hi_rel < 0 || lo_rel > 63;
        if (!__all(none)) {
            if (SKEW) { ATT_QK3(kb); } else { ATT_QK(kb); }
            float ls = 0.f;
            if (((j - tile_lo) & 3) == 0) {
                ATT_MASK(lo_rel, hi_rel, bit);
                float mt; ATT_TILEMAX(mt); const bool upd = mt > m_run + 8.0f;
                if (__any(upd)) {
                    const float m_new = upd ? mt : m_run, alpha = __builtin_amdgcn_exp2f(m_run - m_new);
                    l_run *= alpha; m_run = m_new;
#pragma unroll
                    for (int d = 0; d < 4; ++d)
#pragma unroll
                        for (int r = 0; r < 16; ++r) oacc[d][r] *= alpha;
                }
#pragma unroll
                for (int kh = 0; kh < 2; ++kh)
#pragma unroll
                    for (int r = 0; r < 16; ++r) { const float p = __builtin_amdgcn_exp2f(sacc[kh][r] - m_run); sacc[kh][r] = p; ls += p; }
            } else {
                const bool full_ = bit && lo_rel <= 0 && hi_rel >= 63;
                if (__all(none || full_)) { const float bm = none ? -INFINITY : -m_run;
#pragma unroll
                    for (int kh = 0; kh < 2; ++kh)
#pragma unroll
                        for (int r = 0; r < 16; ++r) { const float p = __builtin_amdgcn_exp2f(__builtin_fmaf(sacc[kh][r], ATT_C, bm)); sacc[kh][r] = p; ls += p; } }
                else {
#pragma unroll
                    for (int kh = 0; kh < 2; ++kh)
#pragma unroll
                        for (int r = 0; r < 16; ++r) { const int k_ = 32 * kh + (r & 3) + 8 * (r >> 2) + 4 * h; const bool ok_ = bit && k_ >= lo_rel && k_ <= hi_rel;
                            const float p = ok_ ? __builtin_amdgcn_exp2f(__builtin_fmaf(sacc[kh][r], ATT_C, -m_run)) : 0.f; sacc[kh][r] = p; ls += p; } }
            }
            l_run += ls;
            ATT_PACKP();
            if (SKEW) { ATT_PVP3(vb); } else { ATT_PVP(vb); }
        }
        if (SKEW) { if (j + 2 < tile_hi) asm volatile("s_waitcnt vmcnt(4) lgkmcnt(0)" ::: "memory"); else asm volatile("s_waitcnt vmcnt(0) lgkmcnt(0)" ::: "memory"); __builtin_amdgcn_s_barrier(); asm volatile("" ::: "memory"); }
        else ATT_SYNC();
        kb = kbn; vb = vbn;
    }
    const float l_tot = l_run + __shfl_xor(l_run, 32);
    const float inv = l_tot > 0.f ? 1.0f / l_tot : 0.f;
#pragma unroll
    for (int db = 0; db < 4; ++db) { unsigned pc[4][2]; u32x2 aw4[4], cw4[4];
        if (MODE == 2) {
#pragma unroll
            for (int i = 0; i < 2; ++i) { const u32x4 wa = *(const u32x4*)((const bf16*)o1 + 32 * db + 16 * h + 8 * i), wc = *(const u32x4*)((const bf16*)o2 + 32 * db + 16 * h + 8 * i);
                const auto a0 = __builtin_amdgcn_permlane32_swap(wa.x, wa.z, false, false), a1 = __builtin_amdgcn_permlane32_swap(wa.y, wa.w, false, false);
                const auto c0 = __builtin_amdgcn_permlane32_swap(wc.x, wc.z, false, false), c1 = __builtin_amdgcn_permlane32_swap(wc.y, wc.w, false, false);
                aw4[i].x = a0[0]; aw4[i].y = a1[0]; aw4[i + 2].x = a0[1]; aw4[i + 2].y = a1[1]; cw4[i].x = c0[0]; cw4[i].y = c1[0]; cw4[i + 2].x = c0[1]; cw4[i + 2].y = c1[1]; } }
#pragma unroll
        for (int i4 = 0; i4 < 4; ++i4) {
            const int d = 32 * db + 8 * i4 + 4 * h; (void)d;
            f32x4 v = {oacc[db][4 * i4] * inv, oacc[db][4 * i4 + 1] * inv, oacc[db][4 * i4 + 2] * inv, oacc[db][4 * i4 + 3] * inv};
            if (MODE == 0) { pc[i4][0] = pk2(v[0], v[1]); pc[i4][1] = pk2(v[2], v[3]); }
            else {
                if (MODE == 2) { const u32x2 aw = aw4[i4], cw = cw4[i4];
                    const f32x4 a = {bf2f(aw.x & 0xffff), bf2f(aw.x >> 16), bf2f(aw.y & 0xffff), bf2f(aw.y >> 16)}, c = {bf2f(cw.x & 0xffff), bf2f(cw.x >> 16), bf2f(cw.y & 0xffff), bf2f(cw.y >> 16)}; v = a * g0 + v * g1 + c * g2; }
                v = v * A8_SCALE; pc[i4][0] = pk4_fp8(v[0], v[1], v[2], v[3]); pc[i4][1] = 0u;
            }
        }
        if (MODE == 0) {
#pragma unroll
            for (int i = 0; i < 2; ++i) { const auto s0 = __builtin_amdgcn_permlane32_swap(pc[i][0], pc[i + 2][0], false, false), s1 = __builtin_amdgcn_permlane32_swap(pc[i][1], pc[i + 2][1], false, false);
                u32x4 w; w.x = s0[0]; w.y = s1[0]; w.z = s0[1]; w.w = s1[1]; *(u32x4*)((bf16*)o0 + 32 * db + 16 * h + 8 * i) = w; }
        } else { const auto s0 = __builtin_amdgcn_permlane32_swap(pc[0][0], pc[2][0], false, false), s1 = __builtin_amdgcn_permlane32_swap(pc[1][0], pc[3][0], false, false);
            u32x4 w; w.x = s0[0]; w.y = s0[1]; w.z = s1[0]; w.w = s1[1]; *(u32x4*)((unsigned char*)o0 + 32 * db + 16 * h) = w; }
    }
}

__device__ __forceinline__ void cmp_item(LAS unsigned char* lds, unsigned char* ws, int bg, int qc) {
    int tid = threadIdx.x; asm volatile("" : "+v"(tid));
    const int lane = tid & 63, wv = tid >> 6, r32 = lane & 31, h = lane >> 5;
    const int b = bg >> 1, g = bg & 1, head = r32 >> 3, qi = 8 * wv + (r32 & 7), tq = qc * 64 + qi;
    const unsigned so = (unsigned)tid * 16u;
    const unsigned kbase_l = (unsigned)r32 * 256u, kx = (unsigned)(h ^ (lane & 15)), vbase_l = (unsigned)(h * 1024 + r32 * 8);
    const bf16* qrow = (const bf16*)(ws + WS_QN) + (((size_t)b * 8 + g * 4 + head) * S + tq) * HD;
    const bf16* kt = (const bf16*)(ws + WS_KC) + (size_t)bg * 4 * 8192;
    const bf16* vt = (const bf16*)(ws + WS_VC) + (size_t)bg * 4 * 8192;
    LAS float* impA = (LAS float*)(lds + 65536);
    LAS float* impB = (LAS float*)(lds + 65536 + 16384);
    f32x16 oacc[4], sacc[2];
#define CMP_LOADQ() bf16x8 qf[8]; { const bf16* _qp = qrow; asm volatile("" : "+v"(_qp)); _Pragma("unroll") for (int _s = 0; _s < 8; ++_s) qf[_s] = *(const bf16x8*)(_qp + 16 * _s + 8 * h); }
#pragma unroll
    for (int d = 0; d < 4; ++d)
#pragma unroll
        for (int r = 0; r < 16; ++r) oacc[d][r] = 0.f;
    const int khi = (tq - 31) >> 4;
    const int nmax = (qc * 64 + 63 - 31) >> 4;
    const int ntile = nmax < 0 ? 0 : (nmax >> 6) + 1;
    for (int i = tid; i < 8192; i += NTHREADS) impA[i] = 0.f;
    float m_run = -1e30f, l_run = 0.f;
    const unsigned wbase = (unsigned)__builtin_amdgcn_readfirstlane(tid >> 6) * 1024u;
    if (ntile > 0) {
        ATT_DMA(0, 0);
        { CMP_LOADQ();
        ATT_SYNC();
        for (int j = 0; j < ntile; ++j) {
            const int cur = j & 1;
            if (j + 1 < ntile) ATT_DMA(j + 1, cur ^ 1);
            const int hi_rel = khi - 64 * j;
            ATT_QK(cur);
            ATT_MASK(0, hi_rel, true);
            float mt; ATT_TILEMAX(mt);
            const float m_new = fmaxf(m_run, mt);
            float ls = 0.f;
#pragma unroll
            for (int kh = 0; kh < 2; ++kh)
#pragma unroll
                for (int r = 0; r < 16; ++r) ls += __builtin_amdgcn_exp2f(sacc[kh][r] - m_new);
            l_run = l_run * __builtin_amdgcn_exp2f(m_run - m_new) + ls; m_run = m_new;
            ATT_SYNC();
        } }
        const float l_tot = l_run + __shfl_xor(l_run, 32);
        const float inv = l_tot > 0.f ? 1.0f / l_tot : 0.f;
        ATT_DMA(0, 0);
        { CMP_LOADQ();
        ATT_SYNC();
        for (int j = 0; j < ntile; ++j) {
            const int cur = j & 1;
            if (j + 1 < ntile) ATT_DMA(j + 1, cur ^ 1);
            const int hi_rel = khi - 64 * j;
            ATT_QK(cur);
            ATT_MASK(0, hi_rel, true);
#pragma unroll
            for (int kh = 0; kh < 2; ++kh)
#pragma unroll
                for (int r = 0; r < 16; ++r) sacc[kh][r] = __builtin_amdgcn_exp2f(sacc[kh][r] - m_run) * inv;
#pragma unroll
            for (int kh = 0; kh < 2; ++kh)
#pragma unroll
                for (int i4 = 0; i4 < 4; ++i4) {
                    float a = sacc[kh][4 * i4] + sacc[kh][4 * i4 + 1] + sacc[kh][4 * i4 + 2] + 0.5f * sacc[kh][4 * i4 + 3], bb = 0.5f * sacc[kh][4 * i4 + 3];
                    a += __shfl_xor(a, 8); a += __shfl_xor(a, 16); bb += __shfl_xor(bb, 8); bb += __shfl_xor(bb, 16);
                    if (head == 0) { const int jj = 16 * j + 8 * kh + 2 * i4 + h; impA[qi * 64 + jj] = a; impB[qi * 64 + jj] = bb; }
                }
            ATT_SYNC();
        } }
#pragma unroll
        for (int d = 0; d < 4; ++d)
#pragma unroll
            for (int r = 0; r < 16; ++r) oacc[d][r] = 0.f;
        ATT_DMA(0, 0);
        ATT_SYNC();
        for (int j = 0; j < ntile; ++j) {
            const int cur = j & 1;
            if (j + 1 < ntile) ATT_DMA(j + 1, cur ^ 1);
            const int hi_rel = khi - 64 * j;
            { CMP_LOADQ(); ATT_QK(cur); }
            ATT_MASK(0, hi_rel, true);
#pragma unroll
            for (int kh = 0; kh < 2; ++kh)
#pragma unroll
                for (int r = 0; r < 16; ++r) sacc[kh][r] = __builtin_amdgcn_exp2f(sacc[kh][r] - m_run) * inv;
            ATT_PV(cur);
            ATT_SYNC();
        }
    }
    {
        bf16* orow = (bf16*)(ws + WS_OCMP) + ((size_t)b * S + tq) * 1024 + (g * 4 + head) * HD;
#pragma unroll
        for (int db = 0; db < 4; ++db) { unsigned pc[4][2];
#pragma unroll
            for (int i4 = 0; i4 < 4; ++i4) { pc[i4][0] = pk2(oacc[db][4 * i4], oacc[db][4 * i4 + 1]); pc[i4][1] = pk2(oacc[db][4 * i4 + 2], oacc[db][4 * i4 + 3]); }
#pragma unroll
            for (int i = 0; i < 2; ++i) { const auto s0 = __builtin_amdgcn_permlane32_swap(pc[i][0], pc[i + 2][0], false, false), s1 = __builtin_amdgcn_permlane32_swap(pc[i][1], pc[i + 2][1], false, false);
                u32x4 w; w.x = s0[0]; w.y = s1[0]; w.z = s0[1]; w.w = s1[1]; *(u32x4*)(orow + 32 * db + 16 * h + 8 * i) = w; } }
    }
    __syncthreads();
    {
        const int q = tid >> 3, jg = tid & 7, cur = qc;
        float sc[8];
#pragma unroll
        for (int i = 0; i < 8; ++i) { const int jj = 8 * jg + i; const float v = impA[q * 64 + jj] + (jj > 0 ? impB[q * 64 + jj - 1] : 0.f);
            const bool valid = jj <= cur, forced = (jj == 0) || (jj == cur) || (jj == cur - 1); sc[i] = forced ? 1e9f : (valid ? v : -1e9f); }
        __syncthreads();
#pragma unroll
        for (int i = 0; i < 8; ++i) impA[q * 64 + 8 * jg + i] = sc[i];
        __syncthreads();
        int rank[8];
#pragma unroll
        for (int i = 0; i < 8; ++i) rank[i] = 0;
#pragma unroll 2
        for (int jp = 0; jp < 64; ++jp) { const float v = impA[q * 64 + jp];
#pragma unroll
            for (int i = 0; i < 8; ++i) rank[i] += (v > sc[i] || (v == sc[i] && jp < 8 * jg + i)) ? 1 : 0; }
        unsigned bits = 0;
#pragma unroll
        for (int i = 0; i < 8; ++i) bits |= (rank[i] < 16 && sc[i] > -0.5e9f) ? (1u << i) : 0u;
        unsigned lo = jg < 4 ? (bits << (8 * jg)) : 0u, hi2 = jg >= 4 ? (bits << (8 * (jg - 4))) : 0u;
        lo |= __shfl_xor(lo, 1); lo |= __shfl_xor(lo, 2); lo |= __shfl_xor(lo, 4); hi2 |= __shfl_xor(hi2, 1); hi2 |= __shfl_xor(hi2, 2); hi2 |= __shfl_xor(hi2, 4);
        if (jg == 0) ((u64*)(ws + WS_MSEL))[(size_t)bg * S + qc * 64 + q] = ((u64)hi2 << 32) | lo;
    }
    __syncthreads();
}

struct SchedOne { Unit u; bool has; __device__ __forceinline__ bool next(int i, Unit& o) const { if (i == 0 && has) { o = u; return true; } return false; } };
struct EpiHid {
    static constexpr bool PERM = false; float* dst;
    __device__ __forceinline__ void operator()(const f32x4 (&acc)[2][2][4][2], const Unit& u, int wr, int wc, int fr, int fq) const {
#pragma unroll
        for (int ai = 0; ai < 2; ++ai)
#pragma unroll
            for (int m = 0; m < 4; ++m) { float* rp = dst + (size_t)(ai * 128 + wr * 64 + m * 16 + fr) * 256 + wc * 32 + 4 * fq;
#pragma unroll
                for (int bj = 0; bj < 2; ++bj)
#pragma unroll
                    for (int n = 0; n < 2; ++n) *(f32x4*)(rp + bj * 128 + n * 16) = acc[ai][bj][m][n]; }
    }
};
struct EpiProj {
    static constexpr bool PERM = true; unsigned char* ws;
    __device__ __forceinline__ void operator()(const f32x4 (&acc)[2][2][4][2], const Unit& u, int wr, int wc, int fr, int fq) const {
#pragma unroll
        for (int ai = 0; ai < 2; ++ai) { u32x2 gw[4][2]; u32x4 pw[4][2];
#pragma unroll
            for (int m = 0; m < 4; ++m) { const int t = u.pm * 256 + ai * 128 + wr * 64 + m * 16 + fr;
#pragma unroll
                for (int bj = 0; bj < 2; ++bj) { const int c = u.pn * 256 + bj * 128 + wc * 32 + fq * 8;
                    gw[m][bj] = *(const u32x2*)(ws + WS_GM + (size_t)t * 4096 + u.kind * 2048 + c);
                    if (u.kind != 0) pw[m][bj] = *(const u32x4*)((const bf16*)(ws + WS_MIXP) + (size_t)t * D + c); } }
#pragma unroll
            for (int m = 0; m < 4; ++m) { const int t = u.pm * 256 + ai * 128 + wr * 64 + m * 16 + fr;
#pragma unroll
                for (int bj = 0; bj < 2; ++bj) { const int c = u.pn * 256 + bj * 128 + wc * 32 + fq * 8; const u32x2 g = gw[m][bj];
                    f32x4 g0 = {(float)(g.x & 0xff), (float)((g.x >> 8) & 0xff), (float)((g.x >> 16) & 0xff), (float)(g.x >> 24)}, g1 = {(float)(g.y & 0xff), (float)((g.y >> 8) & 0xff), (float)((g.y >> 16) & 0xff), (float)(g.y >> 24)};
                    constexpr float us = 1.0f / (W8_SCALE * A8_SCALE * 255.0f);
                    f32x4 v0 = acc[ai][bj][m][0] * us * g0, v1 = acc[ai][bj][m][1] * us * g1;
                    bf16* mp = (bf16*)(ws + WS_MIXP) + (size_t)t * D + c;
                    if (u.kind == 0) { u32x4 w; w.x = pk2(v0[0], v0[1]); w.y = pk2(v0[2], v0[3]); w.z = pk2(v1[0], v1[1]); w.w = pk2(v1[2], v1[3]); *(u32x4*)mp = w; }
                    else { const u32x4 q = pw[m][bj]; v0 += (f32x4){bf2f(q.x & 0xffff), bf2f(q.x >> 16), bf2f(q.y & 0xffff), bf2f(q.y >> 16)}; v1 += (f32x4){bf2f(q.z & 0xffff), bf2f(q.z >> 16), bf2f(q.w & 0xffff), bf2f(q.w >> 16)};
                        v0 = v0 * A8_SCALE; v1 = v1 * A8_SCALE; u32x2 w; w.x = pk4_fp8(v0[0], v0[1], v0[2], v0[3]); w.y = pk4_fp8(v1[0], v1[1], v1[2], v1[3]);
                        *(u32x2*)(ws + WS_MIX + (size_t)t * D + c) = w; } } } }
    }
};
struct SchedProj { int G, c; const char* oa; const char* ob; const char* wn; const char* wm;
    __device__ __forceinline__ bool next(int i, Unit& u) const { const int p = (i >> 1) * G + c; if (p >= 512) return false; tile_map(p, 64, 8, u.pm, u.pn); u.kind = i & 1;
        constexpr size_t ts = (size_t)256 * 1024; u.a = (u.kind ? ob : oa) + u.pm * ts; u.b = (u.kind ? wm : wn) + u.pn * ts; return true; } };
struct EpiOut {
    static constexpr bool PERM = true; const float* x; bf16* x1;
    __device__ __forceinline__ void operator()(const f32x4 (&acc)[2][2][4][2], const Unit& u, int wr, int wc, int fr, int fq) const {
#pragma unroll
        for (int ai = 0; ai < 2; ++ai) { f32x4 xv[4][2][2];
#pragma unroll
            for (int m = 0; m < 4; ++m) { const size_t ro = (size_t)(u.pm * 256 + ai * 128 + wr * 64 + m * 16 + fr) * D + u.pn * 256 + wc * 32 + 8 * fq;
#pragma unroll
                for (int bj = 0; bj < 2; ++bj) { xv[m][bj][0] = __builtin_nontemporal_load((const f32x4*)(x + ro + bj * 128)); xv[m][bj][1] = __builtin_nontemporal_load((const f32x4*)(x + ro + bj * 128 + 4)); } }
#pragma unroll
            for (int m = 0; m < 4; ++m) { const size_t ro = (size_t)(u.pm * 256 + ai * 128 + wr * 64 + m * 16 + fr) * D + u.pn * 256 + wc * 32 + 8 * fq;
#pragma unroll
                for (int bj = 0; bj < 2; ++bj) { constexpr float us = 1.0f / (W8_SCALE * A8_SCALE);
                    const f32x4 v0 = xv[m][bj][0] + acc[ai][bj][m][0] * us, v1 = xv[m][bj][1] + acc[ai][bj][m][1] * us;
                    u32x4 w; w.x = pk2(v0[0], v0[1]); w.y = pk2(v0[2], v0[3]); w.z = pk2(v1[0], v1[1]); w.w = pk2(v1[2], v1[3]);
                    *(u32x4*)(x1 + ro + bj * 128) = w; } } }
    }
};
struct SchedOut { int G, c; const char* a; const char* b;
    __device__ __forceinline__ bool next(int i, Unit& u) const { const int L = i * G + c; if (L >= 512) return false; tile_map(L, 64, 8, u.pm, u.pn); constexpr size_t ts = (size_t)256 * 2048;
        u.a = a + u.pm * ts; u.b = b + u.pn * ts; u.kind = 0; return true; } };
struct SchedMoe { int G, c, nN; const LAS int* offs; const char* A; const char* W; size_t wstride, ts;
    __device__ __forceinline__ bool next(int i, Unit& u) const { const int ntile = __builtin_amdgcn_readfirstlane(offs[NE]) >> 8, L = i * G + c; if (L >= ntile * nN) return false; tile_map(L, ntile, nN, u.pm, u.pn);
        int e = 0;
        for (int k = 1; k < NE; ++k) e = (__builtin_amdgcn_readfirstlane(offs[k]) <= u.pm * 256) ? k : e;
        u.kind = e; u.a = A + u.pm * ts; u.b = W + e * wstride + u.pn * ts; return true; } };
typedef _Float16 h2_t __attribute__((ext_vector_type(2)));
typedef short s2_t __attribute__((ext_vector_type(2)));
struct EpiAct {
    static constexpr bool PERM = true; const float* bgu; unsigned char* act;
    __device__ __forceinline__ void operator()(const f32x4 (&acc)[2][2][4][2], const Unit& u, int wr, int wc, int fr, int fq) const {
        const int c = u.pn * 128 + wc * 32 + fq * 8; const float* bp = bgu + (size_t)u.kind * 2 * FF + c;
        const f32x4 bg0 = *(const f32x4*)bp, bg1 = *(const f32x4*)(bp + 4), bl0 = *(const f32x4*)(bp + FF), bl1 = *(const f32x4*)(bp + FF + 4);
        h2_t bg[4], bl[4];
        bg[0] = (h2_t){(_Float16)bg0[0], (_Float16)bg0[1]}; bg[1] = (h2_t){(_Float16)bg0[2], (_Float16)bg0[3]}; bg[2] = (h2_t){(_Float16)bg1[0], (_Float16)bg1[1]}; bg[3] = (h2_t){(_Float16)bg1[2], (_Float16)bg1[3]};
        bl[0] = (h2_t){(_Float16)bl0[0], (_Float16)bl0[1]}; bl[1] = (h2_t){(_Float16)bl0[2], (_Float16)bl0[3]}; bl[2] = (h2_t){(_Float16)bl1[0], (_Float16)bl1[1]}; bl[3] = (h2_t){(_Float16)bl1[2], (_Float16)bl1[3]};
        const h2_t us = {(_Float16)(1.0f / W8_SCALE), (_Float16)(1.0f / W8_SCALE)}, seven = {(_Float16)7.0f, (_Float16)7.0f}, one = {(_Float16)1.0f, (_Float16)1.0f}, na = {(_Float16)(-1.702f * 1.4426950408889634f), (_Float16)(-1.702f * 1.4426950408889634f)};
#pragma unroll
        for (int ai = 0; ai < 2; ++ai)
#pragma unroll
            for (int m = 0; m < 4; ++m) { const size_t row = (size_t)u.pm * 256 + ai * 128 + wr * 64 + m * 16 + fr; h2_t a2[4];
#pragma unroll
                for (int p = 0; p < 4; ++p) { const f32x4 gv = acc[ai][0][m][p >> 1], lv = acc[ai][1][m][p >> 1];
                    h2_t g = __builtin_bit_cast(h2_t, __builtin_amdgcn_cvt_pkrtz(gv[2 * (p & 1)], gv[2 * (p & 1) + 1])), l = __builtin_bit_cast(h2_t, __builtin_amdgcn_cvt_pkrtz(lv[2 * (p & 1)], lv[2 * (p & 1) + 1]));
                    g = __builtin_elementwise_min(g * us + bg[p], seven); l = __builtin_elementwise_max(__builtin_elementwise_min(l * us + bl[p], seven), -seven);
                    const h2_t den = __builtin_elementwise_exp2(g * na) + one;
                    const h2_t sg = {(_Float16)__builtin_amdgcn_rcph(den[0]), (_Float16)__builtin_amdgcn_rcph(den[1])};
                    a2[p] = g * sg * (l + one); }
                s2_t w0 = {0, 0}, w1 = {0, 0};
                w0 = __builtin_amdgcn_cvt_scalef32_pk_fp8_f16(w0, a2[0], 1.0f, false); w0 = __builtin_amdgcn_cvt_scalef32_pk_fp8_f16(w0, a2[1], 1.0f, true);
                w1 = __builtin_amdgcn_cvt_scalef32_pk_fp8_f16(w1, a2[2], 1.0f, false); w1 = __builtin_amdgcn_cvt_scalef32_pk_fp8_f16(w1, a2[3], 1.0f, true);
                u32x2 w; w.x = __builtin_bit_cast(unsigned, w0); w.y = __builtin_bit_cast(unsigned, w1);
                *(u32x2*)(act + row * FF + c) = w; }
    }
};
struct EpiDown {
    static constexpr bool PERM = true; const float* bdn; const int* rowdst; const float* roww; unsigned char* ys; const LAS int* offs;
    __device__ __forceinline__ void operator()(const f32x4 (&acc)[2][2][4][2], const Unit& u, int wr, int wc, int fr, int fq) const {
        int dsts[2][4]; float ws_[2][4]; f32x4 bb[2][2];
#pragma unroll
        for (int ai = 0; ai < 2; ++ai)
#pragma unroll
            for (int m = 0; m < 4; ++m) { const int row = u.kind * T - offs[u.kind] + u.pm * 256 + ai * 128 + wr * 64 + m * 16 + fr; dsts[ai][m] = rowdst[row]; ws_[ai][m] = roww[row]; }
#pragma unroll
        for (int bj = 0; bj < 2; ++bj) { const float* bp = bdn + (size_t)u.kind * D + u.pn * 256 + bj * 128 + wc * 32 + fq * 8; bb[bj][0] = *(const f32x4*)bp; bb[bj][1] = *(const f32x4*)(bp + 4); }
#pragma unroll
        for (int ai = 0; ai < 2; ++ai)
#pragma unroll
            for (int m = 0; m < 4; ++m) { const int dst = dsts[ai][m]; const float w = ws_[ai][m] * YS_SCALE;
                if (dst >= 0) {
#pragma unroll
                    for (int bj = 0; bj < 2; ++bj) { const int c = u.pn * 256 + bj * 128 + wc * 32 + fq * 8;
                        constexpr float us = 1.0f / W8_SCALE;
                        const f32x4 v0 = (acc[ai][bj][m][0] * us + bb[bj][0]) * w, v1 = (acc[ai][bj][m][1] * us + bb[bj][1]) * w;
                        u32x2 o; o.x = pk4_fp8(v0[0], v0[1], v0[2], v0[3]); o.y = pk4_fp8(v1[0], v1[1], v1[2], v1[3]);
                        *(u32x2*)(ys + (size_t)dst * D + c) = o; } } }
    }
};
__device__ __forceinline__ float gelu_tanh_f(float x) { const float u = 0.7978845608028654f * (x + 0.044715f * x * x * x); const float e = __expf(2.0f * u); return 0.5f * x * (1.0f + (1.0f - 2.0f / (e + 1.0f))); }

__device__ __forceinline__ int queue_pop(volatile LAS unsigned* misc, unsigned* head) {
    __syncthreads();
    if (threadIdx.x == 0) misc[4] = __hip_atomic_fetch_add(head, 1u, __ATOMIC_RELAXED, __HIP_MEMORY_SCOPE_AGENT);
    __syncthreads();
    return (int)misc[4];
}
__device__ __forceinline__ int queue_pop_x(volatile LAS unsigned* misc, unsigned* qbase, int nper) {
    __syncthreads();
    if (threadIdx.x == 0) { int res = -1; const unsigned x0 = xb_xcc_id() & 7u;
        for (unsigned a = 0; a < 8u; ++a) { const unsigned xq = (x0 + a) & 7u; if (misc[5] & (1u << xq)) continue;
            const unsigned j = __hip_atomic_fetch_add(qbase + 64 * xq, 1u, __ATOMIC_RELAXED, __HIP_MEMORY_SCOPE_AGENT);
            if ((int)j < nper) { res = (int)(j * 8u + xq); break; } misc[5] = misc[5] | (1u << xq); }
        misc[4] = (unsigned)res; }
    __syncthreads();
    return (int)misc[4];
}
__device__ __forceinline__ void moe_offsets(volatile LAS unsigned* misc, const unsigned* counts) {
    __syncthreads();
    if (threadIdx.x < NE) misc[96 + threadIdx.x] = ((unsigned)__hip_atomic_load(counts + 64 * threadIdx.x, __ATOMIC_RELAXED, __HIP_MEMORY_SCOPE_AGENT) + 255u) / 256u * 256u;
    __syncthreads();
    if (threadIdx.x == 0) { unsigned o = 0; for (int e = 0; e < NE; ++e) { misc[16 + e] = o; o += misc[96 + e]; } misc[16 + NE] = o; }
    __syncthreads();
}

constexpr int NPHASE = 13;
__global__ void __launch_bounds__(NTHREADS, 2) fwd(Args args) {
    extern __shared__ __attribute__((aligned(16))) unsigned char lds_raw[];
    LAS unsigned char* lds = (LAS unsigned char*)lds_raw;
    volatile LAS unsigned* misc = (volatile LAS unsigned*)(lds + MISC_OFF);
    const int tid = threadIdx.x, lane = tid & 63, wave = __builtin_amdgcn_readfirstlane(tid >> 6);
    const int G = gridDim.x, blk = blockIdx.x, gw = blk * NWAVES + wave, NGW = G * NWAVES;
    unsigned char* ws = args.ws;
    unsigned* ctl = (unsigned*)(ws + WS_CTL);
    const float* x = args.in[0]; const int* positions = (const int*)args.in[1];
    for (int u = tid; u < 64; u += NTHREADS) misc[u] = 0u;
    __syncthreads();
    const int lo = args.ph_lo, hi = args.ph_hi;
    int cv_it = gw; constexpr int CV_P1 = 1 << 20;
    XcdBarrier bar; bar.bar = ctl + CW_BAR; bar.x = 0; bar.st = nullptr;
    if (hi - lo > 1) bar = xcd_barrier_post(ctl + CW_BAR, misc);
#ifndef FK_PHASE_MASK
#define FK_PHASE_MASK 0xFFFF
#endif
#define IN(k) (((FK_PHASE_MASK >> (k)) & 1) && lo <= (k) && (k) < hi)
#ifdef FK_TS
#define STAMP(k) do { if (blk == 0 && tid == 0) { const unsigned long long _t = __builtin_amdgcn_s_memrealtime(); misc[64 + 2 * (k)] = (unsigned)_t; misc[65 + 2 * (k)] = (unsigned)(_t >> 32); } } while (0)
#else
#define STAMP(k) do { } while (0)
#endif
#define SEAM(k) do { if (IN(k) && IN((k) + 1)) xcd_barrier(bar); STAMP((k) + 1); } while (0)

#ifdef FK_TS
    unsigned long long fk_pa = 0, fk_pb = 0;
#endif
    STAMP(0);
    if (IN(0)) {
        if (blk >= G - 16) { const int pb = blk - (G - 16);
            const int kv = pb >> 3, c = (pb & 7) * 32 + (tid & 31), ks = tid >> 5; const float* pe = args.in[kv ? 7 : 4]; const float* w1 = args.in[kv ? 8 : 5]; float a = 0.f;
            for (int k = ks * 256; k < ks * 256 + 256; k += 16) { float pv[16], wv[16];
#pragma unroll
                for (int i = 0; i < 16; ++i) { pv[i] = pe[k + i]; wv[i] = w1[(size_t)(k + i) * 256 + c]; }
#pragma unroll
                for (int i = 0; i < 16; ++i) a += pv[i] * wv[i]; }
            LAS float* red = (LAS float*)lds; red[tid] = a; __syncthreads();
            if (tid < 32) { float s2 = 0.f; for (int q = 0; q < 16; ++q) s2 += red[q * 32 + tid]; ((float*)(ws + WS_PEB))[kv * 256 + (pb & 7) * 32 + tid] = s2; }
            __syncthreads();
        }
        LAS float* scr = (LAS float*)(lds + wave * 16384);
        constexpr int I_IN = 16 * 305, I_K1 = 64 * 8, I_PN = 8 * 64, I_OUT = 16 * 64, I_GU = 16 * 128, I_DN = 16 * 64;
        constexpr int NIT = I_IN + 2 * I_K1 + 2 * I_PN + I_OUT;
        { const int nw = NGW - 16 * NWAVES, U = 4 * nw + 3 * 16 * NWAVES, us = gw < nw ? 4 * gw : 4 * nw + 3 * (gw - nw), ue = us + (gw < nw ? 4 : 3);
          const int it0 = (int)((long long)us * NIT / U), it1 = (int)((long long)ue * NIT / U);
          for (int it = it0; it < it1; ++it) { int r = it;
            if (r < I_IN) { conv_win_item(r, args.in[3], (unsigned char*)(ws + WS_WIN_T), scr, lane); continue; } r -= I_IN;
            if (r < I_K1) { transpose_item(args.in[5], 4096, 256, (bf16*)(ws + WS_WK1_T), RmIdent{0}, scr, r, lane); continue; } r -= I_K1;
            if (r < I_K1) { transpose_item(args.in[8], 4096, 256, (bf16*)(ws + WS_WV1_T), RmIdent{0}, scr, r, lane); continue; } r -= I_K1;
            if (r < I_PN) { conv_plain_item(r, args.in[10], 1024, D, (unsigned char*)(ws + WS_WPN_T), scr, lane); continue; } r -= I_PN;
            if (r < I_PN) { conv_plain_item(r, args.in[11], 1024, D, (unsigned char*)(ws + WS_WPM_T), scr, lane); continue; } r -= I_PN;
            conv_plain_item(r, args.in[12], D, D, (unsigned char*)(ws + WS_WOUT_T), scr, lane);
          } }
        for (int row = gw; row < T; row += NGW) {
            const f32x4* xr = (const f32x4*)(x + (size_t)row * D); f32x4 v[8]; float ss = 0.f;
#pragma unroll
            for (int i = 0; i < 8; ++i) { v[i] = xr[lane + 64 * i]; ss += v[i][0] * v[i][0] + v[i][1] * v[i][1] + v[i][2] * v[i][2] + v[i][3] * v[i][3]; }
            ss = wave_sum(ss); const float rs = rsqrtf(ss * (1.0f / D) + 1e-5f);
            unsigned* hr8 = (unsigned*)(ws + WS_H8 + (size_t)row * D);
#pragma unroll
            for (int i = 0; i < 8; ++i) { const f32x4 gg = ((const f32x4*)args.in[2])[lane + 64 * i]; const f32x4 o = v[i] * rs * gg; hr8[lane + 64 * i] = pk4_fp8(o[0], o[1], o[2], o[3]); }
        }
        for (int i = blk * NTHREADS + tid; i < NE * T; i += G * NTHREADS) ((int*)(ws + WS_ROWDST))[i] = -1;
        for (int i = blk * NTHREADS + tid; i < T * 16; i += G * NTHREADS) { const int t = i >> 4, f = i & 15; const float inv = powf(500000.0f, -(float)(2 * f) / 32.0f); const float ang = (float)positions[t] * inv;
            float* cs = (float*)(ws + WS_CS) + (size_t)t * 32; cs[f] = cosf(ang); cs[16 + f] = sinf(ang); }
    }
    SEAM(0);
    if (IN(1)) {
        EpiIn E{ws, (const float*)(ws + WS_CS)};
        const int gsplit = blk % 10;
        { SchedIn Sc{G, blk, (const char*)(ws + WS_H8), (const char*)(ws + WS_WIN_T), 0, gsplit}; gemm_phase<EpiIn, SchedIn, false, true>(lds, Gemm{D / 2, D / 2, D / 2}, Sc, E); }
        { LAS float* scr = (LAS float*)(lds + wave * 16384);
          { constexpr int NTOT = NE * (16 * 128 + 16 * 64); const int per = (NTOT + NGW - 1) / NGW;
            cv_it = moe_convert<true>(args.in[16], args.in[18], (unsigned char*)(ws + WS_WGU_T), (unsigned char*)(ws + WS_WDN_T), scr, gw * per, 1, lane, per); }
          __syncthreads(); }
        { SchedIn Sc{G, blk, (const char*)(ws + WS_H8), (const char*)(ws + WS_WIN_T), gsplit, 1 << 20}; gemm_phase<EpiIn, SchedIn, false, true>(lds, Gemm{D / 2, D / 2, D / 2}, Sc, E); }
    }
    SEAM(1);
    if (IN(2)) {
        {
#if defined(FK_TS) && defined(FK_EXP) && FK_EXP == 12
            fk_pa = __builtin_amdgcn_s_memrealtime();
#endif
            SchedOne Sc; Sc.has = blk < 64;
            const int kv = blk >> 5, pm = (blk & 31) >> 2, ks = blk & 3;
            Sc.u.a = (const char*)(ws + (kv ? WS_VCMP : WS_KCMP)) + ((size_t)pm * 256 * 2048 + ks * 1024) * 2; Sc.u.b = (const char*)(ws + (kv ? WS_WV1_T : WS_WK1_T)) + (size_t)ks * 1024 * 2; Sc.u.pm = pm; Sc.u.pn = 0; Sc.u.kind = 0;
            EpiHid E{(float*)(ws + WS_HIDP) + ((size_t)(kv * 4 + ks) * 2048 + pm * 256) * 256};
            gemm_phase<EpiHid, SchedOne>(lds, Gemm{1024, 2048, 4096}, Sc, E);
#if defined(FK_TS) && defined(FK_EXP) && FK_EXP == 12
            fk_pb = __builtin_amdgcn_s_memrealtime();
#endif
        }
#if defined(FK_TS) && defined(FK_EXP) && FK_EXP == 11
        for (int rep = 0; rep < 2; ++rep) { if (rep == 1) { xcd_barrier(bar); fk_pa = __builtin_amdgcn_s_memrealtime(); }
#else
        for (int rep = 0; rep < 1; ++rep) {
#endif
        if (tid == 0) misc[5] = 0u;
        for (;;) {
            const int itx = queue_pop_x(misc, ctl + CW_Q + 64 * 8, 128);
            if (itx < 0) break;
            const int it = (itx >> 3) < 64 ? itx : 512 + (itx - 512);
            if (it < 512) {
                const int bg = it & 7, qc = it >> 3, b = bg >> 1, g = bg & 1, head = g * 4 + (wave >> 1), tq = qc * 64 + (wave & 1) * 32 + (lane & 31);
                const bf16* qrow = (const bf16*)(ws + WS_QN) + (((size_t)b * 8 + head) * S + tq) * HD;
                bf16* orow = (bf16*)(ws + WS_OWIN) + ((size_t)b * S + tq) * 1024 + head * HD;
                attn_item<0, false>(lds, qrow, (const bf16*)(ws + WS_KWIN) + (size_t)bg * S * HD, (const bf16*)(ws + WS_VWIN) + (size_t)bg * S * HD, ~0ull, tq, 512, qc > 8 ? qc - 8 : 0, qc + 1, orow, nullptr, nullptr, 0.f, 0.f, 0.f);
            } else {
                const int id = it - 512, bh = id >> 4, nb = id & 15, p = tid & 15, kg = tid >> 4;
                const bf16* kb = (const bf16*)(ws + WS_MK) + ((size_t)bh * S + nb * 256) * HD; float a[8];
#pragma unroll
                for (int i = 0; i < 8; ++i) a[i] = 0.f;
                for (int kk = 0; kk < 8; ++kk) { const int key = kg * 8 + kk; const u32x4 w = *(const u32x4*)(kb + (size_t)key * HD + ((p ^ (key & 15)) * 8));
                    a[0] += bf2f(w.x & 0xffff); a[1] += bf2f(w.x >> 16); a[2] += bf2f(w.y & 0xffff); a[3] += bf2f(w.y >> 16); a[4] += bf2f(w.z & 0xffff); a[5] += bf2f(w.z >> 16); a[6] += bf2f(w.w & 0xffff); a[7] += bf2f(w.w >> 16); }
                LAS float* red = (LAS float*)lds;
#pragma unroll
                for (int i = 0; i < 8; ++i) red[kg * 128 + p * 8 + i] = a[i];
                __syncthreads();
                if (tid < 128) { float s = 0.f; for (int q = 0; q < 32; ++q) s += red[q * 128 + tid]; ((float*)(ws + WS_KMEAN))[((size_t)bh * 16 + nb) * HD + tid] = s * (1.0f / 256.0f); }
            }
        }
#if defined(FK_TS) && defined(FK_EXP) && FK_EXP == 11
        if (rep == 1) { xcd_barrier(bar); fk_pb = __builtin_amdgcn_s_memrealtime(); }
#endif
        }
    }
    SEAM(2);
    if (IN(3)) {
#if defined(FK_TS) && defined(FK_EXP) && (FK_EXP == 15)
        fk_pa = __builtin_amdgcn_s_memrealtime();
#endif
        for (int it = blk; it < 256; it += G) {
            __syncthreads();
            {
                const int kv = it >> 7, m0 = (it & 127) * 16;
                LAS float* hid = (LAS float*)lds;
                LAS float* outb = (LAS float*)(lds + 16384);
                const float* hp = (const float*)(ws + WS_HIDP) + (size_t)kv * 4 * 2048 * 256; const float* peb = (const float*)(ws + WS_PEB) + kv * 256;
                for (int i = tid; i < 16 * 256; i += NTHREADS) { const int r = i >> 8, c = i & 255; const size_t o = (size_t)(m0 + r) * 256 + c;
                    const float v = ((hp[o] + hp[o + 2048 * 256]) + (hp[o + 2 * 2048 * 256] + hp[o + 3 * 2048 * 256])) + peb[c]; hid[i] = gelu_tanh_f(v); }
                __syncthreads();
                {
                    const float* w2 = args.in[kv ? 9 : 6]; const int fe = lane & 15, q4 = lane >> 4; float wv[8][8];
#pragma unroll
                    for (int ks = 0; ks < 8; ++ks)
#pragma unroll
                        for (int i = 0; i < 8; ++i) wv[ks][i] = w2[(size_t)(32 * ks + 8 * q4 + i) * 128 + 16 * wave + fe];
                    f32x4 d = {0.f, 0.f, 0.f, 0.f};
#pragma unroll
                    for (int ks = 0; ks < 8; ++ks) { const f32x4 a0 = *(const LAS f32x4*)(hid + fe * 256 + 32 * ks + 8 * q4), a1 = *(const LAS f32x4*)(hid + fe * 256 + 32 * ks + 8 * q4 + 4);
                        u32x4 ah, al, bh, bl;
                        ah.x = pk2(a0[0], a0[1]); ah.y = pk2(a0[2], a0[3]); ah.z = pk2(a1[0], a1[1]); ah.w = pk2(a1[2], a1[3]);
                        al.x = pk2(a0[0] - bf2f(ah.x & 0xffff), a0[1] - bf2f(ah.x >> 16)); al.y = pk2(a0[2] - bf2f(ah.y & 0xffff), a0[3] - bf2f(ah.y >> 16));
                        al.z = pk2(a1[0] - bf2f(ah.z & 0xffff), a1[1] - bf2f(ah.z >> 16)); al.w = pk2(a1[2] - bf2f(ah.w & 0xffff), a1[3] - bf2f(ah.w >> 16));
                        bh.x = pk2(wv[ks][0], wv[ks][1]); bh.y = pk2(wv[ks][2], wv[ks][3]); bh.z = pk2(wv[ks][4], wv[ks][5]); bh.w = pk2(wv[ks][6], wv[ks][7]);
                        bl.x = pk2(wv[ks][0] - bf2f(bh.x & 0xffff), wv[ks][1] - bf2f(bh.x >> 16)); bl.y = pk2(wv[ks][2] - bf2f(bh.y & 0xffff), wv[ks][3] - bf2f(bh.y >> 16));
                        bl.z = pk2(wv[ks][4] - bf2f(bh.z & 0xffff), wv[ks][5] - bf2f(bh.z >> 16)); bl.w = pk2(wv[ks][6] - bf2f(bh.w & 0xffff), wv[ks][7] - bf2f(bh.w >> 16));
                        const bf16x8 xh = __builtin_bit_cast(bf16x8, ah), xl = __builtin_bit_cast(bf16x8, al), yh = __builtin_bit_cast(bf16x8, bh), yl = __builtin_bit_cast(bf16x8, bl);
                        d = __builtin_amdgcn_mfma_f32_16x16x32_bf16(xh, yh, d, 0, 0, 0); d = __builtin_amdgcn_mfma_f32_16x16x32_bf16(xh, yl, d, 0, 0, 0); d = __builtin_amdgcn_mfma_f32_16x16x32_bf16(xl, yh, d, 0, 0, 0); }
#pragma unroll
                    for (int r = 0; r < 4; ++r) outb[(4 * q4 + r) * 128 + 16 * wave + fe] = d[r]; }
                __syncthreads();
                const int bg = m0 >> 8, i0 = m0 & 255;
                if (kv == 0) {
                    if (tid < 256) { const int r = tid >> 4, p = tid & 15, i = i0 + r; float v[8];
#pragma unroll
                        for (int e = 0; e < 8; ++e) v[e] = outb[r * 128 + p * 8 + e];
                        if (p < 4) { int tk = 16 * i + 31; tk = tk < S ? tk : S - 1; const float* cs = (const float*)(ws + WS_CS) + ((size_t)(bg >> 1) * S + tk) * 32 + 8 * (p & 1);
#pragma unroll
                            for (int e = 0; e < 8; ++e) { const float o = outb[r * 128 + (p ^ 2) * 8 + e]; v[e] = p < 2 ? v[e] * cs[e] - o * cs[16 + e] : v[e] * cs[e] + o * cs[16 + e]; } }
                        u32x4 w; w.x = pk2(v[0], v[1]); w.y = pk2(v[2], v[3]); w.z = pk2(v[4], v[5]); w.w = pk2(v[6], v[7]);
                        *(u32x4*)((bf16*)(ws + WS_KC) + (size_t)bg * 4 * 8192 + (size_t)i * HD + ((p ^ (i & 15)) * 8)) = w; }
                } else {
                    const int qd = tid >> 7, d = tid & 127, i = i0 + 4 * qd;
                    u32x2 w; w.x = pk2(outb[(4 * qd) * 128 + d], outb[(4 * qd + 1) * 128 + d]); w.y = pk2(outb[(4 * qd + 2) * 128 + d], outb[(4 * qd + 3) * 128 + d]);
                    *(u32x2*)((bf16*)(ws + WS_VC) + (size_t)bg * 4 * 8192 + (size_t)(i >> 6) * 8192 + (((i & 63) >> 2) * 128 + d) * 4) = w;
                }
            }
        }
#if defined(FK_TS) && defined(FK_EXP) && (FK_EXP == 15)
        asm volatile("s_waitcnt vmcnt(0)" ::: "memory"); fk_pb = __builtin_amdgcn_s_memrealtime();
#endif
        for (int it = blk; it < 256; it += G) {
            const int bh = it >> 3, tbase = (it & 7) * 512 + 64 * wave, fe = lane & 15, q4 = lane >> 4;
            bf16x8 khi[4], klo[4];
#pragma unroll
            for (int ks = 0; ks < 4; ++ks) { const float* kp = (const float*)(ws + WS_KMEAN) + ((size_t)bh * 16 + fe) * HD + 32 * ks + 8 * q4; const f32x4 a = *(const f32x4*)kp, c = *(const f32x4*)(kp + 4);
                u32x4 h, l; h.x = pk2(a[0], a[1]); h.y = pk2(a[2], a[3]); h.z = pk2(c[0], c[1]); h.w = pk2(c[2], c[3]);
                l.x = pk2(a[0] - bf2f(h.x & 0xffff), a[1] - bf2f(h.x >> 16)); l.y = pk2(a[2] - bf2f(h.y & 0xffff), a[3] - bf2f(h.y >> 16));
                l.z = pk2(c[0] - bf2f(h.z & 0xffff), c[1] - bf2f(h.z >> 16)); l.w = pk2(c[2] - bf2f(h.w & 0xffff), c[3] - bf2f(h.w >> 16));
                khi[ks] = __builtin_bit_cast(bf16x8, h); klo[ks] = __builtin_bit_cast(bf16x8, l); }
#pragma unroll
            for (int rb = 0; rb < 4; ++rb) { const int t = tbase + 16 * rb + fe, own = t >> 8;
                const bf16* qr = (const bf16*)(ws + WS_MQ) + ((size_t)bh * S + t) * HD + 8 * q4; bf16x8 qa[4];
#pragma unroll
                for (int ks = 0; ks < 4; ++ks) qa[ks] = *(const bf16x8*)(qr + 32 * ks);
                f32x4 d = {0.f, 0.f, 0.f, 0.f};
#pragma unroll
                for (int ks = 0; ks < 4; ++ks) { d = __builtin_amdgcn_mfma_f32_16x16x32_bf16(khi[ks], qa[ks], d, 0, 0, 0); d = __builtin_amdgcn_mfma_f32_16x16x32_bf16(klo[ks], qa[ks], d, 0, 0, 0); }
                float g[4]; int rank[4];
#pragma unroll
                for (int r = 0; r < 4; ++r) { g[r] = (4 * q4 + r) < own ? d[r] : -1e9f; rank[r] = 0; }
#pragma unroll
                for (int r = 0; r < 4; ++r)
#pragma unroll
                    for (int rp = 0; rp < 4; ++rp) if (rp != r) rank[r] += (g[rp] > g[r] || (g[rp] == g[r] && rp < r)) ? 1 : 0;
#pragma unroll
                for (int xq = 1; xq < 4; ++xq)
#pragma unroll
                    for (int rp = 0; rp < 4; ++rp) { const float o = __shfl_xor(g[rp], 16 * xq); const int np = 4 * (q4 ^ xq) + rp;
#pragma unroll
                        for (int r = 0; r < 4; ++r) rank[r] += (o > g[r] || (o == g[r] && np < 4 * q4 + r)) ? 1 : 0; }
                unsigned mlo = 0u, mhi = 0u;
#pragma unroll
                for (int r = 0; r < 4; ++r) if (rank[r] < 3 && g[r] > -0.5e9f) { const unsigned nb = 0xFu << (4 * ((4 * q4 + r) & 7)); if (q4 < 2) mlo |= nb; else mhi |= nb; }
                mlo |= __shfl_xor(mlo, 16); mhi |= __shfl_xor(mhi, 16); mlo |= __shfl_xor(mlo, 32); mhi |= __shfl_xor(mhi, 32);
                if (q4 == 0) ((u64*)(ws + WS_MMOBA))[(size_t)bh * S + t] = (((u64)mhi << 32) | mlo) | (0xFull << (4 * own));
            }
        }
    }
    SEAM(3);
    if (IN(4)) {
        if (tid == 0) misc[5] = 0u;
        for (;;) {
            const int itx = queue_pop_x(misc, ctl + CW_Q + 64 * 16, 128);
            if (itx < 0) break;
            const int jq = itx >> 3, xq = itx & 7, it = jq < 64 ? (((jq >> 2) << 5) | ((jq & 3) * 8 + xq)) : 512 + (jq - 64) * 8 + xq;
            if (it < 512) {
                const int qb = 15 - (it >> 5), bh = it & 31, b = bh >> 3, head = bh & 7, tq = qb * 256 + wave * 32 + (lane & 31);
                const bf16* qrow = (const bf16*)(ws + WS_MQ) + ((size_t)bh * S + tq) * HD;
                const u64 mk = ((const u64*)(ws + WS_MMOBA))[(size_t)bh * S + tq];
                unsigned char* orow = (unsigned char*)(ws + WS_OB) + ((size_t)b * S + tq) * 1024 + head * HD;
                attn_item<1, false>(lds, qrow, (const bf16*)(ws + WS_MK) + (size_t)bh * S * HD, (const bf16*)(ws + WS_MV) + (size_t)bh * S * HD, mk, tq, 1 << 30, 0, 4 * (qb + 1), orow, nullptr, nullptr, 0.f, 0.f, 0.f);
            } else { const int id = it - 512; cmp_item(lds, ws, id & 7, 63 - (id >> 3)); }
        }
    }
    SEAM(4);
    if (IN(5)) {
        if (tid == 0) misc[5] = 0u;
        for (;;) {
            const int it = queue_pop_x(misc, ctl + CW_Q + 64 * 24, 64);
            if (it < 0) break;
            const int bg = it & 7, qc = 63 - (it >> 3), b = bg >> 1, g = bg & 1, head = g * 4 + (wave >> 1), tq = qc * 64 + (wave & 1) * 32 + (lane & 31);
            const size_t trow = (size_t)b * S + tq;
            const bf16* qrow = (const bf16*)(ws + WS_QN) + (((size_t)b * 8 + head) * S + tq) * HD;
            const u64 mk = ((const u64*)(ws + WS_MSEL))[(size_t)bg * S + tq];
            const float* gn = (const float*)(ws + WS_GN) + trow * 24;
            attn_item<2, false>(lds, qrow, (const bf16*)(ws + WS_KSLC) + (size_t)bg * S * HD, (const bf16*)(ws + WS_VSLC) + (size_t)bg * S * HD, mk, tq, 1 << 30, 0, qc + 1,
                         (unsigned char*)(ws + WS_OA) + trow * 1024 + head * HD, (const bf16*)(ws + WS_OCMP) + trow * 1024 + head * HD, (const bf16*)(ws + WS_OWIN) + trow * 1024 + head * HD, gn[head], gn[8 + head], gn[16 + head]);
        }
    }
    SEAM(5);
    if (IN(6)) {
        SchedProj Sc{G, blk, (const char*)(ws + WS_OA), (const char*)(ws + WS_OB), (const char*)(ws + WS_WPN_T), (const char*)(ws + WS_WPM_T)}; EpiProj E{ws};
        gemm_phase<EpiProj, SchedProj, false, true>(lds, Gemm{512, 512, 512}, Sc, E);
#if defined(FK_TS) && defined(FK_EXP) && FK_EXP == 8
        xcd_barrier(bar); STAMP(14);
        gemm_phase<EpiProj, SchedProj, false, true>(lds, Gemm{512, 512, 512}, Sc, E, nullptr, nullptr, true);
        xcd_barrier(bar); STAMP(15);
#endif
    }
    SEAM(6);
    if (IN(7)) {
        SchedOut Sc{G, blk, (const char*)(ws + WS_MIX), (const char*)(ws + WS_WOUT_T)}; EpiOut E{x, (bf16*)(ws + WS_X1)};
        gemm_phase<EpiOut, SchedOut, false, true>(lds, Gemm{D / 2, D / 2, D / 2}, Sc, E);
    }
    SEAM(7);
    if (IN(8)) {
        LAS float* part = (LAS float*)lds;
        LAS float* rsv = (LAS float*)(lds + 65536);
        LAS int* lcnt = (LAS int*)(lds + 65536 + 8192);
        LAS int* lbase = lcnt + 32;
        LAS int* lsel = lcnt + 64;
        LAS int* lidx = lcnt + 64 + 2048;
        LAS float* lwt = (LAS float*)(lcnt + 64 + 4096);
        if (tid < NE) lcnt[tid] = 0;
        const int tok0 = blk * 64, fe = lane & 15, kq = lane >> 4;
        { f32x4 gg8[8]; u32x2 vr[8];
#pragma unroll
          for (int i = 0; i < 8; ++i) gg8[i] = ((const f32x4*)args.in[13])[lane + 64 * i];
          { const u32x2* xr = (const u32x2*)((const bf16*)(ws + WS_X1) + (size_t)(tok0 + 8 * wave) * D);
#pragma unroll
            for (int i = 0; i < 8; ++i) vr[i] = xr[lane + 64 * i]; }
          for (int r = 0; r < 8; ++r) { const int tok = tok0 + 8 * wave + r; float ss = 0.f; f32x4 v[8];
              int ln = lane; asm volatile("" : "+v"(ln));
#pragma unroll
              for (int i = 0; i < 8; ++i) { v[i][0] = bf2f(vr[i].x & 0xffff); v[i][1] = bf2f(vr[i].x >> 16); v[i][2] = bf2f(vr[i].y & 0xffff); v[i][3] = bf2f(vr[i].y >> 16); }
              if (r + 1 < 8) { const u32x2* xr = (const u32x2*)((const bf16*)(ws + WS_X1) + (size_t)(tok + 1) * D);
#pragma unroll
                  for (int i = 0; i < 8; ++i) vr[i] = xr[ln + 64 * i]; }
#pragma unroll
              for (int i = 0; i < 8; ++i) ss += v[i][0] * v[i][0] + v[i][1] * v[i][1] + v[i][2] * v[i][2] + v[i][3] * v[i][3];
              ss = wave_sum(ss); const float rs = rsqrtf(ss * (1.0f / D) + 1e-5f);
              unsigned* hr = (unsigned*)(ws + WS_H8 + (size_t)tok * D);
#pragma unroll
              for (int i = 0; i < 8; ++i) { const f32x4 o = v[i] * rs * gg8[i]; hr[ln + 64 * i] = pk4_fp8(o[0], o[1], o[2], o[3]); }
              if (lane == 0) rsv[8 * wave + r] = rs; } }
        bf16x8 bhi[8][2], blo[8][2];
#pragma unroll
        for (int j = 0; j < 8; ++j) { const int k0 = 256 * wave + 64 * (j >> 1) + 16 * kq + 8 * (j & 1);
            const f32x4 g0 = *(const f32x4*)(args.in[13] + k0), g1 = *(const f32x4*)(args.in[13] + k0 + 4);
#pragma unroll
            for (int eb = 0; eb < 2; ++eb) { float v[8], r[8];
#pragma unroll
                for (int i = 0; i < 8; ++i) v[i] = args.in[14][(size_t)(k0 + i) * NE + 16 * eb + fe] * (i < 4 ? g0[i & 3] : g1[i & 3]);
                u32x4 h, l; h.x = pk2(v[0], v[1]); h.y = pk2(v[2], v[3]); h.z = pk2(v[4], v[5]); h.w = pk2(v[6], v[7]);
                r[0] = v[0] - bf2f(h.x & 0xffff); r[1] = v[1] - bf2f(h.x >> 16); r[2] = v[2] - bf2f(h.y & 0xffff); r[3] = v[3] - bf2f(h.y >> 16);
                r[4] = v[4] - bf2f(h.z & 0xffff); r[5] = v[5] - bf2f(h.z >> 16); r[6] = v[6] - bf2f(h.w & 0xffff); r[7] = v[7] - bf2f(h.w >> 16);
                l.x = pk2(r[0], r[1]); l.y = pk2(r[2], r[3]); l.z = pk2(r[4], r[5]); l.w = pk2(r[6], r[7]);
                bhi[j][eb] = __builtin_bit_cast(bf16x8, h); blo[j][eb] = __builtin_bit_cast(bf16x8, l); } }
        { f32x4 lacc[4][2];
#pragma unroll
          for (int rb = 0; rb < 4; ++rb)
#pragma unroll
              for (int eb = 0; eb < 2; ++eb) lacc[rb][eb] = (f32x4){0.f, 0.f, 0.f, 0.f};
#pragma unroll
          for (int rbp = 0; rbp < 2; ++rbp) { bf16x8 af[2][8];
#pragma unroll
              for (int rr = 0; rr < 2; ++rr)
#pragma unroll
                  for (int j = 0; j < 8; ++j) af[rr][j] = *(const bf16x8*)((const bf16*)(ws + WS_X1) + (size_t)(tok0 + 16 * (2 * rbp + rr) + fe) * D + 256 * wave + 64 * (j >> 1) + 16 * kq + 8 * (j & 1));
#pragma unroll
              for (int rr = 0; rr < 2; ++rr)
#pragma unroll
                  for (int j = 0; j < 8; ++j)
#pragma unroll
                      for (int eb = 0; eb < 2; ++eb) { lacc[2 * rbp + rr][eb] = __builtin_amdgcn_mfma_f32_16x16x32_bf16(af[rr][j], bhi[j][eb], lacc[2 * rbp + rr][eb], 0, 0, 0);
                          lacc[2 * rbp + rr][eb] = __builtin_amdgcn_mfma_f32_16x16x32_bf16(af[rr][j], blo[j][eb], lacc[2 * rbp + rr][eb], 0, 0, 0); } }
#pragma unroll
          for (int rb = 0; rb < 4; ++rb)
#pragma unroll
              for (int eb = 0; eb < 2; ++eb)
#pragma unroll
                  for (int i = 0; i < 4; ++i) part[(wave * 64 + 16 * rb + 4 * kq + i) * 32 + 16 * eb + fe] = lacc[rb][eb][i]; }
        __syncthreads();
#pragma unroll 1
        for (int q4 = 0; q4 < 4; ++q4) { const int tl = 16 * q4 + (tid >> 5), e = lane & 31, tok = tok0 + tl; float lg = 0.f;
#pragma unroll
            for (int w8 = 0; w8 < 8; ++w8) lg += part[(w8 * 64 + tl) * 32 + e];
            lg = lg * rsv[tl] + args.in[15][e];
            int rank = 0; float mx = lg;
#pragma unroll
            for (int ep = 0; ep < 32; ++ep) { const float o = __shfl(lg, (lane & 32) + ep); rank += (o > lg || (o == lg && ep < e)) ? 1 : 0; mx = fmaxf(mx, o); }
            const bool sel = rank < 4; const float ex = sel ? __expf(lg - mx) : 0.f; float sum = ex;
#pragma unroll
            for (int o = 1; o < 32; o <<= 1) sum += __shfl_xor(sum, o);
            if (sel) { const int slot = (tl << 2) + rank;
                lsel[slot] = e; lidx[slot] = (int)__hip_atomic_fetch_add((LAS unsigned*)lcnt + e, 1u, __ATOMIC_RELAXED, __HIP_MEMORY_SCOPE_WORKGROUP);
                lwt[slot] = ex / sum; } (void)tok; }
        __syncthreads();
        if (tid < NE) lbase[tid] = (int)__hip_atomic_fetch_add(ctl + CW_CNT + 64 * tid, (unsigned)lcnt[tid], __ATOMIC_RELAXED, __HIP_MEMORY_SCOPE_AGENT);
        __syncthreads();
        if (tid < 256) { const int e = lsel[tid], r = e * T + lbase[e] + lidx[tid];
            ((int*)(ws + WS_ROWDST))[r] = (tok0 + (tid >> 2)) * 4 + (tid & 3); ((float*)(ws + WS_ROWW))[r] = lwt[tid]; }
    }
    SEAM(8);
    STAMP(10);
    if (IN(10)) {
        moe_offsets(misc, ctl + CW_CNT);
        SchedMoe Sc{G, blk, 16, (const LAS int*)(misc + 16), (const char*)(ws + WS_H8), (const char*)(ws + WS_WGU_T), (size_t)4096 * 2048, (size_t)256 * 2048}; EpiAct E{args.in[17], (unsigned char*)(ws + WS_ACT)};
        LAS unsigned short* gtab = (LAS unsigned short*)(lds + MISC_OFF + 1024);
        { const int hs = tid >> 8, tl = tid & 255;
          for (int ui0 = 0; ui0 < 24; ui0 += 8) {
            Unit uu[4]; bool ok[4]; int vv[4];
#pragma unroll
            for (int q = 0; q < 4; ++q) { ok[q] = Sc.next(ui0 + 4 * hs + q, uu[q]); vv[q] = ok[q] ? ((const int*)(ws + WS_ROWDST))[uu[q].kind * T - (int)misc[16 + uu[q].kind] + uu[q].pm * 256 + tl] : 0; }
#pragma unroll
            for (int q = 0; q < 4; ++q) if (ok[q]) gtab[(ui0 + 4 * hs + q) * 256 + tl] = (unsigned short)(vv[q] < 0 ? 0 : (vv[q] >> 2));
            Unit ulast; if (!Sc.next(ui0 + 7, ulast)) break; } }
        __syncthreads();
        gemm_phase<EpiAct, SchedMoe, true, true>(lds, Gemm{D / 2, D / 2, D / 2}, Sc, E, (const char*)(ws + WS_H8), gtab);
#if defined(FK_TS) && defined(FK_EXP) && FK_EXP != 8
        xcd_barrier(bar); STAMP(14);
#if FK_EXP == 1
        gemm_phase<EpiAct, SchedMoe, true, true>(lds, Gemm{D / 2, D / 2, D / 2}, Sc, E, (const char*)(ws + WS_H8), gtab, true);
#elif FK_EXP == 3
        { struct SX { SchedMoe s; __device__ __forceinline__ bool next(int i, Unit& u) const { if (!s.next(i, u)) return false; u.a = s.A + (size_t)(u.pm & 63) * s.ts; return true; } } Sx{Sc};
          gemm_phase<EpiAct, SX, false, true>(lds, Gemm{D / 2, D / 2, D / 2}, Sx, E, nullptr, nullptr, true); }
#elif FK_EXP == 4
        gemm_phase<EpiAct, SchedMoe, true, true, 1>(lds, Gemm{D / 2, D / 2, D / 2}, Sc, E, (const char*)(ws + WS_H8), gtab, true);
#elif FK_EXP == 5
        gemm_phase<EpiAct, SchedMoe, true, true, 2>(lds, Gemm{D / 2, D / 2, D / 2}, Sc, E, (const char*)(ws + WS_H8), gtab, true);
#elif FK_EXP == 6
        gemm_phase<EpiAct, SchedMoe, true, true, 0, true>(lds, Gemm{D / 2, D / 2, D / 2}, Sc, E, (const char*)(ws + WS_H8), gtab, true);
#elif FK_EXP == 7
        { struct SX { SchedMoe s; __device__ __forceinline__ bool next(int i, Unit& u) const { if (!s.next(i, u)) return false; u.a = s.A + (size_t)(u.pm & 1) * s.ts; u.b = s.W + (size_t)(u.pn & 1) * s.ts; return true; } } Sx{Sc};
          gemm_phase<EpiAct, SX, false, true>(lds, Gemm{D / 2, D / 2, D / 2}, Sx, E, nullptr, nullptr, true); }
#elif FK_EXP == 2
        gemm_phase<EpiAct, SchedMoe, true, true>(lds, Gemm{D / 2, D / 2, D / 2}, Sc, E, (const char*)(ws + WS_H8), gtab, false);
#endif
        xcd_barrier(bar); STAMP(15);
#endif
    }
    SEAM(10);
    if (IN(11)) {
        moe_offsets(misc, ctl + CW_CNT);
        SchedMoe Sc{G, blk, 8, (const LAS int*)(misc + 16), (const char*)(ws + WS_ACT), (const char*)(ws + WS_WDN_T), (size_t)2048 * 2048, (size_t)256 * 2048}; EpiDown E{args.in[19], (const int*)(ws + WS_ROWDST), (const float*)(ws + WS_ROWW), (unsigned char*)(ws + WS_YS), (const LAS int*)(misc + 16)};
        gemm_phase<EpiDown, SchedMoe, false, true>(lds, Gemm{FF / 2, FF / 2, FF / 2}, Sc, E);
    }
    SEAM(11);
    if (IN(12)) {
        for (int tok = gw; tok < T; tok += NGW) {
            f32x4 v[8]; float ss = 0.f;
#pragma unroll
            for (int i = 0; i < 8; ++i) { const u32x2 xb = ((const u32x2*)((const bf16*)(ws + WS_X1) + (size_t)tok * D))[lane + 64 * i]; f32x4 a = {bf2f(xb.x & 0xffff), bf2f(xb.x >> 16), bf2f(xb.y & 0xffff), bf2f(xb.y >> 16)}, ysum = {0.f, 0.f, 0.f, 0.f};
#pragma unroll
                for (int k = 0; k < 4; ++k) { const int y = ((const int*)(ws + WS_YS + ((size_t)tok * 4 + k) * D))[lane + 64 * i];
                    const auto lo = __builtin_amdgcn_cvt_pk_f32_fp8(y, false), hi = __builtin_amdgcn_cvt_pk_f32_fp8(y, true);
                    ysum[0] += lo[0]; ysum[1] += lo[1]; ysum[2] += hi[0]; ysum[3] += hi[1]; }
                a = a + ysum * (1.0f / YS_SCALE);
                v[i] = a; ss += a[0] * a[0] + a[1] * a[1] + a[2] * a[2] + a[3] * a[3]; }
            ss = wave_sum(ss); const float rs = rsqrtf(ss * (1.0f / D) + 1e-5f);
#pragma unroll
            for (int i = 0; i < 8; ++i) { const f32x4 gg = ((const f32x4*)args.in[20])[lane + 64 * i]; ((f32x4*)(args.out + (size_t)tok * D))[lane + 64 * i] = v[i] * rs * gg; }
        }
    }
#ifdef FK_TS
    if (blk == 0 && tid == 0) {
        asm volatile("s_waitcnt vmcnt(0)" ::: "memory");
        const unsigned long long tend = __builtin_amdgcn_s_memrealtime();
        misc[64 + 2 * 13] = (unsigned)tend; misc[65 + 2 * 13] = (unsigned)(tend >> 32);
        const unsigned long long ta = ((unsigned long long)misc[65 + 2 * FK_TS_LO] << 32) | misc[64 + 2 * FK_TS_LO], tb = ((unsigned long long)misc[65 + 2 * FK_TS_HI] << 32) | misc[64 + 2 * FK_TS_HI];
#if FK_TS_LO == 99
        const unsigned long long span = (fk_pb - fk_pa) * FK_TS_F;
#else
        const unsigned long long span = (tb - ta) * FK_TS_F;
#endif
        if (span < 2000000ull) while (__builtin_amdgcn_s_memrealtime() - tend < span) __builtin_amdgcn_s_sleep(8);
    }
#endif
#undef IN
#undef SEAM
}

static void launch_phases(void* const* d_in, void* d_out, void* d_ws, hipStream_t stream, int lo, int hi, bool per_phase) {
    static int grid = 0;
    if (grid == 0) {
        int dev = 0, cus = 0;
        (void)hipGetDevice(&dev); (void)hipDeviceGetAttribute(&cus, hipDeviceAttributeMultiprocessorCount, dev);
        (void)hipFuncSetAttribute((const void*)fwd, hipFuncAttributeMaxDynamicSharedMemorySize, LDS_BYTES);
        grid = cus > 0 ? cus : 256;
    }
    Args a{};
    for (int i = 0; i < 21; ++i) a.in[i] = (const float*)d_in[i];
    a.out = (float*)d_out; a.ws = (unsigned char*)d_ws;
    if (per_phase) { for (int p = lo; p < hi; ++p) { a.ph_lo = p; a.ph_hi = p + 1; hipLaunchKernelGGL(fwd, dim3(grid), dim3(NTHREADS), LDS_BYTES, stream, a); } }
    else { a.ph_lo = lo; a.ph_hi = hi; hipLaunchKernelGGL(fwd, dim3(grid), dim3(NTHREADS), LDS_BYTES, stream, a); }
}
}
extern "C" void kernel_launch(void* const* d_in, const int* in_sizes, int n_in, void* d_out, int out_size, void* d_ws, size_t ws_size, hipStream_t stream) {
    using namespace fk;
    (void)hipMemsetAsync((char*)d_ws + WS_CTL, 0, CTL_BYTES, stream);
    launch_phases(d_in, d_out, d_ws, stream, 0, NPHASE, false);
}
```
